# Optimizing an MI355X kernel written in HIP

```python
import jax, jax.numpy as jnp
from jax import lax
import numpy as np

D_MODEL = 2048
BATCH = 1
SEQ = 8192
DEPTH = 1

POOL_WINDOWS = (2, 4, 8, 16)
N_POOL_GROUPS = len(POOL_WINDOWS)
POOL_WIDTH = D_MODEL // 2
POOL_GROUP = POOL_WIDTH // N_POOL_GROUPS
HEAD_DIM = 128
ATTN_WIDTH = D_MODEL // 2
ATTN_HEADS = ATTN_WIDTH // HEAD_DIM
MOBA_BLOCK = 256
MOBA_TOPK = 3
Q_CHUNK = 64
IN_PROJ_WIDTH = POOL_WIDTH + 3 * ATTN_WIDTH + 2 * D_MODEL
N_GROUPS = 4
EXPERTS_PER_GROUP = 4
N_EXPERTS = N_GROUPS * EXPERTS_PER_GROUP
EXPERT_TOPK = 2
D_EXPERT = D_MODEL // 2
RMS_EPS = 1e-6
NEG_INF = -1e30

kernel_name = "hybrid_pool_moba_hmoe_block"


def rms_norm(x, g):
    xf = x.astype(jnp.float32)
    y = xf * lax.rsqrt(jnp.mean(xf * xf, axis=-1, keepdims=True) + RMS_EPS)
    return (y * g.astype(jnp.float32)).astype(x.dtype)


def alibi_slopes(n_heads):
    return jnp.exp2(-8.0 * jnp.arange(1, n_heads + 1, dtype=jnp.float32) / n_heads)


def pool_mixer(u, w_pool, pool_scale):
    B, S, _ = u.shape
    ug = u.reshape(B, S, N_POOL_GROUPS, POOL_GROUP).astype(jnp.float32)
    cs = jnp.cumsum(ug, axis=1)
    t = jnp.arange(S)
    pooled = []
    for gi, w in enumerate(POOL_WINDOWS):
        c = cs[:, :, gi]
        c_prev = jnp.pad(c, ((0, 0), (w, 0), (0, 0)))[:, :S]
        cnt = jnp.minimum(t + 1, w).astype(jnp.float32)[None, :, None]
        pooled.append((c - c_prev) / cnt)
    pooled = jnp.stack(pooled, axis=2)
    mixed = (pooled - ug).astype(u.dtype)
    y = jnp.einsum('bsgc,gcd->bsgd', mixed, w_pool).reshape(B, S, POOL_WIDTH)
    return y * pool_scale


def moba_attention(q, k, v):
    B, S, H, Dh = q.shape
    s_pad = -(-S // MOBA_BLOCK) * MOBA_BLOCK
    pad = ((0, 0), (0, 0), (0, s_pad - S), (0, 0))
    qh = jnp.pad(q.transpose(0, 2, 1, 3), pad)
    kh = jnp.pad(k.transpose(0, 2, 1, 3), pad)
    vh = jnp.pad(v.transpose(0, 2, 1, 3), pad)
    nb = s_pad // MOBA_BLOCK
    topk = min(MOBA_TOPK, nb)
    kb = kh.reshape(B, H, nb, MOBA_BLOCK, Dh)
    vb = vh.reshape(B, H, nb, MOBA_BLOCK, Dh)
    kmean = jnp.mean(kb.astype(jnp.float32), axis=3)
    slopes = alibi_slopes(H)
    scale = HEAD_DIM ** -0.5
    nq = s_pad // Q_CHUNK
    qc = qh.reshape(B, H, nq, Q_CHUNK, Dh).transpose(2, 0, 1, 3, 4)
    b_ar = jnp.arange(B)[:, None, None, None]
    h_ar = jnp.arange(H)[None, :, None, None]
    blk_pos = jnp.arange(MOBA_BLOCK)

    def chunk(args):
        qi, ci = args
        t = ci * Q_CHUNK + jnp.arange(Q_CHUNK)
        own = (ci * Q_CHUNK) // MOBA_BLOCK
        gate = jnp.einsum('bhqd,bhnd->bhqn', qi.astype(jnp.float32), kmean)
        gate = jnp.where(jnp.arange(nb) < own, gate, NEG_INF)
        _, idx = lax.top_k(gate, topk)
        valid = idx < own
        kg = kb[b_ar, h_ar, idx]
        vg = vb[b_ar, h_ar, idx]
        s_sel = jnp.einsum('bhqd,bhqkcd->bhqkc', qi, kg).astype(jnp.float32) * scale
        pos_sel = idx[..., None] * MOBA_BLOCK + blk_pos
        dist_sel = (t[None, None, :, None, None] - pos_sel).astype(jnp.float32)
        s_sel = jnp.where(valid[..., None], s_sel - slopes[None, :, None, None, None] * dist_sel, NEG_INF)
        ko = lax.dynamic_index_in_dim(kb, own, axis=2, keepdims=False)
        vo = lax.dynamic_index_in_dim(vb, own, axis=2, keepdims=False)
        s_own = jnp.einsum('bhqd,bhcd->bhqc', qi, ko).astype(jnp.float32) * scale
        pos_own = own * MOBA_BLOCK + blk_pos
        dist_own = (t[:, None] - pos_own[None, :]).astype(jnp.float32)
        s_own = jnp.where((dist_own >= 0)[None, None], s_own - slopes[None, :, None, None] * dist_own[None, None], NEG_INF)
        scores = jnp.concatenate([s_sel.reshape(B, H, Q_CHUNK, topk * MOBA_BLOCK), s_own], axis=-1)
        p = jax.nn.softmax(scores, axis=-1).astype(v.dtype)
        p_sel = p[..., :topk * MOBA_BLOCK].reshape(B, H, Q_CHUNK, topk, MOBA_BLOCK)
        p_own = p[..., topk * MOBA_BLOCK:]
        return (jnp.einsum('bhqkc,bhqkcd->bhqd', p_sel, vg)
                + jnp.einsum('bhqc,bhcd->bhqd', p_own, vo))

    outs = lax.map(chunk, (qc, jnp.arange(nq, dtype=jnp.int32)))
    out = outs.transpose(1, 0, 3, 2, 4).reshape(B, s_pad, H * Dh)
    return out[:, :S]


def hier_moe(h, w_r_group, b_r_group, w_r_expert, b_r_expert, w_gate, w_up, w_down):
    hf = h.astype(jnp.float32)
    g_logits = hf @ w_r_group.astype(jnp.float32) + b_r_group.astype(jnp.float32)
    g_prob = jax.nn.softmax(g_logits, axis=-1)
    g_w, g_idx = lax.top_k(g_prob, 1)
    e_logits = jnp.einsum('bsd,gde->bsge', hf, w_r_expert.astype(jnp.float32)) + b_r_expert.astype(jnp.float32)
    e_logits = jnp.take_along_axis(e_logits, g_idx[..., None], axis=2)[:, :, 0]
    top_v, top_i = lax.top_k(e_logits, EXPERT_TOPK)
    top_w = jax.nn.softmax(top_v, axis=-1) * g_w
    flat_i = g_idx * EXPERTS_PER_GROUP + top_i
    combine = jnp.sum(jax.nn.one_hot(flat_i, N_EXPERTS, dtype=jnp.float32) * top_w[..., None], axis=-2)
    a = jnp.einsum('bsd,edf->bsef', h, w_gate)
    u = jnp.einsum('bsd,edf->bsef', h, w_up)
    hid = jax.nn.silu(a) * u * combine[..., None].astype(h.dtype)
    return jnp.einsum('bsef,efd->bsd', hid, w_down)


def setup_inputs(seed: int = 0) -> dict:
    key = jax.random.key(seed)
    ks = jax.random.split(key, 18)
    f32 = jnp.float32
    L = DEPTH

    def nrm(k, shape, scale):
        return jax.random.normal(k, shape, f32) * scale

    return {
        "x": nrm(ks[0], (BATCH, SEQ, D_MODEL), 1.0),
        "norm_mix": 1.0 + nrm(ks[1], (L, D_MODEL), 0.02),
        "w_in": nrm(ks[2], (L, D_MODEL, IN_PROJ_WIDTH), D_MODEL ** -0.5),
        "w_pool": nrm(ks[3], (L, N_POOL_GROUPS, POOL_GROUP, POOL_GROUP), POOL_GROUP ** -0.5),
        "pool_scale": 1.0 + nrm(ks[4], (L, POOL_WIDTH), 0.02),
        "w_branch_pool": nrm(ks[5], (L, POOL_WIDTH, D_MODEL), POOL_WIDTH ** -0.5),
        "w_branch_attn": nrm(ks[6], (L, ATTN_WIDTH, D_MODEL), ATTN_WIDTH ** -0.5),
        "w_out": nrm(ks[7], (L, D_MODEL, D_MODEL), D_MODEL ** -0.5),
        "norm_ffn": 1.0 + nrm(ks[8], (L, D_MODEL), 0.02),
        "w_r_group": nrm(ks[9], (L, D_MODEL, N_GROUPS), D_MODEL ** -0.5),
        "b_r_group": nrm(ks[10], (L, N_GROUPS), 0.01),
        "w_r_expert": nrm(ks[11], (L, N_GROUPS, D_MODEL, EXPERTS_PER_GROUP), D_MODEL ** -0.5),
        "b_r_expert": nrm(ks[12], (L, N_GROUPS, EXPERTS_PER_GROUP), 0.01),
        "w_gate": nrm(ks[13], (L, N_EXPERTS, D_MODEL, D_EXPERT), D_MODEL ** -0.5),
        "w_up": nrm(ks[14], (L, N_EXPERTS, D_MODEL, D_EXPERT), D_MODEL ** -0.5),
        "w_down": nrm(ks[15], (L, N_EXPERTS, D_EXPERT, D_MODEL), D_EXPERT ** -0.5),
        "norm_final": 1.0 + nrm(ks[16], (D_MODEL,), 0.02),
    }


def reference(x, norm_mix, w_in, w_pool, pool_scale, w_branch_pool, w_branch_attn, w_out,
              norm_ffn, w_r_group, b_r_group, w_r_expert, b_r_expert, w_gate, w_up, w_down,
              norm_final):
    B, S, _ = x.shape
    splits = [POOL_WIDTH, POOL_WIDTH + ATTN_WIDTH, POOL_WIDTH + 2 * ATTN_WIDTH,
              POOL_WIDTH + 3 * ATTN_WIDTH, POOL_WIDTH + 3 * ATTN_WIDTH + D_MODEL]
    for l in range(DEPTH):
        h = rms_norm(x, norm_mix[l])
        proj = h @ w_in[l]
        u_pool, q, k, v, gl_pool, gl_attn = jnp.split(proj, splits, axis=-1)
        y_pool = pool_mixer(u_pool, w_pool[l], pool_scale[l]) @ w_branch_pool[l]
        qh = q.reshape(B, S, ATTN_HEADS, HEAD_DIM)
        kh = k.reshape(B, S, ATTN_HEADS, HEAD_DIM)
        vh = v.reshape(B, S, ATTN_HEADS, HEAD_DIM)
        y_attn = moba_attention(qh, kh, vh) @ w_branch_attn[l]
        merged = jax.nn.sigmoid(gl_pool) * y_pool + jax.nn.sigmoid(gl_attn) * y_attn
        x = x + merged @ w_out[l]
        h = rms_norm(x, norm_ffn[l])
        x = x + hier_moe(h, w_r_group[l], b_r_group[l], w_r_expert[l], b_r_expert[l],
                         w_gate[l], w_up[l], w_down[l])
    return rms_norm(x, norm_final)
```

```cpp
#include <hip/hip_runtime.h>
#include <cstdio>
#include <cstdint>

__device__ __forceinline__ int lane_id() { int l; asm volatile("v_mbcnt_lo_u32_b32 %0, -1, 0\n\tv_mbcnt_hi_u32_b32 %0, -1, %0" : "=v"(l)); return l; }
namespace pg8 {
#define PG8_LAS __attribute__((address_space(3)))
typedef unsigned short bf16_t;
typedef short bf16x8 __attribute__((ext_vector_type(8)));
typedef float f32x4 __attribute__((ext_vector_type(4)));
typedef unsigned u32x4 __attribute__((ext_vector_type(4)));
typedef unsigned u32x2 __attribute__((ext_vector_type(2)));
constexpr int BM = 256, BK = 64, HALF = 128, HTB = HALF * BK * 2  , STAGE_BYTES = 8 * HTB, NXCD = 8, WGM = 8;

__host__ __device__ __forceinline__ int lds_byte(int r, int c) { const int st = (r >> 4) * 2 + (c >> 5), rr = r & 15, cc = c & 31, ob = rr * 64 + cc * 2; return st * 1024 + (ob ^ (((ob >> 9) & 1) << 5)); }
__host__ __device__ __forceinline__ void stage_rc(int b, int& R, int& C) { const int st = b / 1024, sb = b % 1024, swz = sb ^ (((sb >> 9) & 1) << 5); R = (st >> 1) * 16 + swz / 64; C = (st & 1) * 32 + (swz % 64) / 2; }
__host__ __device__ __forceinline__ int perm32(int rho) { const int n = rho >> 4, i = rho & 15; return 8 * (i >> 2) + 4 * n + (i & 3); }

struct Unit { int pm, pn, row0, cnt, rows; };
struct Gemm { const bf16_t* A; const bf16_t* Bt; int M, N, K; const int* rowtok; };

struct StaticOrder {
    int nM, nN, nwg, G, c;
    __host__ __device__ void init(int M, int N, int G_, int c_) { nM = M / BM; nN = N / BM; nwg = nM * nN; G = G_; c = c_; }
    __host__ __device__ bool next(int i, Unit& u) const {
        const long L = (long)i * G + c; if (L >= nwg) return false;
        int wgid = (int)L; { const int q = nwg / NXCD, r = nwg % NXCD, xcd = wgid % NXCD, off = wgid / NXCD; wgid = (xcd < r ? xcd * (q + 1) : r * (q + 1) + (xcd - r) * q) + off; }
        const int nig = WGM * nN, gid = wgid / nig, fm = gid * WGM, gsz = (nM - fm) < WGM ? (nM - fm) : WGM;
        u.pm = fm + ((wgid % nig) % gsz); u.pn = (wgid % nig) / gsz; u.row0 = 0; u.cnt = 0; u.rows = 256; return true;
    }
    __device__ __forceinline__ void a_ready(const Unit&) const {}
    __device__ __forceinline__ void done(const Unit&) const {}
};

__device__ __forceinline__ unsigned cvt_pk_bf16(float lo, float hi) { unsigned r; asm volatile("v_cvt_pk_bf16_f32 %0, %1, %2" : "=v"(r) : "v"(lo), "v"(hi)); return r; }

template <class Epi, class Sched, bool ALIGN_EPI = false, bool SP2 = false, bool SKIP = false, bool GATHER = false>
__device__ __forceinline__ void gemm_phase(PG8_LAS unsigned char* lds, const Gemm g, const Sched& S, const Epi& E, int wave_in) {
    int tid_ = wave_in * 64 + lane_id(); asm volatile("" : "+v"(tid_));
    const int tid = tid_, wid = __builtin_amdgcn_readfirstlane(tid >> 6), lane = tid & 63, wr = wid >> 2, wc = wid & 3, fr = lane & 15, fq = lane >> 4;
    const int K = g.K, nt = K / BK;
    unsigned voffA[2], voffB[2];
#pragma unroll
    for (int i = 0; i < 2; ++i) { int R, C; stage_rc(tid * 16 + i * 8192, R, C); const int Rb = Epi::PERM ? ((R & ~31) + perm32(R & 31)) : R;
        voffA[i] = (unsigned)(R * K + C) * 2u; voffB[i] = (unsigned)(Rb * K + C) * 2u; }
    unsigned gvp[2];
    PG8_LAS unsigned* gtab = (PG8_LAS unsigned*)(lds + STAGE_BYTES);
    auto gather_toks = [&](const Unit& u, unsigned (&o)[2]) {
#pragma unroll
        for (int h = 0; h < 2; ++h) { unsigned tk_[2];
#pragma unroll
            for (int i = 0; i < 2; ++i) { int R, C; stage_rc(tid * 16 + i * 8192, R, C); const int slot = u.pm * BM - u.row0 + h * HALF + R;
                tk_[i] = slot < u.cnt ? (unsigned)g.rowtok[(u.pn >> 3) * 8192 + slot] : 0u; }
            o[h] = tk_[0] | (tk_[1] << 16); } };
    auto gather_off = [&](unsigned packed, int i) -> unsigned { int R, C; stage_rc(tid * 16 + i * 8192, R, C); const unsigned tok = i ? (packed >> 16) : (packed & 0xffffu); return (tok * (unsigned)K + (unsigned)C) * 2u; };
    const size_t kstep = (size_t)(BK * 2);
    const size_t hstep = (size_t)HALF * K * 2;
    const size_t tstep = 2 * hstep;
    const unsigned ldsw = (unsigned)wid * 1024u;
    const int aoff = lds_byte(wr * 64 + fr, fq * 8), boff = lds_byte(wc * 32 + fr, fq * 8);
#define PG8_SA(b, h) (((b) * 2 + (h)) * HTB)
#define PG8_SB(b, h) ((4 + (b) * 2 + (h)) * HTB)
#define PG8_STAGE(bufoff, gbase, voff) do { _Pragma("unroll") for (int _i = 0; _i < 2; ++_i) \
        __builtin_amdgcn_global_load_lds((const unsigned*)((const char*)(gbase) + (voff)[_i]), (PG8_LAS unsigned*)(lds + (bufoff) + ldsw + _i * 8192), 16, 0, 0); } while (0)
#define PG8_LDA(dst, b, h) do { _Pragma("unroll") for (int m = 0; m < 4; ++m) _Pragma("unroll") for (int k = 0; k < 2; ++k) dst[m][k] = *(const PG8_LAS bf16x8*)(lds + PG8_SA(b, h) + aoff + m * 2048 + k * 1024); } while (0)
#define PG8_LDB(dst, b, h) do { _Pragma("unroll") for (int n = 0; n < 2; ++n) _Pragma("unroll") for (int k = 0; k < 2; ++k) dst[n][k] = *(const PG8_LAS bf16x8*)(lds + PG8_SB(b, h) + boff + n * 2048 + k * 1024); } while (0)
#define PG8_MMA(ai, bj, At, Bt) do { __builtin_amdgcn_s_setprio(1); _Pragma("unroll") for (int m = 0; m < 4; ++m) { if (!SKIP || (ai) * 128 + wr * 64 + m * 16 < vrows) { _Pragma("unroll") for (int n = 0; n < 2; ++n) _Pragma("unroll") for (int k = 0; k < 2; ++k) \
        acc[ai][bj][m][n] = __builtin_amdgcn_mfma_f32_16x16x32_bf16(Bt[n][k], At[m][k], acc[ai][bj][m][n], 0, 0, 0); } } __builtin_amdgcn_s_setprio(0); } while (0)
#define PG8_WAIT_V(n) asm volatile("s_waitcnt vmcnt(" #n ")" ::: "memory")
#define PG8_WAIT_L(n) asm volatile("s_waitcnt lgkmcnt(" #n ")" ::: "memory")
#define PG8_BAR __builtin_amdgcn_s_barrier()
#define PG8_SCHED __builtin_amdgcn_sched_barrier(0)
    Unit cur, nxt; int ui = 0;
    if (!S.next(0, cur)) return;
    int vrows = cur.rows;
    f32x4 acc[2][2][4][2];
#pragma unroll
    for (int a = 0; a < 2; ++a)
#pragma unroll
        for (int b = 0; b < 2; ++b)
#pragma unroll
            for (int m = 0; m < 4; ++m)
#pragma unroll
                for (int n = 0; n < 2; ++n) acc[a][b][m][n] = (f32x4){0.f, 0.f, 0.f, 0.f};
    bf16x8 At[4][2], B0[2][2], B1[2][2];
    const char* cA = (const char*)g.A + (GATHER ? (size_t)0 : (size_t)cur.pm * tstep); const char* cB = (const char*)g.Bt + (size_t)cur.pn * tstep;
    if constexpr (GATHER) gather_toks(cur, gvp);
#define PG8_STAGE_A(bufoff, ptr, half, nextu) do { if constexpr (!GATHER) { PG8_STAGE(bufoff, (ptr) + ((half) ? hstep : 0), voffA); } else { \
        const unsigned p_ = (nextu) ? gtab[(half) * 512 + tid] : gvp[half]; unsigned o_[2]; o_[0] = gather_off(p_, 0); o_[1] = gather_off(p_, 1); PG8_STAGE(bufoff, ptr, o_); } } while (0)
    S.a_ready(cur);
    if constexpr (SP2) {
        PG8_STAGE(PG8_SB(0, 0), cB, voffB); PG8_STAGE(PG8_SB(0, 1), cB + hstep, voffB); PG8_STAGE_A(PG8_SA(0, 0), cA, 0, false); PG8_STAGE_A(PG8_SA(0, 1), cA, 1, false);
        if (wr == 1) PG8_BAR;
        PG8_WAIT_V(2); PG8_BAR;
        PG8_STAGE(PG8_SB(1, 0), cB + kstep, voffB); PG8_STAGE_A(PG8_SA(1, 0), cA + kstep, 0, false); PG8_STAGE(PG8_SB(1, 1), cB + hstep + kstep, voffB);
        PG8_WAIT_V(6); PG8_BAR;
    } else {
        PG8_STAGE(PG8_SB(0, 0), cB, voffB); PG8_STAGE(PG8_SA(0, 0), cA, voffA); PG8_STAGE(PG8_SB(0, 1), cB + hstep, voffB); PG8_STAGE(PG8_SA(0, 1), cA + hstep, voffA);
        if (wr == 1) PG8_BAR;
        PG8_WAIT_V(4); PG8_BAR;
        PG8_STAGE(PG8_SB(1, 0), cB + kstep, voffB); PG8_STAGE(PG8_SA(1, 0), cA + kstep, voffA); PG8_STAGE(PG8_SB(1, 1), cB + hstep + kstep, voffB);
        PG8_WAIT_V(6); PG8_BAR;
    }
    for (;;) {
        const bool has_next = S.next(ui + 1, nxt);
        const char* nA = (has_next && !GATHER) ? (const char*)g.A + (size_t)nxt.pm * tstep : cA;
        if constexpr (GATHER) { unsigned o_[2] = {gvp[0], gvp[1]}; if (has_next) gather_toks(nxt, o_); gtab[tid] = o_[0]; gtab[512 + tid] = o_[1]; } const char* nB = has_next ? (const char*)g.Bt + (size_t)nxt.pn * tstep : cB;
        for (int t = 0; t < nt; t += 2) {
            const bool last = (t == nt - 2);
            const char* a1 = cA + (size_t)(t + 1) * kstep;
            const char* a2 = last ? nA : cA + (size_t)(t + 2) * kstep; const char* b2 = last ? nB : cB + (size_t)(t + 2) * kstep;
            const char* a3 = a2 + kstep; const char* b3 = b2 + kstep;
            if (last && has_next) S.a_ready(nxt);
            if constexpr (SP2) {
            PG8_LDB(B0, 0, 0); PG8_LDB(B1, 0, 1); PG8_SCHED; PG8_LDA(At, 0, 0); PG8_STAGE_A(PG8_SA(1, 1), a1, 1, false);
            PG8_WAIT_V(8); PG8_WAIT_L(0); PG8_BAR; PG8_MMA(0, 0, At, B0); PG8_MMA(0, 1, At, B1); PG8_BAR; PG8_SCHED;
            PG8_LDA(At, 0, 1); PG8_STAGE(PG8_SB(0, 0), b2, voffB); PG8_STAGE(PG8_SB(0, 1), b2 + hstep, voffB); PG8_STAGE_A(PG8_SA(0, 0), a2, 0, last);
            PG8_WAIT_V(8); PG8_WAIT_L(0); PG8_BAR; PG8_MMA(1, 0, At, B0); PG8_MMA(1, 1, At, B1); PG8_BAR; PG8_SCHED;
            PG8_LDB(B0, 1, 0); PG8_LDB(B1, 1, 1); PG8_SCHED; PG8_LDA(At, 1, 0); PG8_STAGE_A(PG8_SA(0, 1), a2, 1, last);
            PG8_WAIT_V(8); PG8_WAIT_L(0); PG8_BAR; PG8_MMA(0, 0, At, B0); PG8_MMA(0, 1, At, B1); PG8_BAR; PG8_SCHED;
            PG8_LDA(At, 1, 1); PG8_STAGE(PG8_SB(1, 0), b3, voffB); PG8_STAGE(PG8_SB(1, 1), b3 + hstep, voffB); PG8_STAGE_A(PG8_SA(1, 0), a3, 0, last);
            PG8_WAIT_V(8); PG8_WAIT_L(0); PG8_BAR; PG8_MMA(1, 0, At, B0); PG8_MMA(1, 1, At, B1); PG8_BAR; PG8_SCHED;
            } else {
            PG8_LDB(B0, 0, 0); PG8_SCHED; PG8_LDA(At, 0, 0); PG8_STAGE(PG8_SA(1, 1), a1 + hstep, voffA);
            PG8_WAIT_L(8); PG8_BAR; PG8_WAIT_L(0); PG8_MMA(0, 0, At, B0); PG8_BAR; PG8_SCHED;
            PG8_LDB(B1, 0, 1); PG8_STAGE(PG8_SB(0, 0), b2, voffB);
            PG8_BAR; PG8_WAIT_L(0); PG8_MMA(0, 1, At, B1); PG8_BAR;
            PG8_LDA(At, 0, 1); PG8_STAGE(PG8_SA(0, 0), a2, voffA);
            PG8_BAR; PG8_WAIT_L(0); PG8_MMA(1, 0, At, B0); PG8_BAR; PG8_SCHED;
            PG8_STAGE(PG8_SB(0, 1), b2 + hstep, voffB);
            PG8_WAIT_V(6); PG8_BAR; PG8_MMA(1, 1, At, B1); PG8_BAR;
            PG8_LDB(B0, 1, 0); PG8_SCHED; PG8_LDA(At, 1, 0); PG8_STAGE(PG8_SA(0, 1), a2 + hstep, voffA);
            PG8_WAIT_L(8); PG8_BAR; PG8_WAIT_L(0); PG8_MMA(0, 0, At, B0); PG8_BAR; PG8_SCHED;
            PG8_LDB(B1, 1, 1); PG8_STAGE(PG8_SB(1, 0), b3, voffB);
            PG8_BAR; PG8_WAIT_L(0); PG8_MMA(0, 1, At, B1); PG8_BAR;
            PG8_LDA(At, 1, 1); PG8_STAGE(PG8_SA(1, 0), a3, voffA);
            PG8_BAR; PG8_WAIT_L(0); PG8_MMA(1, 0, At, B0); PG8_BAR; PG8_SCHED;
            PG8_STAGE(PG8_SB(1, 1), b3 + hstep, voffB);
            PG8_WAIT_V(6); PG8_BAR; PG8_MMA(1, 1, At, B1); PG8_BAR;
            }
        }
        if constexpr (ALIGN_EPI) { if (wr == 0) PG8_BAR; }
        if constexpr (!Epi::AFTER_DRAIN) { E(acc, cur, wr, wc, fr, fq); S.done(cur); }
        if (!has_next) break;
#pragma unroll
        for (int a = 0; a < 2; ++a)
#pragma unroll
            for (int b = 0; b < 2; ++b)
#pragma unroll
                for (int m = 0; m < 4; ++m)
#pragma unroll
                    for (int n = 0; n < 2; ++n) acc[a][b][m][n] = (f32x4){0.f, 0.f, 0.f, 0.f};
        cur = nxt; cA = nA; cB = nB; ++ui; vrows = cur.rows;
        if constexpr (GATHER) { gvp[0] = gtab[tid]; gvp[1] = gtab[512 + tid]; }
        if constexpr (ALIGN_EPI) { if (wr == 1) PG8_BAR; }
    }
    PG8_WAIT_V(0);
    if constexpr (!ALIGN_EPI) { if (wr == 0) PG8_BAR; }
    PG8_BAR;
    if constexpr (Epi::AFTER_DRAIN) { E.fused(acc, cur, wr, wc, fr, fq, lds, wid, lane); S.done(cur); }
#undef PG8_STAGE_A
#undef PG8_SA
#undef PG8_SB
#undef PG8_STAGE
#undef PG8_LDA
#undef PG8_LDB
#undef PG8_MMA
#undef PG8_WAIT_V
#undef PG8_WAIT_L
#undef PG8_BAR
#undef PG8_SCHED
}
}

constexpr int SEQ = 8192, DM = 2048, NPROJ = 8192, PW = 1024, AW = 1024, NH = 8, HD = 128, MBLK = 256, NBLK = 32;
constexpr int NE = 16, DE = 1024, ECAP = 8192;
constexpr float RMS_EPS = 1e-6f;
constexpr int NWAVES = 8, NTHREADS = 512;

#define GAS __attribute__((address_space(1)))
#define LAS __attribute__((address_space(3)))
typedef unsigned short bf16;
typedef unsigned v4u __attribute__((ext_vector_type(4)));
typedef unsigned v2u __attribute__((ext_vector_type(2)));
typedef float f32x4 __attribute__((ext_vector_type(4)));
typedef float f32x2 __attribute__((ext_vector_type(2)));
typedef short bf16x8 __attribute__((ext_vector_type(8)));
typedef GAS unsigned gu32;
#define RLX_AGENT __ATOMIC_RELAXED, __HIP_MEMORY_SCOPE_AGENT
#define LDS_WAIT() asm volatile("s_waitcnt lgkmcnt(0)" ::: "memory")
#define VM_WAIT() asm volatile("s_waitcnt vmcnt(0)" ::: "memory")
__device__ __forceinline__ unsigned f2bf(float f) { unsigned u = __builtin_bit_cast(unsigned, f); return (u + 0x7fffu + ((u >> 16) & 1u)) >> 16; }
__device__ __forceinline__ unsigned pk2(float lo, float hi) { unsigned r; asm("v_cvt_pk_bf16_f32 %0, %1, %2" : "=v"(r) : "v"(lo), "v"(hi)); return r; }
__device__ __forceinline__ float bf_lo(unsigned w) { return __builtin_bit_cast(float, w << 16); }
__device__ __forceinline__ float bf_hi(unsigned w) { return __builtin_bit_cast(float, w & 0xffff0000u); }
__device__ __forceinline__ float bf2f(bf16 b) { return __builtin_bit_cast(float, (unsigned)b << 16); }
__device__ __forceinline__ float shx(float v, int o, int lane) { return __builtin_bit_cast(float, __builtin_amdgcn_ds_bpermute((lane ^ o) << 2, __builtin_bit_cast(int, v))); }
__device__ __forceinline__ float wave_sum(float v) {
    const int l = lane_id();
#pragma unroll
    for (int o = 1; o < 64; o <<= 1) v += shx(v, o, l);
    return v;
}
__device__ __forceinline__ float wave_max(float v) {
    const int l = lane_id();
#pragma unroll
    for (int o = 1; o < 64; o <<= 1) v = fmaxf(v, shx(v, o, l));
    return v;
}
__device__ __forceinline__ float sigmoidf_(float x) { return __builtin_amdgcn_rcpf(1.0f + __expf(-x)); }

constexpr size_t MiB = 1u << 20;
constexpr size_t WS_CTL = 0, CTL_ZERO_BYTES = 128 * 1024;
constexpr size_t WS_TOKE = 1 * MiB;
constexpr size_t WS_TOKS = WS_TOKE + 65536;
constexpr size_t WS_ROWTOK = WS_TOKS + 65536;
constexpr size_t WS_ROWW = WS_ROWTOK + 524288;
constexpr size_t WS_SEL = 3 * MiB;
constexpr size_t WS_KMEAN = WS_SEL + 262144;
constexpr size_t WS_KMH = WS_KMEAN + 131072, WS_KML = WS_KMH + 65536;
constexpr size_t WS_KPART = WS_KML + 65536;
constexpr size_t WS_WIN = 4 * MiB, WS_WPOOL = 36 * MiB, WS_WBP = 37 * MiB, WS_WBA = 41 * MiB, WS_WOUT = 45 * MiB, WS_WGU = 53 * MiB, WS_WDN = 181 * MiB;
constexpr size_t WS_HN = 245 * MiB;
constexpr size_t WS_U = 277 * MiB, WS_Q = 293 * MiB, WS_K = 309 * MiB, WS_V = 325 * MiB, WS_SGP = 341 * MiB, WS_SGA = 373 * MiB;
constexpr size_t WS_YP = 405 * MiB, WS_AO = 421 * MiB, WS_MIXED = 437 * MiB, WS_PART = 453 * MiB;
constexpr size_t WS_PART3 = 245 * MiB, WS_ML = 261 * MiB;
constexpr size_t WS_TMP = 437 * MiB;
constexpr size_t WS_X1 = 293 * MiB;
constexpr size_t WS_H2P = 277 * MiB, WS_HID = 357 * MiB, WS_Y = 397 * MiB, WS_END = 502 * MiB;
constexpr int CW_BAR = 4096;
constexpr int CW_ATTN = 8192;
constexpr int CW_CONV = 8192 + 512;
constexpr int CW_MOEQ = 8192 + 1024;
constexpr int CW_CNT = 16384;

namespace pg8 {
struct EpiInProj {
    static constexpr bool PERM = true, AFTER_DRAIN = false;
    bf16_t *u, *q, *k, *v, *sgp, *sga; float* kpart;
    __device__ __forceinline__ void operator()(const f32x4 (&acc)[2][2][4][2], const Unit& un, int wr, int wc, int fr, int fq) const {
        if (un.pn >= 8 && un.pn < 12) {
#pragma unroll
            for (int bj = 0; bj < 2; ++bj)
#pragma unroll
                for (int n = 0; n < 2; ++n) { f32x4 s = acc[0][bj][0][n];
#pragma unroll
                    for (int m = 1; m < 4; ++m) s += acc[0][bj][m][n];
#pragma unroll
                    for (int m = 0; m < 4; ++m) s += acc[1][bj][m][n];
#pragma unroll
                    for (int o = 1; o < 16; o <<= 1) { s.x += __shfl_xor(s.x, o); s.y += __shfl_xor(s.y, o); s.z += __shfl_xor(s.z, o); s.w += __shfl_xor(s.w, o); }
                    if (fr == 0) *(f32x4*)(kpart + (size_t)(un.pm * 2 + wr) * 1024 + (un.pn - 8) * 256 + bj * HALF + wc * 32 + 8 * fq + 4 * n) = s; }
        }
        const int pn = un.pn; bf16_t* base; int ldc, colt; const bool sig = pn >= 16;
        if (pn < 16) { base = pn < 4 ? u : pn < 8 ? q : pn < 12 ? k : v; ldc = 1024; colt = (pn & 3) * 256; }
        else { base = pn < 24 ? sgp : sga; ldc = 2048; colt = (pn & 7) * 256; }
        const int row0 = un.pm * BM + wr * 64 + fr, col0 = colt + wc * 32 + 8 * fq;
#pragma unroll
        for (int ai = 0; ai < 2; ++ai)
#pragma unroll
            for (int m = 0; m < 4; ++m) { bf16_t* rowp = base + (size_t)(row0 + ai * HALF + m * 16) * ldc + col0;
#pragma unroll
                for (int bj = 0; bj < 2; ++bj) { f32x4 v0 = acc[ai][bj][m][0], v1 = acc[ai][bj][m][1];
                    if (sig) {
#pragma unroll
                        for (int i = 0; i < 4; ++i) { v0[i] = __builtin_amdgcn_rcpf(1.0f + __expf(-v0[i])); v1[i] = __builtin_amdgcn_rcpf(1.0f + __expf(-v1[i])); } }
                    u32x4 w; w.x = cvt_pk_bf16(v0[0], v0[1]); w.y = cvt_pk_bf16(v0[2], v0[3]); w.z = cvt_pk_bf16(v1[0], v1[1]); w.w = cvt_pk_bf16(v1[2], v1[3]);
                    *(u32x4*)(rowp + bj * HALF) = w; } }
    }
};
struct EpiPool {
    static constexpr bool PERM = true, AFTER_DRAIN = false;
    bf16_t* yp; const float* scale;
    __device__ __forceinline__ void operator()(const f32x4 (&acc)[2][2][4][2], const Unit& un, int wr, int wc, int fr, int fq) const {
        const int g = un.pn, row0 = (un.pm & 31) * BM + wr * 64 + fr, col0 = g * 256 + wc * 32 + 8 * fq;
#pragma unroll
        for (int bj = 0; bj < 2; ++bj) { const f32x4 s0 = *(const f32x4*)(scale + col0 + bj * HALF), s1 = *(const f32x4*)(scale + col0 + bj * HALF + 4);
#pragma unroll
            for (int ai = 0; ai < 2; ++ai)
#pragma unroll
                for (int m = 0; m < 4; ++m) { bf16_t* rowp = yp + (size_t)(row0 + ai * HALF + m * 16) * 1024 + col0 + bj * HALF;
                    const f32x4 v0 = acc[ai][bj][m][0] * s0, v1 = acc[ai][bj][m][1] * s1;
                    u32x4 w; w.x = cvt_pk_bf16(v0[0], v0[1]); w.y = cvt_pk_bf16(v0[2], v0[3]); w.z = cvt_pk_bf16(v1[0], v1[1]); w.w = cvt_pk_bf16(v1[2], v1[3]);
                    *(u32x4*)rowp = w; } }
    }
};
__device__ __forceinline__ void unpack8(const u32x4 w, float (&f)[8]) {
    f[0] = __builtin_bit_cast(float, w.x << 16); f[1] = __builtin_bit_cast(float, w.x & 0xffff0000u);
    f[2] = __builtin_bit_cast(float, w.y << 16); f[3] = __builtin_bit_cast(float, w.y & 0xffff0000u);
    f[4] = __builtin_bit_cast(float, w.z << 16); f[5] = __builtin_bit_cast(float, w.z & 0xffff0000u);
    f[6] = __builtin_bit_cast(float, w.w << 16); f[7] = __builtin_bit_cast(float, w.w & 0xffff0000u);
}
struct EpiBranch {
    static constexpr bool PERM = true, AFTER_DRAIN = false;
    const bf16_t* sgp; bf16_t* tmp; long sg_step, out_step;
    __device__ __forceinline__ void operator()(const f32x4 (&acc)[2][2][4][2], const Unit& un, int wr, int wc, int fr, int fq) const {
        const bool second = un.pm >= 32; const int pm = second ? un.pm - 32 : un.pm, pn = second ? un.pn - 8 : un.pn;
        const bf16_t* sg = sgp + (second ? sg_step : 0); bf16_t* outp = tmp + (second ? out_step : 0);
        const int row0 = pm * BM + wr * 64 + fr, col0 = pn * BM + wc * 32 + 8 * fq;
#pragma unroll
        for (int ai = 0; ai < 2; ++ai) { u32x4 gv[4][2], tv[4][2];
#pragma unroll
            for (int m = 0; m < 4; ++m)
#pragma unroll
                for (int bj = 0; bj < 2; ++bj) gv[m][bj] = *(const u32x4*)(sg + (size_t)(row0 + ai * HALF + m * 16) * 2048 + col0 + bj * HALF);
            if (second) {
#pragma unroll
                for (int m = 0; m < 4; ++m)
#pragma unroll
                    for (int bj = 0; bj < 2; ++bj) tv[m][bj] = *(const u32x4*)(tmp + (size_t)(row0 + ai * HALF + m * 16) * 2048 + col0 + bj * HALF);
            } else {
#pragma unroll
                for (int m = 0; m < 4; ++m)
#pragma unroll
                    for (int bj = 0; bj < 2; ++bj) tv[m][bj] = u32x4{0u, 0u, 0u, 0u};
            }
#pragma unroll
            for (int m = 0; m < 4; ++m)
#pragma unroll
                for (int bj = 0; bj < 2; ++bj) { float g[8], t[8]; unpack8(gv[m][bj], g); unpack8(tv[m][bj], t);
                    const f32x4 a0 = acc[ai][bj][m][0], a1 = acc[ai][bj][m][1];
                    const float r[8] = {a0[0] * g[0] + t[0], a0[1] * g[1] + t[1], a0[2] * g[2] + t[2], a0[3] * g[3] + t[3], a1[0] * g[4] + t[4], a1[1] * g[5] + t[5], a1[2] * g[6] + t[6], a1[3] * g[7] + t[7]};
                    u32x4 w; w.x = cvt_pk_bf16(r[0], r[1]); w.y = cvt_pk_bf16(r[2], r[3]); w.z = cvt_pk_bf16(r[4], r[5]); w.w = cvt_pk_bf16(r[6], r[7]);
                    *(u32x4*)(outp + (size_t)(row0 + ai * HALF + m * 16) * 2048 + col0 + bj * HALF) = w; } }
    }
};
struct BranchOrder {
    StaticOrder so; int nc;
    __device__ __forceinline__ void init(int G, int c) { so.init(8192, 2048, G, c); nc = c < so.nwg ? (so.nwg - 1 - c) / G + 1 : 0; }
    __device__ __forceinline__ bool next(int i, Unit& u) const {
        if (i >= 2 * nc) return false; const bool second = i >= nc; (void)so.next(second ? i - nc : i, u); if (second) { u.pm += 32; u.pn += 8; } return true; }
    __device__ __forceinline__ void a_ready(const Unit&) const {}
    __device__ __forceinline__ void done(const Unit&) const {}
};
struct EpiResid {
    static constexpr bool PERM = true, AFTER_DRAIN = false;
    const float* x; bf16_t* x1;
    __device__ __forceinline__ void operator()(const f32x4 (&acc)[2][2][4][2], const Unit& un, int wr, int wc, int fr, int fq) const {
        const int row0 = un.pm * BM + wr * 64 + fr, col0 = un.pn * BM + wc * 32 + 8 * fq;
#pragma unroll
        for (int ai = 0; ai < 2; ++ai) { f32x4 xv[4][2][2];
#pragma unroll
            for (int m = 0; m < 4; ++m)
#pragma unroll
                for (int bj = 0; bj < 2; ++bj)
#pragma unroll
                    for (int n = 0; n < 2; ++n) xv[m][bj][n] = *(const f32x4*)(x + (size_t)(row0 + ai * HALF + m * 16) * 2048 + col0 + bj * HALF + n * 4);
#pragma unroll
            for (int m = 0; m < 4; ++m)
#pragma unroll
                for (int bj = 0; bj < 2; ++bj) { const f32x4 v0 = xv[m][bj][0] + acc[ai][bj][m][0], v1 = xv[m][bj][1] + acc[ai][bj][m][1];
                    u32x4 w; w.x = cvt_pk_bf16(v0[0], v0[1]); w.y = cvt_pk_bf16(v0[2], v0[3]); w.z = cvt_pk_bf16(v1[0], v1[1]); w.w = cvt_pk_bf16(v1[2], v1[3]);
                    *(u32x4*)(x1 + (size_t)(row0 + ai * HALF + m * 16) * 2048 + col0 + bj * HALF) = w; } }
    }
};
struct EpiGU {
    static constexpr bool PERM = false, AFTER_DRAIN = false;
    bf16_t* hid; const float* roww;
    __device__ __forceinline__ void operator()(const f32x4 (&acc)[2][2][4][2], const Unit& un, int wr, int wc, int fr, int fq) const {
        const int e = un.pn >> 3, pnl = un.pn & 7; const int row0 = un.pm * BM + wr * 64 + fr, col0 = pnl * 128 + wc * 16 + 4 * fq;
        float wv[2][4];
#pragma unroll
        for (int ai = 0; ai < 2; ++ai)
#pragma unroll
            for (int m = 0; m < 4; ++m) { const int slot = row0 + ai * HALF + m * 16 - un.row0; wv[ai][m] = slot < un.cnt ? roww[e * ECAP + slot] : 0.f; }
#pragma unroll
        for (int ai = 0; ai < 2; ++ai)
#pragma unroll
            for (int m = 0; m < 4; ++m) { const int row = row0 + ai * HALF + m * 16; const float w = wv[ai][m];
#pragma unroll
                for (int bj = 0; bj < 2; ++bj) { const f32x4 a = acc[ai][bj][m][0], uu = acc[ai][bj][m][1]; float h[4];
#pragma unroll
                    for (int i = 0; i < 4; ++i) h[i] = a[i] * __builtin_amdgcn_rcpf(1.0f + __expf(-a[i])) * uu[i] * w;
                    u32x2 o; o.x = cvt_pk_bf16(h[0], h[1]); o.y = cvt_pk_bf16(h[2], h[3]);
                    *(u32x2*)(hid + (size_t)row * DE_ + col0 + bj * 64) = o; } }
    }
    static constexpr int DE_ = 1024;
};
struct EpiDown {
    static constexpr bool PERM = true, AFTER_DRAIN = false;
    bf16_t* y;
    __device__ __forceinline__ void operator()(const f32x4 (&acc)[2][2][4][2], const Unit& un, int wr, int wc, int fr, int fq) const {
        const int pnl = un.pn & 7; const int row0 = un.pm * BM + wr * 64 + fr, col0 = pnl * 256 + wc * 32 + 8 * fq;
#pragma unroll
        for (int ai = 0; ai < 2; ++ai)
#pragma unroll
            for (int m = 0; m < 4; ++m) { bf16_t* rowp = y + (size_t)(row0 + ai * HALF + m * 16) * 2048 + col0;
#pragma unroll
                for (int bj = 0; bj < 2; ++bj) { const f32x4 v0 = acc[ai][bj][m][0], v1 = acc[ai][bj][m][1];
                    u32x4 w; w.x = cvt_pk_bf16(v0[0], v0[1]); w.y = cvt_pk_bf16(v0[2], v0[3]); w.z = cvt_pk_bf16(v1[0], v1[1]); w.w = cvt_pk_bf16(v1[2], v1[3]);
                    *(u32x4*)(rowp + bj * HALF) = w; } }
    }
};
struct PoolOrder {
    int G, c;
    __device__ __forceinline__ bool next(int i, Unit& u) const { const int L = i * G + c; if (L >= 128) return false; u.pm = L; u.pn = L >> 5; u.row0 = 0; u.cnt = 0; u.rows = 256; return true; }
    __device__ __forceinline__ void a_ready(const Unit&) const {}
    __device__ __forceinline__ void done(const Unit&) const {}
};
struct MoeOrder {
    const unsigned* cnt; int mode, G, c;
    __device__ __forceinline__ bool next(int i, Unit& u) const {
        const int lane = lane_id();
        unsigned cv = 0; if (lane < NE_) cv = __hip_atomic_load(cnt + 64 * lane, __ATOMIC_RELAXED, __HIP_MEMORY_SCOPE_AGENT);
        const int tiles = (int)((cv + 255u) >> 8); int incl = tiles;
#pragma unroll
        for (int o = 1; o < 16; o <<= 1) { const int t = __shfl_up(incl, o); if (lane >= o) incl += t; }
        const int Ttot = __shfl(incl, 15); int L = -1;
        if (G == 256 && Ttot >= 64) {
            const int n3 = 8 * (Ttot - 64), Gp = G - n3;
            if (mode == 0) { const int l = i * G + c; if (l < 512) L = l; }
            else if (mode == 1) { if (i == 0 && c < n3) L = 512 + c; }
            else if (mode == 2) { if (c >= n3 && i < 2) L = i * Gp + (c - n3); }
            else { const int r = i * G + c; if (r < 3 * n3) L = r < 2 * n3 ? 2 * Gp + r : 512 + (r - 2 * n3); }
        } else {
            if (mode == 0 || mode == 3) { const int l = i * G + c; if (l < 8 * Ttot) L = l; }
        }
        if (L < 0) return false;
        const int T = L >> 3;
        const int e = __popcll(__ballot(lane < NE_ && incl <= T));
        u.pm = __builtin_amdgcn_readfirstlane(T); u.pn = __builtin_amdgcn_readfirstlane(e * 8 + (L & 7)); u.row0 = __builtin_amdgcn_readfirstlane(__shfl(incl - tiles, e) * 256);
        u.cnt = __builtin_amdgcn_readfirstlane((int)__shfl((int)cv, e)); u.rows = 256; return true;
    }
    __device__ __forceinline__ void a_ready(const Unit&) const {}
    __device__ __forceinline__ void done(const Unit&) const {}
    static constexpr int NE_ = 16;
};
}

#define XB_TMO      128
#define XB_XCNT(j)  (256  + 64 * (j))
#define XB_XSUB(j)  (1280 + 64 * (j))
#define XB_XGEN(j)  (2304 + 64 * (j))
#define XB_TOP      3328
#define XB_TOPGEN   3392
#define XCD_BAR_WORDS 3456
#define XB_SPIN_CAP (1u << 18)

__device__ __forceinline__ unsigned xb_ld(unsigned* p)              { return __hip_atomic_load(p, __ATOMIC_RELAXED, __HIP_MEMORY_SCOPE_AGENT); }
__device__ __forceinline__ unsigned xb_add(unsigned* p, unsigned v) { return __hip_atomic_fetch_add(p, v, __ATOMIC_RELAXED, __HIP_MEMORY_SCOPE_AGENT); }
__device__ __forceinline__ unsigned xb_xcc_id() { return (unsigned)__builtin_amdgcn_s_getreg((3 << 11) | 20) & 0xFu; }
#define XB_SPIN(cond, bar) do { unsigned _sp = 0; while (cond) { __builtin_amdgcn_s_sleep(1); \
    if ((++_sp & 255u) == 0u) { if (xb_ld(&(bar)[XB_TMO])) break; if (_sp > XB_SPIN_CAP) { atomicAdd(&(bar)[XB_TMO], 1u); break; } } } } while (0)

struct XcdBarrier {
    int wave;
    unsigned* bar; unsigned x;
    volatile LAS unsigned* st;
};

__device__ __forceinline__ XcdBarrier xcd_barrier_post(unsigned* bar, volatile LAS unsigned* st, int wave) {
    XcdBarrier b; b.wave = wave; b.bar = bar; b.x = xb_xcc_id(); b.st = st;
    if (b.wave == 0 && lane_id() == 0) (void)xb_add(&bar[XB_XCNT(b.x)], 1u);
    return b;
}
__device__ __forceinline__ void xcd_barrier_complete(unsigned* bar, unsigned x, unsigned& nloc, unsigned& nx) {
    const unsigned G = gridDim.x * gridDim.y * gridDim.z;
    unsigned sum, cnt, mine, sp = 0u;
    for (;;) {
        sum = 0u; cnt = 0u; mine = 0u;
#pragma unroll
        for (unsigned j = 0; j < 16; ++j) { const unsigned c = xb_ld(&bar[XB_XCNT(j)]); sum += c; cnt += (c > 0u) ? 1u : 0u; mine = (j == x) ? c : mine; }
        if (sum == G) break;
        __builtin_amdgcn_s_sleep(1);
        if ((++sp & 255u) == 0u) { if (xb_ld(&bar[XB_TMO])) break; if (sp > XB_SPIN_CAP) { atomicAdd(&bar[XB_TMO], 1u); break; } }
    }
    nloc = mine > 0u ? mine : 1u; nx = cnt > 0u ? cnt : 1u;
}

__device__ __forceinline__ void xcd_barrier(const XcdBarrier& b) {
    asm volatile("s_waitcnt vmcnt(0)" ::: "memory");
    __syncthreads();
    if (b.wave == 0 && lane_id() == 0) {
        unsigned* bar = b.bar;
        __builtin_amdgcn_s_waitcnt(0);
        unsigned nloc = b.st[0], nx = b.st[1];
        if (nloc == 0u) { xcd_barrier_complete(bar, b.x, nloc, nx); b.st[0] = nloc; b.st[1] = nx; }
        const unsigned old = xb_add(&bar[XB_XSUB(b.x)], 1u);
        const unsigned gen = old / nloc;
        if (old + 1u == (gen + 1u) * nloc) {
            __builtin_amdgcn_fence(__ATOMIC_RELEASE, "agent");
            asm volatile("s_waitcnt vmcnt(0)" ::: "memory");
            const unsigned og = xb_add(&bar[XB_TOP], 1u);
            const unsigned tg = og / nx;
            if (og + 1u == (tg + 1u) * nx) xb_add(&bar[XB_TOPGEN], 1u);
            else XB_SPIN(xb_ld(&bar[XB_TOPGEN]) == tg, bar);
            __builtin_amdgcn_fence(__ATOMIC_ACQUIRE, "agent");
            xb_add(&bar[XB_XGEN(b.x)], 1u);
            asm volatile("s_waitcnt vmcnt(0)" ::: "memory");
        } else {
            XB_SPIN(xb_ld(&bar[XB_XGEN(b.x)]) == gen, bar);
            __builtin_amdgcn_fence(__ATOMIC_ACQUIRE, "agent");
            asm volatile("s_waitcnt vmcnt(0)" ::: "memory");
        }
    }
    __syncthreads();
}


constexpr int RING_OFF = 0, RING_BYTES = 139264;
constexpr int LDSCTL_OFF = RING_BYTES, MISC_OFF = LDSCTL_OFF + 320;
constexpr int LDS_BYTES = 147456;

struct Args { const float* in[17]; float* out; unsigned char* ws; int ph_lo, ph_hi; };

struct Ctx {
    LAS unsigned char* lds; int tid, lane, wave, G, bid, gw, ngw;
};

struct TrDesc { const float* src; bf16* dst; int N, K, mode, n0; };
__device__ __forceinline__ TrDesc tr_desc(const float* W, int K, int N, bf16* WT, int mode, int tile) {
    const int nblk = N >> 6, kb = tile / nblk, nb = tile - kb * nblk; TrDesc d; d.src = W + (size_t)(kb * 64) * N + nb * 64; d.dst = WT + kb * 64; d.N = N; d.K = K; d.mode = mode; d.n0 = nb * 64; return d;
}
__device__ __forceinline__ void tr_load(const TrDesc& d, f32x4 (&v)[16], int lane) {
    const unsigned lo = (unsigned)((lane >> 4) * d.N + 4 * (lane & 15)) * 4u;
    const char* p = (const char*)d.src;
#pragma unroll
    for (int i = 0; i < 16; ++i) v[i] = __builtin_nontemporal_load((const f32x4*)(p + (size_t)(16 * i) * d.N + lo));
}
__device__ __forceinline__ void tr_store(const TrDesc& d, const f32x4 (&v)[16], LAS float* scr, int lane) {
    asm volatile("" ::: "memory"); __builtin_amdgcn_sched_barrier(0);
    {   const unsigned wa = (unsigned)(uintptr_t)(scr + (lane >> 4) * 65 + 4 * (lane & 15));
#pragma unroll
        for (int i = 0; i < 16; ++i) {
            asm volatile("ds_write_b32 %0, %1 offset:%2" :: "v"(wa), "v"(v[i].x), "n"(i * 1040 + 0) : "memory");
            asm volatile("ds_write_b32 %0, %1 offset:%2" :: "v"(wa), "v"(v[i].y), "n"(i * 1040 + 4) : "memory");
            asm volatile("ds_write_b32 %0, %1 offset:%2" :: "v"(wa), "v"(v[i].z), "n"(i * 1040 + 8) : "memory");
            asm volatile("ds_write_b32 %0, %1 offset:%2" :: "v"(wa), "v"(v[i].w), "n"(i * 1040 + 12) : "memory"); } }
    LDS_WAIT(); asm volatile("" ::: "memory");
    const int c = lane >> 3;
    const int rowbase = d.mode == 0 ? d.n0 : (d.n0 >> 4) * 32 + (d.mode == 2 ? 16 : 0);
    const unsigned so = (unsigned)((lane & 7) * d.K + 8 * c) * 2u;
    char* q = (char*)(d.dst + (size_t)rowbase * d.K);
#pragma unroll
    for (int j = 0; j < 8; ++j) { const LAS float* s = scr + (8 * c) * 65 + (lane & 7) + 8 * j;
        v4u o; o.x = pk2(s[0 * 65], s[1 * 65]); o.y = pk2(s[2 * 65], s[3 * 65]); o.z = pk2(s[4 * 65], s[5 * 65]); o.w = pk2(s[6 * 65], s[7 * 65]);
        const int rowj = d.mode == 0 ? 8 * j : (j >> 1) * 32 + 8 * (j & 1);
        __builtin_nontemporal_store(o, (v4u*)(q + (size_t)(2 * rowj) * d.K + so)); }
    LDS_WAIT(); asm volatile("" ::: "memory");
}
__device__ __forceinline__ void rms_row_bf16(const float* xrow, const float* g, bf16* orow, int lane) {
    f32x4 v[8]; float s = 0.f;
#pragma unroll
    for (int j = 0; j < 4; ++j) { const float* p = xrow + 8 * (lane + 64 * j); v[2 * j] = __builtin_nontemporal_load((const f32x4*)p); v[2 * j + 1] = __builtin_nontemporal_load((const f32x4*)(p + 4)); }
#pragma unroll
    for (int j = 0; j < 8; ++j) s += (v[j].x * v[j].x + v[j].y * v[j].y) + (v[j].z * v[j].z + v[j].w * v[j].w);
    const float rstd = 1.0f / sqrtf(wave_sum(s) * (1.0f / DM) + RMS_EPS);
#pragma unroll
    for (int j = 0; j < 4; ++j) { const float* gp = g + 8 * (lane + 64 * j); const f32x4 g0 = *(const f32x4*)gp, g1 = *(const f32x4*)(gp + 4);
        const f32x4 a = v[2 * j] * rstd * g0, b = v[2 * j + 1] * rstd * g1;
        v4u o; o.x = pk2(a.x, a.y); o.y = pk2(a.z, a.w); o.z = pk2(b.x, b.y); o.w = pk2(b.z, b.w);
        *(v4u*)(orow + 8 * (lane + 64 * j)) = o; }
}
__device__ __forceinline__ TrDesc p0_desc(const Args& a, int r) {
    unsigned char* ws = a.ws;
    constexpr int T_IN = (DM / 64) * (NPROJ / 64), T_POOL = 4 * 4 * 4, T_BP = (PW / 64) * (DM / 64);
    if (r < T_IN) return tr_desc(a.in[2], DM, NPROJ, (bf16*)(ws + WS_WIN), 0, r); r -= T_IN;
    if (r < T_POOL) { const int g = r >> 4; return tr_desc(a.in[3] + (size_t)g * 65536, 256, 256, (bf16*)(ws + WS_WPOOL) + (size_t)g * 65536, 0, r & 15); } r -= T_POOL;
    if (r < T_BP) return tr_desc(a.in[5], PW, DM, (bf16*)(ws + WS_WBP), 0, r); r -= T_BP;
    if (r < T_BP) return tr_desc(a.in[6], AW, DM, (bf16*)(ws + WS_WBA), 0, r); r -= T_BP;
    return tr_desc(a.in[7], DM, DM, (bf16*)(ws + WS_WOUT), 0, r);
}
__device__ __forceinline__ void p0_prologue(const Ctx& C, const Args& a) {
    LAS float* scr = (LAS float*)(C.lds + C.wave * 16640);
    constexpr int NT = (DM / 64) * (NPROJ / 64) + 64 + 2 * (PW / 64) * (DM / 64) + (DM / 64) * (DM / 64);
    int it = C.gw;
    if (it < NT) {
        f32x4 va[16], vb[16]; TrDesc d0 = p0_desc(a, it); tr_load(d0, va, C.lane);
        for (;;) { const int nx = it + C.ngw; const bool more = nx < NT; TrDesc d1 = d0;
            if (more) { d1 = p0_desc(a, nx); tr_load(d1, vb, C.lane); }
            tr_store(d0, va, scr, C.lane);
            if (!more) break;
            d0 = d1; it = nx;
#pragma unroll
            for (int i = 0; i < 16; ++i) va[i] = vb[i]; }
    }
    for (int m = C.gw; m < SEQ; m += C.ngw) rms_row_bf16(a.in[0] + (size_t)m * DM, a.in[1], (bf16*)(a.ws + WS_HN) + (size_t)m * DM, C.lane);
}
__device__ __forceinline__ TrDesc moe_desc(const Args& a, int r) {
    unsigned char* ws = a.ws;
    constexpr int TPE_G = (DM / 64) * (DE / 64), TPE_D = (DE / 64) * (DM / 64), T_G = NE * TPE_G;
    if (r < T_G) { const int e = r / TPE_G; return tr_desc(a.in[13] + (size_t)e * DM * DE, DM, DE, (bf16*)(ws + WS_WGU) + (size_t)e * 2048 * DM, 1, r - e * TPE_G); } r -= T_G;
    if (r < T_G) { const int e = r / TPE_G; return tr_desc(a.in[14] + (size_t)e * DM * DE, DM, DE, (bf16*)(ws + WS_WGU) + (size_t)e * 2048 * DM, 2, r - e * TPE_G); } r -= T_G;
    const int e = r / TPE_D; return tr_desc(a.in[15] + (size_t)e * DE * DM, DE, DM, (bf16*)(ws + WS_WDN) + (size_t)e * DM * DE, 0, r - e * TPE_D);
}
template <bool CONV_CU>
__device__ __forceinline__ void conv_tiles(const Ctx& C, const Args& a, int idx) {
    LAS float* scr = (LAS float*)(C.lds + C.wave * 16640);
    constexpr int NT = 3 * NE * (DM / 64) * (DE / 64), NGW = 208 * NWAVES, TAIL_PER_WAVE = 3, NT_A = NT - TAIL_PER_WAVE * NGW, NT_8 = NT_A - 1536;
    static_assert(NT_A % 64 == 0 && NT_8 % 64 == 0 && NT_8 > 0, "whole tile groups");
    f32x4 va[16], vb[16];
    if (C.G != 256) { for (int t = C.gw; t < NT; t += C.ngw) { const TrDesc d = moe_desc(a, t); tr_load(d, va, C.lane); tr_store(d, va, scr, C.lane); } return; }
    if (!CONV_CU) {
#pragma unroll 1
        for (int s_ = 0; s_ < TAIL_PER_WAVE; ++s_) { const TrDesc d = moe_desc(a, NT_A + s_ * NGW + idx); tr_load(d, va, C.lane); tr_store(d, va, scr, C.lane); }
        return;
    }
    unsigned* ctr = (unsigned*)(a.ws + WS_CTL) + CW_CONV;
    auto pull = [&](unsigned* c, unsigned n) -> int { unsigned b0 = 0; if (C.lane == 0) b0 = __hip_atomic_fetch_add(c, n, RLX_AGENT); return __builtin_amdgcn_readfirstlane((int)b0); };
    auto first = [&](int base_) { const int b = base_ >> 3; return moe_desc(a, ((b >> 3) << 6) + (b & 7)); };
    auto sub = [](const TrDesc& m, int i) { const int sh = m.N == DM ? 2 : 1  , nbi = i & ((1 << sh) - 1), kbi = i >> sh;
        TrDesc d = m; d.src = m.src + (size_t)(kbi * 64) * m.N + nbi * 512; d.dst = m.dst + kbi * 64; d.n0 = m.n0 + nbi * 512; return d; };
    int base = pull(ctr, 8u);
    if (base < NT_8) {
        TrDesc m = first(base); tr_load(m, va, C.lane);
        for (;;) {
            const TrDesc d1 = sub(m, 1); tr_load(d1, vb, C.lane); tr_store(m, va, scr, C.lane);
            const TrDesc d2 = sub(m, 2); tr_load(d2, va, C.lane); tr_store(d1, vb, scr, C.lane);
            const TrDesc d3 = sub(m, 3); tr_load(d3, vb, C.lane); tr_store(d2, va, scr, C.lane);
            const TrDesc d4 = sub(m, 4); tr_load(d4, va, C.lane); tr_store(d3, vb, scr, C.lane);
            const TrDesc d5 = sub(m, 5); tr_load(d5, vb, C.lane); tr_store(d4, va, scr, C.lane);
            const TrDesc d6 = sub(m, 6); tr_load(d6, va, C.lane); tr_store(d5, vb, scr, C.lane);
            const TrDesc d7 = sub(m, 7); tr_load(d7, vb, C.lane); tr_store(d6, va, scr, C.lane);
            base = pull(ctr, 8u);
            if (base >= NT_8) { tr_store(d7, vb, scr, C.lane); break; }
            m = first(base); tr_load(m, va, C.lane);
            tr_store(d7, vb, scr, C.lane);
        }
    }
    for (;;) {
        const int t = pull(ctr + 64, 2u); if (t >= NT_A - NT_8) break;
        const TrDesc d0 = moe_desc(a, NT_8 + t), d1 = moe_desc(a, NT_8 + t + 1);
        tr_load(d0, va, C.lane); tr_load(d1, vb, C.lane); tr_store(d0, va, scr, C.lane); tr_store(d1, vb, scr, C.lane);
    }
}

__device__ __forceinline__ void pool_mixed_tile(const Ctx& C, const Args& a, int L) {
    unsigned char* ws = a.ws; const bf16* u = (const bf16*)(ws + WS_U); bf16* mixed = (bf16*)(ws + WS_MIXED);
    const int g = L >> 5, rt = L & 31, w = 2 << g; const int chunk = C.tid & 31, run = C.tid >> 5;
    const int r0 = rt * 256 + run * 16; const bf16* up = u + g * 256 + chunk * 8; bf16* mp = mixed + ((size_t)g * SEQ) * 256 + chunk * 8;
    float s[8], cur[8];
#pragma unroll
    for (int i = 0; i < 8; ++i) { s[i] = 0.f; cur[i] = 0.f; }
    for (int i = (r0 - w + 1 < 0 ? 0 : r0 - w + 1); i <= r0; ++i) { float f[8]; pg8::unpack8(*(const v4u*)(up + (size_t)i * PW), f);
#pragma unroll
        for (int k = 0; k < 8; ++k) { s[k] += f[k]; cur[k] = f[k]; } }
    for (int r = r0; r < r0 + 16; ++r) {
        if (r > r0) { float f[8]; pg8::unpack8(*(const v4u*)(up + (size_t)r * PW), f);
#pragma unroll
            for (int k = 0; k < 8; ++k) { s[k] += f[k]; cur[k] = f[k]; }
            if (r - w >= 0) { float o[8]; pg8::unpack8(*(const v4u*)(up + (size_t)(r - w) * PW), o);
#pragma unroll
                for (int k = 0; k < 8; ++k) s[k] -= o[k]; } }
        const float inv = 1.0f / (float)(r + 1 < w ? r + 1 : w);
        v4u o; o.x = pk2(s[0] * inv - cur[0], s[1] * inv - cur[1]); o.y = pk2(s[2] * inv - cur[2], s[3] * inv - cur[3]);
        o.z = pk2(s[4] * inv - cur[4], s[5] * inv - cur[5]); o.w = pk2(s[6] * inv - cur[6], s[7] * inv - cur[7]);
        *(v4u*)(mp + (size_t)r * 256) = o;
    }
}

__device__ __forceinline__ bool gate_better(float av, int ai, float bv, int bi) { return av > bv || (av == bv && ai < bi); }

__device__ __forceinline__ void moe_offsets(const unsigned* cnt, int lane, int& incl_tiles, int& tiles, unsigned& cv) {
    cv = 0; if (lane < NE) cv = __hip_atomic_load(cnt + 64 * lane, RLX_AGENT);
    tiles = (int)((cv + 255u) >> 8); incl_tiles = tiles;
#pragma unroll
    for (int o = 1; o < 16; o <<= 1) { const int tt = __shfl_up(incl_tiles, o); if (lane >= o) incl_tiles += tt; }
}
constexpr int TPW = 4;
__device__ __forceinline__ void reduce32(float (&v)[32], int lane) {
#pragma unroll
    for (int i = 0; i < 16; ++i) { const bool up = lane & 32; const float snd = up ? v[i] : v[i + 16], kp = up ? v[i + 16] : v[i]; v[i] = kp + shx(snd, 32, lane); }
#pragma unroll
    for (int i = 0; i < 8; ++i) { const bool up = lane & 16; const float snd = up ? v[i] : v[i + 8], kp = up ? v[i + 8] : v[i]; v[i] = kp + shx(snd, 16, lane); }
#pragma unroll
    for (int i = 0; i < 4; ++i) { const bool up = lane & 8; const float snd = up ? v[i] : v[i + 4], kp = up ? v[i + 4] : v[i]; v[i] = kp + shx(snd, 8, lane); }
#pragma unroll
    for (int i = 0; i < 2; ++i) { const bool up = lane & 4; const float snd = up ? v[i] : v[i + 2], kp = up ? v[i + 2] : v[i]; v[i] = kp + shx(snd, 4, lane); }
    { const bool up = lane & 2; const float snd = up ? v[0] : v[1], kp = up ? v[1] : v[0]; v[0] = kp + shx(snd, 2, lane); }
    v[0] += shx(v[0], 1, lane);
}
template <class Bar>
__device__ __forceinline__ void p_router(const Ctx& C, const Args& a, const Bar& bar) {
    unsigned char* ws = a.ws; const bf16* x1 = (const bf16*)(ws + WS_X1); const float* g2 = a.in[8];
    const float* wrg = a.in[9]; const float* brg = a.in[10]; const float* wre = a.in[11]; const float* bre = a.in[12];
    unsigned* cnt = (unsigned*)(ws + WS_CTL) + CW_CNT;
    int* toke = (int*)(ws + WS_TOKE); int* toks = (int*)(ws + WS_TOKS); int* rowtok = (int*)(ws + WS_ROWTOK); float* roww = (float*)(ws + WS_ROWW);
    bf16* h2 = (bf16*)(ws + WS_HN);
    const int lane = C.lane, tid = C.tid;
    LAS float* wl = (LAS float*)C.lds;
    const bf16* xp[TPW];
#pragma unroll
    for (int k = 0; k < TPW; ++k) { const int t = C.gw + k * C.ngw; xp[k] = x1 + (size_t)__builtin_amdgcn_readfirstlane(t < SEQ ? t : 0) * DM; }
    const int lo4 = 4 * lane;
    float ga[TPW][4], ssq[TPW];
#pragma unroll
    for (int k = 0; k < TPW; ++k) { ssq[k] = 0.f; ga[k][0] = 0.f; ga[k][1] = 0.f; ga[k][2] = 0.f; ga[k][3] = 0.f; }
    pg8::u32x2 xn[TPW][2]; f32x4 gn[2], wn;
#pragma unroll
    for (int jj = 0; jj < 2; ++jj) { gn[jj] = *(const f32x4*)(g2 + 256 * jj + 4 * lane);
#pragma unroll
        for (int k = 0; k < TPW; ++k) xn[k][jj] = *(const pg8::u32x2*)(xp[k] + (256 * jj + lo4)); }
    wn = *(const f32x4*)(wrg + (size_t)tid * 4);
#pragma unroll 1
    for (int ch = 0; ch < 4; ++ch) {
        __syncthreads();
        *(LAS f32x4*)(wl + tid * 4) = wn;
        pg8::u32x2 xv[TPW][2]; f32x4 gg[2];
#pragma unroll
        for (int jj = 0; jj < 2; ++jj) { gg[jj] = gn[jj];
#pragma unroll
            for (int k = 0; k < TPW; ++k) xv[k][jj] = xn[k][jj]; }
        { const int cn = ch < 3 ? ch + 1 : 3;
#pragma unroll
            for (int jj = 0; jj < 2; ++jj) { gn[jj] = *(const f32x4*)(g2 + cn * 512 + 256 * jj + 4 * lane);
#pragma unroll
                for (int k = 0; k < TPW; ++k) xn[k][jj] = *(const pg8::u32x2*)(xp[k] + (cn * 512 + 256 * jj + lo4)); }
            wn = *(const f32x4*)(wrg + (size_t)(cn * 512 + tid) * 4); }
        __syncthreads();
#pragma unroll
        for (int jj = 0; jj < 2; ++jj)
#pragma unroll
            for (int i = 0; i < 4; ++i) { const f32x4 w = *(const LAS f32x4*)(wl + (256 * jj + 4 * lane + i) * 4);
#pragma unroll
                for (int k = 0; k < TPW; ++k) { const unsigned xw_ = i < 2 ? xv[k][jj].x : xv[k][jj].y; const float x = (i & 1) ? bf_hi(xw_) : bf_lo(xw_), xs = x * gg[jj][i]; ssq[k] += x * x; ga[k][0] += xs * w.x; ga[k][1] += xs * w.y; ga[k][2] += xs * w.z; ga[k][3] += xs * w.w; } }
    }
    float rstd[TPW], gwt[TPW]; int gi[TPW];
    { float v[32];
#pragma unroll
        for (int c = 0; c < 32; ++c) v[c] = 0.f;
#pragma unroll
        for (int k = 0; k < TPW; ++k) { v[5 * k] = ga[k][0]; v[5 * k + 1] = ga[k][1]; v[5 * k + 2] = ga[k][2]; v[5 * k + 3] = ga[k][3]; v[5 * k + 4] = ssq[k]; }
        reduce32(v, lane); const float vt = v[0];
#pragma unroll
        for (int k = 0; k < TPW; ++k) {
            rstd[k] = 1.0f / sqrtf(__shfl(vt, 2 * (5 * k + 4)) * (1.0f / DM) + RMS_EPS);
            float gl[4];
#pragma unroll
            for (int i = 0; i < 4; ++i) gl[i] = __shfl(vt, 2 * (5 * k + i)) * rstd[k] + brg[i];
            int g = 0; float gm = gl[0];
#pragma unroll
            for (int i = 1; i < 4; ++i) if (gl[i] > gm) { gm = gl[i]; g = i; }
            float gs = 0.f;
#pragma unroll
            for (int i = 0; i < 4; ++i) gs += __expf(gl[i] - gm);
            gi[k] = g; gwt[k] = 1.0f / gs;
            asm volatile("" : "+v"(gwt[k]));
            __builtin_amdgcn_sched_barrier(0);
        } }
    float eacc[TPW][4];
#pragma unroll
    for (int k = 0; k < TPW; ++k) { eacc[k][0] = 0.f; eacc[k][1] = 0.f; eacc[k][2] = 0.f; eacc[k][3] = 0.f; }
    {
    pg8::u32x2 xn[TPW][2];
#pragma unroll
    for (int jj = 0; jj < 2; ++jj)
#pragma unroll
        for (int k = 0; k < TPW; ++k) xn[k][jj] = *(const pg8::u32x2*)(xp[k] + (256 * jj + lo4));
#pragma unroll 1
    for (int ch = 0; ch < 4; ++ch) {
        __syncthreads();
#pragma unroll
        for (int g = 0; g < 4; ++g) *(LAS f32x4*)(wl + (g + 1) * 2048 + tid * 4) = *(const f32x4*)(wre + ((size_t)g * DM + ch * 512 + tid) * 4);
        pg8::u32x2 xv[TPW][2]; f32x4 gg[2];
#pragma unroll
        for (int jj = 0; jj < 2; ++jj) { gg[jj] = *(const f32x4*)(g2 + ch * 512 + 256 * jj + 4 * lane);
#pragma unroll
            for (int k = 0; k < TPW; ++k) xv[k][jj] = xn[k][jj]; }
        { const int cn = ch < 3 ? ch + 1 : 3;
#pragma unroll
            for (int jj = 0; jj < 2; ++jj)
#pragma unroll
                for (int k = 0; k < TPW; ++k) xn[k][jj] = *(const pg8::u32x2*)(xp[k] + (cn * 512 + 256 * jj + lo4)); }
        __syncthreads();
#pragma unroll
        for (int k = 0; k < TPW; ++k) { const int t = C.gw + k * C.ngw; const LAS float* wp = wl + (gi[k] + 1) * 2048;
#pragma unroll
            for (int jj = 0; jj < 2; ++jj) { float hs[4];
#pragma unroll
                for (int i = 0; i < 4; ++i) { const f32x4 w = *(const LAS f32x4*)(wp + (256 * jj + 4 * lane + i) * 4); const unsigned xw_ = i < 2 ? xv[k][jj].x : xv[k][jj].y; const float x = (i & 1) ? bf_hi(xw_) : bf_lo(xw_), xs = x * gg[jj][i];
                    eacc[k][0] += xs * w.x; eacc[k][1] += xs * w.y; eacc[k][2] += xs * w.z; eacc[k][3] += xs * w.w; hs[i] = x * rstd[k] * gg[jj][i]; }
                if (t < SEQ) { v2u o; o.x = pk2(hs[0], hs[1]); o.y = pk2(hs[2], hs[3]); *(v2u*)(h2 + (size_t)t * DM + ch * 512 + 256 * jj + 4 * lane) = o; } } }
    }
    }
    { float v[32];
#pragma unroll
        for (int c = 0; c < 32; ++c) v[c] = 0.f;
#pragma unroll
        for (int k = 0; k < TPW; ++k) { v[4 * k] = eacc[k][0]; v[4 * k + 1] = eacc[k][1]; v[4 * k + 2] = eacc[k][2]; v[4 * k + 3] = eacc[k][3]; }
        reduce32(v, lane_id()); const float vt = v[0];
#pragma unroll
        for (int k = 0; k < TPW; ++k) {
            const int t = C.gw + k * C.ngw;
            float el[4];
#pragma unroll
            for (int i = 0; i < 4; ++i) el[i] = __shfl(vt, 2 * (4 * k + i)) * rstd[k] + bre[gi[k] * 4 + i];
            int i0 = 0; float v0 = el[0];
#pragma unroll
            for (int i = 1; i < 4; ++i) if (el[i] > v0) { v0 = el[i]; i0 = i; }
            int i1 = -1; float v1 = -3.0e38f;
#pragma unroll
            for (int i = 0; i < 4; ++i) if (i != i0 && el[i] > v1) { v1 = el[i]; i1 = i; }
            const float e1 = __expf(v1 - v0), den = 1.0f / (1.0f + e1);
            const float w0 = den * gwt[k], w1 = e1 * den * gwt[k];
            const int ea = gi[k] * 4 + i0, eb = gi[k] * 4 + i1;
            if (lane == 0 && t < SEQ) { const int xa = (int)__hip_atomic_fetch_add(cnt + 64 * ea, 1u, RLX_AGENT), xb = (int)__hip_atomic_fetch_add(cnt + 64 * eb, 1u, RLX_AGENT);
                roww[ea * ECAP + xa] = w0; roww[eb * ECAP + xb] = w1; rowtok[ea * ECAP + xa] = t; rowtok[eb * ECAP + xb] = t;
                toke[2 * t] = ea; toke[2 * t + 1] = eb; toks[2 * t] = xa; toks[2 * t + 1] = xb; }
            __builtin_amdgcn_sched_barrier(0);
        } }
}
struct FinRow { v4u x[4], ya[4], yb[4]; };
__device__ __forceinline__ void fin_load(FinRow& r, const bf16* xr, const bf16* ya, const bf16* yb, int lane) {
#pragma unroll
    for (int j = 0; j < 4; ++j) { const int c0 = 8 * (lane + 64 * j); r.x[j] = __builtin_nontemporal_load((const v4u*)(xr + c0));
        r.ya[j] = __builtin_nontemporal_load((const v4u*)(ya + c0)); r.yb[j] = __builtin_nontemporal_load((const v4u*)(yb + c0)); }
}
__device__ __forceinline__ void p8_final(const Ctx& C, const Args& a) {
    unsigned char* ws = a.ws; float* out = a.out; const float* gf = a.in[16]; const bf16* y = (const bf16*)(ws + WS_Y); const bf16* x1 = (const bf16*)(ws + WS_X1);
    const int* toke = (const int*)(ws + WS_TOKE); const int* toks = (const int*)(ws + WS_TOKS); const unsigned* cnt = (const unsigned*)(ws + WS_CTL) + CW_CNT;
    const int lane = C.lane;
    int incl, tiles; unsigned cv; moe_offsets(cnt, lane, incl, tiles, cv);
    auto rowof = [&](int e, int slot) { return (__shfl(incl, e) - __shfl(tiles, e)) * 256 + slot; };
    int t = C.gw; if (t >= SEQ) return;
    FinRow cur, nxt;
    { const int ra = rowof(toke[2 * t], toks[2 * t]), rb = rowof(toke[2 * t + 1], toks[2 * t + 1]); fin_load(cur, x1 + (size_t)t * DM, y + (size_t)ra * DM, y + (size_t)rb * DM, lane); }
    for (;;) {
        const int tn = t + C.ngw; const bool more = tn < SEQ;
        if (more) { const int ra = rowof(toke[2 * tn], toks[2 * tn]), rb = rowof(toke[2 * tn + 1], toks[2 * tn + 1]); fin_load(nxt, x1 + (size_t)tn * DM, y + (size_t)ra * DM, y + (size_t)rb * DM, lane); }
        float* xr = out + (size_t)t * DM; float hv[32]; float s = 0.f;
#pragma unroll
        for (int j = 0; j < 4; ++j) { float fa[8], fb[8], fx[8]; pg8::unpack8(cur.ya[j], fa); pg8::unpack8(cur.yb[j], fb); pg8::unpack8(cur.x[j], fx);
#pragma unroll
            for (int i = 0; i < 8; ++i) hv[8 * j + i] = fx[i] + fa[i] + fb[i]; }
#pragma unroll
        for (int i = 0; i < 32; ++i) s += hv[i] * hv[i];
        const float rstd = 1.0f / sqrtf(wave_sum(s) * (1.0f / DM) + RMS_EPS);
#pragma unroll
        for (int j = 0; j < 4; ++j) { const int c0 = 8 * (lane + 64 * j); const f32x4 g0 = *(const f32x4*)(gf + c0), g1 = *(const f32x4*)(gf + c0 + 4);
            __builtin_nontemporal_store((f32x4){hv[8 * j] * rstd * g0.x, hv[8 * j + 1] * rstd * g0.y, hv[8 * j + 2] * rstd * g0.z, hv[8 * j + 3] * rstd * g0.w}, (f32x4*)(xr + c0));
            __builtin_nontemporal_store((f32x4){hv[8 * j + 4] * rstd * g1.x, hv[8 * j + 5] * rstd * g1.y, hv[8 * j + 6] * rstd * g1.z, hv[8 * j + 7] * rstd * g1.w}, (f32x4*)(xr + c0 + 4)); }
        if (!more) break;
        t = tn; cur = nxt;
    }
}

namespace moba {
typedef float f32x16 __attribute__((ext_vector_type(16)));
typedef short s16x4 __attribute__((ext_vector_type(4)));
typedef short v4i16_t __attribute__((ext_vector_type(4)));
constexpr int LK = 0, LV = 65536, LLIST = 131072, LWC = LLIST + 6144;
constexpr int MAXBLK = 12;
constexpr float LOG2E = 1.4426950408889634f, C1 = 0.08838834764831845f * 1.4426950408889634f;
constexpr int TARGET = 448, MAXENT = 192;
struct Tab { int nB, n; unsigned e[MAXENT]; };
constexpr Tab make_tab() {
    Tab t{}; int n = 0; float cost[MAXENT] = {};
    for (int j = 0; j < 31; ++j) { int b = j + 1;
        while (b < 32) { float acc = 0.f; const int lo = b; while (b < 32 && acc < (float)TARGET && b - lo < MAXBLK) { acc += b <= 3 ? 256.f : 768.f / (float)b; ++b; } t.e[n] = (unsigned)j | ((unsigned)lo << 8) | ((unsigned)b << 16); cost[n] = acc; ++n; } }
    for (int i = 1; i < n; ++i) { const unsigned ke = t.e[i]; const float kc = cost[i]; int k = i - 1; while (k >= 0 && cost[k] < kc) { t.e[k + 1] = t.e[k]; cost[k + 1] = cost[k]; --k; } t.e[k + 1] = ke; cost[k + 1] = kc; }
    t.nB = n;
    for (int b = 31; b >= 0; --b) { t.e[n] = (unsigned)b | ((unsigned)b << 8) | ((unsigned)(b + 1) << 16); ++n; }
    t.n = n; return t;
}
__device__ const Tab g_tab = make_tab();

__device__ __forceinline__ int crow(int r, int hf) { return (r & 3) + 8 * (r >> 2) + 4 * hf; }
__device__ __forceinline__ s16x4 vtr(const LAS unsigned char* p) { return __builtin_bit_cast(s16x4, __builtin_amdgcn_ds_read_tr16_b64_v4i16((LAS v4i16_t*)p)); }

__device__ __forceinline__ void load_kv(LAS unsigned char* lds, const bf16* K, const bf16* V, int h, int j, int wave, int lane) {
#pragma unroll
    for (int i = 0; i < 8; ++i) { const int p = wave * 8 + i; const int key = 4 * p + (lane >> 4), cp = lane & 15;
        const bf16* src = K + (size_t)(j * 256 + key) * AW + h * HD + ((cp ^ (key & 15)) * 8);
        __builtin_amdgcn_global_load_lds((const unsigned*)src, (LAS unsigned*)(lds + LK + p * 1024), 16, 0, 0); }
#pragma unroll
    for (int i = 0; i < 8; ++i) { const int p = wave * 8 + i; const int q4 = p >> 4, kg = p & 15; const int key = kg * 16 + (lane >> 2), part = lane & 3;
        const bf16* src = V + (size_t)(j * 256 + key) * AW + h * HD + q4 * 32 + part * 8;
        __builtin_amdgcn_global_load_lds((const unsigned*)src, (LAS unsigned*)(lds + LV + q4 * 16384 + kg * 1024), 16, 0, 0); }
}

#define MOBA_SB() __builtin_amdgcn_sched_barrier(0)
template <bool CAUSAL>
__device__ __forceinline__ void attn_group(LAS unsigned char* lds, const LAS unsigned short* ent, int cnt, int tbase, const bf16* Q, bf16* part, bf16* part3, float* ml, int h, int j, int kmax, int lane) {
    const int ql = lane & 31, hf = lane >> 5;
    const unsigned en = ent[ql < cnt ? ql : 0];
    const int tq = tbase + (int)(en & 0xfffu), slot = (int)(en >> 12);
    bf16x8 qf[8]; { const bf16* qp = Q + (size_t)tq * AW + h * HD + 8 * hf;
#pragma unroll
        for (int s = 0; s < 8; ++s) qf[s] = *(const bf16x8*)(qp + 16 * s); }
    const float slope2 = exp2f(-(float)(h + 1)) * LOG2E;
    const float tb = (float)(j * 256 + 4 * hf - tq);
    f32x16 o[4];
#pragma unroll
    for (int d = 0; d < 4; ++d)
#pragma unroll
        for (int r = 0; r < 16; ++r) o[d][r] = 0.f;
    float m_run = -1e30f, l_run = 0.f;
    const LAS unsigned char* kbase = lds + LK + ql * 256;
    const LAS unsigned char* vbase = lds + LV + (4 * hf + ((lane & 15) >> 2)) * 64 + ((lane >> 4) & 1) * 32 + (lane & 3) * 8;
    const int kq = ql & 15;
#define MOBA_KF(idx) (*(const LAS bf16x8*)(kbase + ((idx) >> 3) * 8192 + (((2 * ((idx) & 7) + hf) ^ kq) * 16)))
#pragma unroll
    for (int half = 0; half < 2; ++half) {
        if (CAUSAL && half * 128 > kmax) break;
        f32x16 st[4];
#pragma unroll
        for (int kt = 0; kt < 4; ++kt)
#pragma unroll
            for (int r = 0; r < 16; ++r) st[kt][r] = 0.f;
        bf16x8 kr[8];
#pragma unroll
        for (int i = 0; i < 3; ++i) kr[i] = MOBA_KF(half * 32 + i);
#pragma unroll
        for (int i = 0; i < 32; ++i) {
            if (i + 3 < 32) kr[(i + 3) & 7] = MOBA_KF(half * 32 + i + 3);
            if ((i & 3) == 0) MOBA_SB();
            const int kt = i >> 3, s = i & 7;
            if (!(CAUSAL && (half * 4 + kt) * 32 > kmax)) st[kt] = __builtin_amdgcn_mfma_f32_32x32x16_bf16(kr[i & 7], qf[s], st[kt], 0, 0, 0);
        }
#pragma unroll
        for (int kt = 0; kt < 4; ++kt) {
            const int ktt = half * 4 + kt;
            if (CAUSAL && ktt * 32 > kmax) {
#pragma unroll
                for (int r = 0; r < 16; ++r) st[kt][r] = -1e30f;
            } else {
                const float tbk = tb + (float)(ktt * 32);
#pragma unroll
                for (int r = 0; r < 16; ++r) { const float rel = tbk + (float)((r & 3) + 8 * (r >> 2));
                    float s2 = st[kt][r] * C1 + slope2 * rel; if (CAUSAL && rel > 0.f) s2 = -1e30f; st[kt][r] = s2; }
            }
        }
        float mx = -1e30f;
#pragma unroll
        for (int kt = 0; kt < 4; ++kt)
#pragma unroll
            for (int r = 0; r < 16; ++r) mx = fmaxf(mx, st[kt][r]);
        mx = fmaxf(mx, __shfl_xor(mx, 32));
        const float m_new = fmaxf(m_run, mx), alpha = __builtin_amdgcn_exp2f(m_run - m_new);
        m_run = m_new; l_run *= alpha;
        if (half == 1) {
#pragma unroll
            for (int d = 0; d < 4; ++d)
#pragma unroll
                for (int r = 0; r < 16; ++r) o[d][r] *= alpha; }
        float ls = 0.f;
        s16x4 vr[8];
#define MOBA_VF(slot, idx) do { const LAS unsigned char* vp_ = vbase + ((idx) & 3) * 16384 + (half * 8 + ((idx) >> 2)) * 1024; vr[2 * (slot)] = vtr(vp_); vr[2 * (slot) + 1] = vtr(vp_ + 512); } while (0)
        MOBA_VF(0, 0); MOBA_VF(1, 1);
#pragma unroll
        for (int kt = 0; kt < 4; ++kt) {
            const int ktt = half * 4 + kt;
            const bool skip = CAUSAL && ktt * 32 > kmax;
            float p[16];
            if (!skip) {
#pragma unroll
                for (int r = 0; r < 16; ++r) { p[r] = __builtin_amdgcn_exp2f(st[kt][r] - m_new); ls += p[r]; } }
            else {
#pragma unroll
                for (int r = 0; r < 16; ++r) p[r] = 0.f; }
#pragma unroll
            for (int s2 = 0; s2 < 2; ++s2) {
                v4u pw; pw.x = pg8::cvt_pk_bf16(p[8 * s2 + 0], p[8 * s2 + 1]); pw.y = pg8::cvt_pk_bf16(p[8 * s2 + 2], p[8 * s2 + 3]); pw.z = pg8::cvt_pk_bf16(p[8 * s2 + 4], p[8 * s2 + 5]); pw.w = pg8::cvt_pk_bf16(p[8 * s2 + 6], p[8 * s2 + 7]);
                const bf16x8 pf = __builtin_bit_cast(bf16x8, pw);
#pragma unroll
                for (int d = 0; d < 4; ++d) {
                    const int idx = (kt * 2 + s2) * 4 + d;
                    if (idx + 2 < 32) MOBA_VF((idx + 2) & 3, idx + 2);
                    if ((idx & 1) == 0) MOBA_SB();
                    const s16x4 lo = vr[2 * (idx & 3)], hi = vr[2 * (idx & 3) + 1];
                    const bf16x8 vf = (bf16x8){lo[0], lo[1], lo[2], lo[3], hi[0], hi[1], hi[2], hi[3]};
                    if (!skip) o[d] = __builtin_amdgcn_mfma_f32_32x32x16_bf16(vf, pf, o[d], 0, 0, 0);
                }
            }
        }
#undef MOBA_VF
        l_run += ls;
    }
#undef MOBA_KF
    const float l_tot = l_run + __shfl_xor(l_run, 32);
    if (ql < cnt) {
        const float inv = 1.0f / l_tot;
        bf16* pp = (slot == 3 ? part3 : part + (size_t)slot * SEQ * AW) + (size_t)tq * AW + h * HD + 4 * hf;
#pragma unroll
        for (int d = 0; d < 4; ++d)
#pragma unroll
            for (int rq = 0; rq < 4; ++rq) { v2u w; w.x = pg8::cvt_pk_bf16(o[d][4 * rq] * inv, o[d][4 * rq + 1] * inv); w.y = pg8::cvt_pk_bf16(o[d][4 * rq + 2] * inv, o[d][4 * rq + 3] * inv);
                *(v2u*)(pp + 32 * d + 8 * rq) = w; }
        if (hf == 0) *(f32x2*)(ml + ((size_t)slot * SEQ + tq) * (2 * NH) + 2 * h) = (f32x2){m_run, l_tot};
    }
}
}

__device__ __forceinline__ bf16* part_ptr(unsigned char* ws) { return (bf16*)(ws + WS_PART); }
__device__ __forceinline__ float* ml_ptr(unsigned char* ws) { return (float*)(ws + WS_ML); }

__device__ __forceinline__ void p_attn(const Ctx& C, const Args& a, int rep) {
    using namespace moba;
    unsigned char* ws = a.ws; LAS unsigned char* lds = C.lds;
    const bf16* Q = (const bf16*)(ws + WS_Q); const bf16* K = (const bf16*)(ws + WS_K); const bf16* V = (const bf16*)(ws + WS_V);
    const unsigned* sel = (const unsigned*)(ws + WS_SEL); bf16* part = part_ptr(ws); bf16* part3 = (bf16*)(ws + WS_PART3); float* ml = ml_ptr(ws);
    unsigned* ctr = (unsigned*)(ws + WS_CTL) + CW_ATTN + 64 * rep;
    LAS unsigned short* lst = (LAS unsigned short*)(lds + LLIST); volatile LAS int* wc = (volatile LAS int*)(lds + LWC);
    const int NU = g_tab.n * NH; const int tid = C.tid, lane = C.lane, wave = C.wave;
    int u = C.bid;
    while (u < NU) {
        const unsigned ent = g_tab.e[u >> 3]; const int h = u & 7, j = (int)(ent & 0xff), blo = (int)((ent >> 8) & 0xff), bhi = (int)(ent >> 16);
        if (tid == 0) wc[16] = (int)(C.G + __hip_atomic_fetch_add(ctr, 1u, RLX_AGENT));
        const bool causal = blo == j; const int t_lo = blo * 256; int n = 256;
        const int nt = causal ? 0 : (bhi - blo) * 256;
        unsigned spv[MAXBLK / 2];
#pragma unroll
        for (int i = 0; i < MAXBLK / 2; ++i) { const int tr = i * 512 + tid; spv[i] = 0xffffffffu; if (tr < nt) spv[i] = sel[(t_lo + tr) * NH + h]; }
        load_kv(lds, K, V, h, j, wave, lane);
        if (causal) { if (tid < 256) lst[tid] = (unsigned short)(tid | (3 << 12)); }
        else {
            int slot[MAXBLK / 2]; int before[MAXBLK / 2]; int mycnt = 0;
#pragma unroll
            for (int i = 0; i < MAXBLK / 2; ++i) { const unsigned sp = spv[i]; slot[i] = (int)(sp & 0xff) == j ? 0 : (int)((sp >> 8) & 0xff) == j ? 1 : (int)((sp >> 16) & 0xff) == j ? 2 : -1; }
#pragma unroll
            for (int i = 0; i < MAXBLK / 2; ++i) { const unsigned long long bal = __ballot(slot[i] >= 0); before[i] = mycnt + __popcll(bal & ((1ull << lane) - 1ull)); mycnt += __popcll(bal); }
            if (lane == 0) wc[wave] = mycnt;
            __syncthreads();
            int base = 0, tot = 0;
#pragma unroll
            for (int w = 0; w < 8; ++w) { const int c = wc[w]; if (w < wave) base += c; tot += c; }
#pragma unroll
            for (int i = 0; i < MAXBLK / 2; ++i) if (slot[i] >= 0) lst[base + before[i]] = (unsigned short)((i * 512 + tid) | (slot[i] << 12));
            n = tot;
        }
        asm volatile("s_waitcnt vmcnt(0)" ::: "memory"); __syncthreads();
        if (causal) attn_group<true>(lds, lst + wave * 32, 32, t_lo, Q, part, part3, ml, h, j, wave * 32 + 31, lane);
        else { const int ng = (n + 31) >> 5;
            for (int g = wave; g < ng; g += 8) { const int c = n - g * 32; attn_group<false>(lds, lst + g * 32, c < 32 ? c : 32, t_lo, Q, part, part3, ml, h, j, 255, lane); } }
        __syncthreads();
        u = wc[16];
        __syncthreads();
    }
}

__device__ __forceinline__ void p_combine(const Ctx& C, const Args& a) {
    unsigned char* ws = a.ws; const unsigned* sel = (const unsigned*)(ws + WS_SEL); const bf16* part = part_ptr(ws); const bf16* part3 = (const bf16*)(ws + WS_PART3); const float* ml = ml_ptr(ws); bf16* ao = (bf16*)(ws + WS_AO);
    const int lane = C.lane, h = lane >> 3, dc = lane & 7;
    for (int t0 = C.gw; t0 < SEQ; t0 += 2 * C.ngw) {
        f32x2 mv[2][4]; v4u pv[2][4][2]; bool val[2][4];
#pragma unroll
        for (int k = 0; k < 2; ++k) { const int t = t0 + k * C.ngw; const bool tv = t < SEQ; const int tt = tv ? t : 0; const unsigned sp = sel[tt * NH + h]; const int own = tt >> 8;
#pragma unroll
            for (int s = 0; s < 4; ++s) { val[k][s] = tv && (s == 3 || (int)((sp >> (8 * s)) & 0xff) < own); } }
#pragma unroll
        for (int k = 0; k < 2; ++k) { const int t = t0 + k * C.ngw; const int tt = t < SEQ ? t : 0;
#pragma unroll
            for (int s = 0; s < 4; ++s) { mv[k][s] = (f32x2){-1e30f, 0.f}; pv[k][s][0] = (v4u){0u, 0u, 0u, 0u}; pv[k][s][1] = (v4u){0u, 0u, 0u, 0u};
                if (val[k][s]) { mv[k][s] = *(const f32x2*)(ml + ((size_t)s * SEQ + tt) * (2 * NH) + 2 * h);
                    const bf16* pp = (s == 3 ? part3 : part + (size_t)s * SEQ * AW) + (size_t)tt * AW + h * HD + dc * 16;
                    pv[k][s][0] = __builtin_nontemporal_load((const v4u*)pp); pv[k][s][1] = __builtin_nontemporal_load((const v4u*)(pp + 8)); } } }
#pragma unroll
        for (int k = 0; k < 2; ++k) { const int t = t0 + k * C.ngw;
            float M = -1e30f;
#pragma unroll
            for (int s = 0; s < 4; ++s) M = fmaxf(M, mv[k][s].x);
            float w[4], L = 0.f;
#pragma unroll
            for (int s = 0; s < 4; ++s) { w[s] = mv[k][s].y * exp2f(mv[k][s].x - M); L += w[s]; }
            const float invL = 1.0f / L; float acc[16];
#pragma unroll
            for (int i = 0; i < 16; ++i) acc[i] = 0.f;
#pragma unroll
            for (int s = 0; s < 4; ++s) { float f0[8], f1[8]; pg8::unpack8(pv[k][s][0], f0); pg8::unpack8(pv[k][s][1], f1); const float ws_ = w[s] * invL;
#pragma unroll
                for (int i = 0; i < 8; ++i) { acc[i] += ws_ * f0[i]; acc[8 + i] += ws_ * f1[i]; } }
            if (t < SEQ) { v4u o0, o1; o0.x = pk2(acc[0], acc[1]); o0.y = pk2(acc[2], acc[3]); o0.z = pk2(acc[4], acc[5]); o0.w = pk2(acc[6], acc[7]);
                o1.x = pk2(acc[8], acc[9]); o1.y = pk2(acc[10], acc[11]); o1.z = pk2(acc[12], acc[13]); o1.w = pk2(acc[14], acc[15]);
                bf16* op = ao + (size_t)t * AW + h * HD + dc * 16; *(v4u*)op = o0; *(v4u*)(op + 8) = o1; }
        }
    }
}

__device__ __forceinline__ void p_gate_mfma(const Ctx& C, const Args& a) {
    using moba::f32x16;
    unsigned char* ws = a.ws; const bf16* Q = (const bf16*)(ws + WS_Q); const float* kpart = (const float*)(ws + WS_KPART); unsigned* sel = (unsigned*)(ws + WS_SEL);
    const int lane = C.lane, ql = lane & 31, hf = lane >> 5;
    const bool split = C.G == 256; const int g0 = split ? C.gw - 128 * NWAVES : C.gw, gstep = split ? 128 * NWAVES : C.ngw;
    if (split && C.bid < 128) return;
    for (int it = g0; it < (SEQ / 32) * NH; it += gstep) {
        const int tile = it >> 3, h = it & 7, tq = tile * 32 + ql, own = tile >> 3;
        f32x16 acc;
#pragma unroll
        for (int r = 0; r < 16; ++r) acc[r] = 0.f;
        const bf16* qp = Q + (size_t)tq * AW + h * HD + 8 * hf; const float* kp = kpart + (size_t)ql * 2048 + h * HD + 8 * hf;
#pragma unroll
        for (int s = 0; s < 8; ++s) { const bf16x8 qf = *(const bf16x8*)(qp + 16 * s);
            const f32x4 p0 = *(const f32x4*)(kp + 16 * s), p1 = *(const f32x4*)(kp + 16 * s + 4), r0 = *(const f32x4*)(kp + 1024 + 16 * s), r1 = *(const f32x4*)(kp + 1024 + 16 * s + 4);
            const f32x4 m0 = (p0 + r0) * (1.0f / MBLK), m1 = (p1 + r1) * (1.0f / MBLK);
            const float mm[8] = {m0.x, m0.y, m0.z, m0.w, m1.x, m1.y, m1.z, m1.w}; unsigned hb[8], lb[8];
#pragma unroll
            for (int i = 0; i < 8; ++i) { hb[i] = f2bf(mm[i]); lb[i] = f2bf(mm[i] - __builtin_bit_cast(float, hb[i] << 16)); }
            v4u hw, lw; hw.x = hb[0] | (hb[1] << 16); hw.y = hb[2] | (hb[3] << 16); hw.z = hb[4] | (hb[5] << 16); hw.w = hb[6] | (hb[7] << 16);
            lw.x = lb[0] | (lb[1] << 16); lw.y = lb[2] | (lb[3] << 16); lw.z = lb[4] | (lb[5] << 16); lw.w = lb[6] | (lb[7] << 16);
            acc = __builtin_amdgcn_mfma_f32_32x32x16_bf16(__builtin_bit_cast(bf16x8, hw), qf, acc, 0, 0, 0); acc = __builtin_amdgcn_mfma_f32_32x32x16_bf16(__builtin_bit_cast(bf16x8, lw), qf, acc, 0, 0, 0); }
        float g[16];
#pragma unroll
        for (int r = 0; r < 16; ++r) g[r] = moba::crow(r, hf) < own ? acc[r] : -1e30f;
        unsigned packed = 0;
#pragma unroll
        for (int rd = 0; rd < 3; ++rd) {
            float bv = g[0]; int bi = moba::crow(0, hf);
#pragma unroll
            for (int r = 1; r < 16; ++r) { const int idx = moba::crow(r, hf); if (gate_better(g[r], idx, bv, bi)) { bv = g[r]; bi = idx; } }
            { const float ov = __shfl_xor(bv, 32); const int oi = __shfl_xor(bi, 32); if (gate_better(ov, oi, bv, bi)) { bv = ov; bi = oi; } }
            packed |= (unsigned)bi << (8 * rd);
#pragma unroll
            for (int r = 0; r < 16; ++r) if (moba::crow(r, hf) == bi) g[r] = -3.0e38f;
        }
        if (hf == 0) sel[tq * NH + h] = packed;
    }
}

__device__ __forceinline__ Ctx phase_ctx(const Ctx& C0) { Ctx C = C0; C.lane = lane_id(); asm volatile("" : "+v"(C.lane)); C.tid = C0.wave * 64 + C.lane; C.gw = C.bid * NWAVES + C.wave; return C; }
__device__ __forceinline__ Args phase_args(const Args& a0) { Args a = a0; GAS unsigned char* w = (GAS unsigned char*)a0.ws; asm volatile("" : "+s"(w)); a.ws = (unsigned char*)w; return a; }
#ifndef SKIP_GU
#define SKIP_GU true
#endif
#ifndef SKIP_DN
#define SKIP_DN true
#endif
struct BarRef { const XcdBarrier* b; __device__ __forceinline__ void sync() const { xcd_barrier(*b); } };
__global__ void __launch_bounds__(NTHREADS, 2) mk_fwd(Args args) {
    extern __shared__ __attribute__((aligned(16))) unsigned char lds[];
    Ctx C0; C0.lds = (LAS unsigned char*)lds; C0.tid = threadIdx.x; C0.lane = C0.tid & 63; C0.wave = __builtin_amdgcn_readfirstlane(C0.tid >> 6);
    C0.G = gridDim.x; C0.bid = blockIdx.x; C0.gw = C0.bid * NWAVES + C0.wave; C0.ngw = C0.G * NWAVES;
    LAS unsigned char* ring = C0.lds + RING_OFF;
    for (int u = C0.tid; u < (LDS_BYTES - LDSCTL_OFF) / 4; u += NTHREADS) ((LAS unsigned*)(C0.lds + LDSCTL_OFF))[u] = 0u;
    __syncthreads();
    volatile LAS unsigned* MISC = (volatile LAS unsigned*)(C0.lds + MISC_OFF);
    XcdBarrier bar = xcd_barrier_post((unsigned*)(args.ws + WS_CTL) + CW_BAR, MISC + 8, C0.wave);
#define SEAM() xcd_barrier(bar)
    { const Ctx C = phase_ctx(C0); const Args A = phase_args(args); p0_prologue(C, A); }
    SEAM();
    { const Ctx C = phase_ctx(C0); const Args A = phase_args(args); unsigned char* ws = A.ws;
        const int grp = C.bid >> 3; const bool conv_cu = (C.G == 256) && (grp % 5 == 4);
        if (!conv_cu) {
            const int Gg = C.G == 256 ? 208 : C.G, cg = C.G == 256 ? C.bid - 8 * ((grp + 1) / 5) : C.bid;
            pg8::Gemm g{(const bf16*)(ws + WS_HN), (const bf16*)(ws + WS_WIN), SEQ, NPROJ, DM}; pg8::StaticOrder S; S.init(SEQ, NPROJ, Gg, cg);
            pg8::EpiInProj E{(bf16*)(ws + WS_U), (bf16*)(ws + WS_Q), (bf16*)(ws + WS_K), (bf16*)(ws + WS_V), (bf16*)(ws + WS_SGP), (bf16*)(ws + WS_SGA), (float*)(ws + WS_KPART)};
            pg8::gemm_phase<pg8::EpiInProj, pg8::StaticOrder, true, true>(ring, g, S, E, C.wave);
            conv_tiles<false>(C, A, cg * NWAVES + C.wave);
        } else conv_tiles<true>(C, A, 0);
    }
    SEAM();
    { const Ctx C = phase_ctx(C0); const Args A = phase_args(args); unsigned char* ws = A.ws;
        for (int L = C.bid; L < 128; L += C.G) pool_mixed_tile(C, A, L);
        VM_WAIT(); __syncthreads();
        pg8::Gemm g{(const bf16*)(ws + WS_MIXED), (const bf16*)(ws + WS_WPOOL), 4 * SEQ, 256, 256}; pg8::PoolOrder S{C.G, C.bid};
        pg8::EpiPool E{(bf16*)(ws + WS_YP), A.in[4]};
        pg8::gemm_phase<pg8::EpiPool, pg8::PoolOrder, false, true>(ring, g, S, E, C.wave);
        p_gate_mfma(C, A);
    }
    SEAM();
    { const Ctx C = phase_ctx(C0); const Args A = phase_args(args); p_attn(C, A, 0); }
    SEAM();
    { const Ctx C = phase_ctx(C0); const Args A = phase_args(args); p_combine(C, A); }
    SEAM();
    { const Ctx C = phase_ctx(C0); const Args A = phase_args(args); unsigned char* ws = A.ws;
        pg8::Gemm g{(const bf16*)(ws + WS_YP), (const bf16*)(ws + WS_WBP), 2 * SEQ, 2 * DM, PW}; pg8::BranchOrder S; S.init(C.G, C.bid);
        pg8::EpiBranch E{(const bf16*)(ws + WS_SGP), (bf16*)(ws + WS_TMP), (long)((WS_SGA - WS_SGP) / 2), ((long)WS_HN - (long)WS_TMP) / 2};
        pg8::gemm_phase<pg8::EpiBranch, pg8::BranchOrder, true, true>(ring, g, S, E, C.wave);
    }
    SEAM();
    { const Ctx C = phase_ctx(C0); const Args A = phase_args(args); unsigned char* ws = A.ws;
        pg8::Gemm g{(const bf16*)(ws + WS_HN), (const bf16*)(ws + WS_WOUT), SEQ, DM, DM}; pg8::StaticOrder S; S.init(SEQ, DM, C.G, C.bid);
        pg8::EpiResid E{A.in[0], (bf16*)(ws + WS_X1)};
        pg8::gemm_phase<pg8::EpiResid, pg8::StaticOrder, true, true>(ring, g, S, E, C.wave);
    }
    SEAM();
    { const Ctx C = phase_ctx(C0); const Args A = phase_args(args); BarRef br{&bar}; p_router(C, A, br); }
    SEAM();
    { const Ctx C = phase_ctx(C0); const Args A = phase_args(args); unsigned char* ws = A.ws;
        pg8::Gemm g{(const bf16*)(ws + WS_HN), (const bf16*)(ws + WS_WGU), 0, 0, DM, (const int*)(ws + WS_ROWTOK)}; pg8::MoeOrder S{(const unsigned*)(ws + WS_CTL) + CW_CNT, 0, C.G, C.bid};
        pg8::EpiGU E{(bf16*)(ws + WS_HID), (const float*)(ws + WS_ROWW)};
        pg8::gemm_phase<pg8::EpiGU, pg8::MoeOrder, true, true, false, true>(ring, g, S, E, C.wave);
    }
    SEAM();
    { const Ctx C = phase_ctx(C0); const Args A = phase_args(args); unsigned char* ws = A.ws;
        { pg8::Gemm g{(const bf16*)(ws + WS_HN), (const bf16*)(ws + WS_WGU), 0, 0, DM, (const int*)(ws + WS_ROWTOK)}; pg8::MoeOrder S{(const unsigned*)(ws + WS_CTL) + CW_CNT, 1, C.G, C.bid};
          pg8::EpiGU E{(bf16*)(ws + WS_HID), (const float*)(ws + WS_ROWW)};
          pg8::gemm_phase<pg8::EpiGU, pg8::MoeOrder, true, true, false, true>(ring, g, S, E, C.wave); }
        { pg8::Gemm g{(const bf16*)(ws + WS_HID), (const bf16*)(ws + WS_WDN), 0, 0, DE}; pg8::MoeOrder S{(const unsigned*)(ws + WS_CTL) + CW_CNT, 2, C.G, C.bid};
          pg8::EpiDown E{(bf16*)(ws + WS_Y)};
          pg8::gemm_phase<pg8::EpiDown, pg8::MoeOrder, true, true>(ring, g, S, E, C.wave); }
    }
    SEAM();
    { const Ctx C = phase_ctx(C0); const Args A = phase_args(args); unsigned char* ws = A.ws;
        pg8::Gemm g{(const bf16*)(ws + WS_HID), (const bf16*)(ws + WS_WDN), 0, 0, DE}; pg8::MoeOrder S{(const unsigned*)(ws + WS_CTL) + CW_CNT, 3, C.G, C.bid};
        pg8::EpiDown E{(bf16*)(ws + WS_Y)};
        pg8::gemm_phase<pg8::EpiDown, pg8::MoeOrder, true, true>(ring, g, S, E, C.wave);
    }
    SEAM();
    { const Ctx C = phase_ctx(C0); const Args A = phase_args(args); p8_final(C, A); }
#undef SEAM
}

#ifndef MK_N_LAUNCHES
#define MK_N_LAUNCHES 1
#endif
extern "C" void kernel_launch(void* const* d_in, const int* in_sizes, int n_in, void* d_out, int out_size, void* d_ws, size_t ws_size, hipStream_t stream) {
    static int grid = 0;
    if (grid == 0) {
        if (n_in != 17 || out_size != SEQ * DM || ws_size < WS_END) { fprintf(stderr, "kernel_launch: unexpected shapes (n_in %d out %d ws %zu)\n", n_in, out_size, ws_size); grid = -1; return; }
        int dev = 0, cus = 0, per_cu = 0;
        if (hipGetDevice(&dev) != hipSuccess || hipDeviceGetAttribute(&cus, hipDeviceAttributeMultiprocessorCount, dev) != hipSuccess) { grid = -1; return; }
        if (hipFuncSetAttribute((const void*)mk_fwd, hipFuncAttributeMaxDynamicSharedMemorySize, LDS_BYTES) != hipSuccess) { fprintf(stderr, "kernel_launch: hipFuncSetAttribute failed\n"); grid = -1; return; }
        if (hipOccupancyMaxActiveBlocksPerMultiprocessor(&per_cu, (const void*)mk_fwd, NTHREADS, LDS_BYTES) != hipSuccess || per_cu < 1) { fprintf(stderr, "kernel_launch: occupancy query failed (%d)\n", per_cu); (void)hipGetLastError(); per_cu = 1; }
        if (per_cu > 1) per_cu = 1;
        grid = cus * per_cu;
    }
    if (grid < 0) return;
    (void)hipMemsetAsync((char*)d_ws + WS_CTL, 0, CTL_ZERO_BYTES, stream);
    Args a{};
    for (int i = 0; i < 17; ++i) a.in[i] = (const float*)d_in[i];
    a.out = (float*)d_out; a.ws = (unsigned char*)d_ws;
    if (MK_N_LAUNCHES == 1) {
        a.ph_lo = 0; a.ph_hi = 0; void* kargs[] = {&a};
        hipError_t e = hipLaunchCooperativeKernel((const void*)mk_fwd, dim3(grid), dim3(NTHREADS), kargs, LDS_BYTES, stream);
        if (e != hipSuccess) fprintf(stderr, "kernel_launch: cooperative launch failed: %s (grid %d)\n", hipGetErrorString(e), grid);
    } else {
        fprintf(stderr, "kernel_launch: multi-launch build not supported in this version\n");
    }
}
```

```cpp
#include <hip/hip_runtime.h>
#include <cstdio>
#include <cstdint>

__device__ __forceinline__ int lane_id() { int l; asm volatile("v_mbcnt_lo_u32_b32 %0, -1, 0\n\tv_mbcnt_hi_u32_b32 %0, -1, %0" : "=v"(l)); return l; }
namespace pg8 {
#define PG8_LAS __attribute__((address_space(3)))
typedef unsigned short bf16_t;
typedef short bf16x8 __attribute__((ext_vector_type(8)));
typedef float f32x4 __attribute__((ext_vector_type(4)));
typedef unsigned u32x4 __attribute__((ext_vector_type(4)));
typedef unsigned u32x2 __attribute__((ext_vector_type(2)));
constexpr int BM = 256, BK = 64, HALF = 128, HTB = HALF * BK * 2  , STAGE_BYTES = 8 * HTB, NXCD = 8, WGM = 8;

__host__ __device__ __forceinline__ int lds_byte(int r, int c) { const int st = (r >> 4) * 2 + (c >> 5), rr = r & 15, cc = c & 31, ob = rr * 64 + cc * 2; return st * 1024 + (ob ^ (((ob >> 9) & 1) << 5)); }
__host__ __device__ __forceinline__ void stage_rc(int b, int& R, int& C) { const int st = b / 1024, sb = b % 1024, swz = sb ^ (((sb >> 9) & 1) << 5); R = (st >> 1) * 16 + swz / 64; C = (st & 1) * 32 + (swz % 64) / 2; }
__host__ __device__ __forceinline__ int perm32(int rho) { const int n = rho >> 4, i = rho & 15; return 8 * (i >> 2) + 4 * n + (i & 3); }

struct Unit { int pm, pn, row0, cnt, rows; };
struct Gemm { const bf16_t* A; const bf16_t* Bt; int M, N, K; const int* rowtok; };

struct StaticOrder {
    int nM, nN, nwg, G, c;
    __host__ __device__ void init(int M, int N, int G_, int c_) { nM = M / BM; nN = N / BM; nwg = nM * nN; G = G_; c = c_; }
    __host__ __device__ bool next(int i, Unit& u) const {
        const long L = (long)i * G + c; if (L >= nwg) return false;
        int wgid = (int)L; { const int q = nwg / NXCD, r = nwg % NXCD, xcd = wgid % NXCD, off = wgid / NXCD; wgid = (xcd < r ? xcd * (q + 1) : r * (q + 1) + (xcd - r) * q) + off; }
        const int nig = WGM * nN, gid = wgid / nig, fm = gid * WGM, gsz = (nM - fm) < WGM ? (nM - fm) : WGM;
        u.pm = fm + ((wgid % nig) % gsz); u.pn = (wgid % nig) / gsz; u.row0 = 0; u.cnt = 0; u.rows = 256; return true;
    }
    __device__ __forceinline__ void a_ready(const Unit&) const {}
    __device__ __forceinline__ void done(const Unit&) const {}
};

__device__ __forceinline__ unsigned cvt_pk_bf16(float lo, float hi) { unsigned r; asm volatile("v_cvt_pk_bf16_f32 %0, %1, %2" : "=v"(r) : "v"(lo), "v"(hi)); return r; }

template <class Epi, class Sched, bool ALIGN_EPI = false, bool SP2 = false, bool SKIP = false, bool GATHER = false>
__device__ __forceinline__ void gemm_phase(PG8_LAS unsigned char* lds, const Gemm g, const Sched& S, const Epi& E, int wave_in) {
    int tid_ = wave_in * 64 + lane_id(); asm volatile("" : "+v"(tid_));
    const int tid = tid_, wid = __builtin_amdgcn_readfirstlane(tid >> 6), lane = tid & 63, wr = wid >> 2, wc = wid & 3, fr = lane & 15, fq = lane >> 4;
    const int K = g.K, nt = K / BK;
    unsigned voffA[2], voffB[2];
#pragma unroll
    for (int i = 0; i < 2; ++i) { int R, C; stage_rc(tid * 16 + i * 8192, R, C); const int Rb = Epi::PERM ? ((R & ~31) + perm32(R & 31)) : R;
        voffA[i] = (unsigned)(R * K + C) * 2u; voffB[i] = (unsigned)(Rb * K + C) * 2u; }
    unsigned gvp[2];
    PG8_LAS unsigned* gtab = (PG8_LAS unsigned*)(lds + STAGE_BYTES);
    auto gather_toks = [&](const Unit& u, unsigned (&o)[2]) {
#pragma unroll
        for (int h = 0; h < 2; ++h) { unsigned tk_[2];
#pragma unroll
            for (int i = 0; i < 2; ++i) { int R, C; stage_rc(tid * 16 + i * 8192, R, C); const int slot = u.pm * BM - u.row0 + h * HALF + R;
                tk_[i] = slot < u.cnt ? (unsigned)g.rowtok[(u.pn >> 3) * 8192 + slot] : 0u; }
            o[h] = tk_[0] | (tk_[1] << 16); } };
    auto gather_off = [&](unsigned packed, int i) -> unsigned { int R, C; stage_rc(tid * 16 + i * 8192, R, C); const unsigned tok = i ? (packed >> 16) : (packed & 0xffffu); return (tok * (unsigned)K + (unsigned)C) * 2u; };
    const size_t kstep = (size_t)(BK * 2);
    const size_t hstep = (size_t)HALF * K * 2;
    const size_t tstep = 2 * hstep;
    const unsigned ldsw = (unsigned)wid * 1024u;
    const int aoff = lds_byte(wr * 64 + fr, fq * 8), boff = lds_byte(wc * 32 + fr, fq * 8);
#define PG8_SA(b, h) (((b) * 2 + (h)) * HTB)
#define PG8_SB(b, h) ((4 + (b) * 2 + (h)) * HTB)
#define PG8_STAGE(bufoff, gbase, voff) do { _Pragma("unroll") for (int _i = 0; _i < 2; ++_i) \
        __builtin_amdgcn_global_load_lds((const unsigned*)((const char*)(gbase) + (voff)[_i]), (PG8_LAS unsigned*)(lds + (bufoff) + ldsw + _i * 8192), 16, 0, 0); } while (0)
#define PG8_LDA(dst, b, h) do { _Pragma("unroll") for (int m = 0; m < 4; ++m) _Pragma("unroll") for (int k = 0; k < 2; ++k) dst[m][k] = *(const PG8_LAS bf16x8*)(lds + PG8_SA(b, h) + aoff + m * 2048 + k * 1024); } while (0)
#define PG8_LDB(dst, b, h) do { _Pragma("unroll") for (int n = 0; n < 2; ++n) _Pragma("unroll") for (int k = 0; k < 2; ++k) dst[n][k] = *(const PG8_LAS bf16x8*)(lds + PG8_SB(b, h) + boff + n * 2048 + k * 1024); } while (0)
#define PG8_MMA(ai, bj, At, Bt) do { __builtin_amdgcn_s_setprio(1); _Pragma("unroll") for (int m = 0; m < 4; ++m) { if (!SKIP || (ai) * 128 + wr * 64 + m * 16 < vrows) { _Pragma("unroll") for (int n = 0; n < 2; ++n) _Pragma("unroll") for (int k = 0; k < 2; ++k) \
        acc[ai][bj][m][n] = __builtin_amdgcn_mfma_f32_16x16x32_bf16(Bt[n][k], At[m][k], acc[ai][bj][m][n], 0, 0, 0); } } __builtin_amdgcn_s_setprio(0); } while (0)
#define PG8_WAIT_V(n) asm volatile("s_waitcnt vmcnt(" #n ")" ::: "memory")
#define PG8_WAIT_L(n) asm volatile("s_waitcnt lgkmcnt(" #n ")" ::: "memory")
#define PG8_BAR __builtin_amdgcn_s_barrier()
#define PG8_SCHED __builtin_amdgcn_sched_barrier(0)
    Unit cur, nxt; int ui = 0;
    if (!S.next(0, cur)) return;
    int vrows = cur.rows;
    f32x4 acc[2][2][4][2];
#pragma unroll
    for (int a = 0; a < 2; ++a)
#pragma unroll
        for (int b = 0; b < 2; ++b)
#pragma unroll
            for (int m = 0; m < 4; ++m)
#pragma unroll
                for (int n = 0; n < 2; ++n) acc[a][b][m][n] = (f32x4){0.f, 0.f, 0.f, 0.f};
    bf16x8 At[4][2], B0[2][2], B1[2][2];
    const char* cA = (const char*)g.A + (GATHER ? (size_t)0 : (size_t)cur.pm * tstep); const char* cB = (const char*)g.Bt + (size_t)cur.pn * tstep;
    if constexpr (GATHER) gather_toks(cur, gvp);
#define PG8_STAGE_A(bufoff, ptr, half, nextu) do { if constexpr (!GATHER) { PG8_STAGE(bufoff, (ptr) + ((half) ? hstep : 0), voffA); } else { \
        const unsigned p_ = (nextu) ? gtab[(half) * 512 + tid] : gvp[half]; unsigned o_[2]; o_[0] = gather_off(p_, 0); o_[1] = gather_off(p_, 1); PG8_STAGE(bufoff, ptr, o_); } } while (0)
    S.a_ready(cur);
    if constexpr (SP2) {
        PG8_STAGE(PG8_SB(0, 0), cB, voffB); PG8_STAGE(PG8_SB(0, 1), cB + hstep, voffB); PG8_STAGE_A(PG8_SA(0, 0), cA, 0, false); PG8_STAGE_A(PG8_SA(0, 1), cA, 1, false);
        if (wr == 1) PG8_BAR;
        PG8_WAIT_V(2); PG8_BAR;
        PG8_STAGE(PG8_SB(1, 0), cB + kstep, voffB); PG8_STAGE_A(PG8_SA(1, 0), cA + kstep, 0, false); PG8_STAGE(PG8_SB(1, 1), cB + hstep + kstep, voffB);
        PG8_WAIT_V(6); PG8_BAR;
    } else {
        PG8_STAGE(PG8_SB(0, 0), cB, voffB); PG8_STAGE(PG8_SA(0, 0), cA, voffA); PG8_STAGE(PG8_SB(0, 1), cB + hstep, voffB); PG8_STAGE(PG8_SA(0, 1), cA + hstep, voffA);
        if (wr == 1) PG8_BAR;
        PG8_WAIT_V(4); PG8_BAR;
        PG8_STAGE(PG8_SB(1, 0), cB + kstep, voffB); PG8_STAGE(PG8_SA(1, 0), cA + kstep, voffA); PG8_STAGE(PG8_SB(1, 1), cB + hstep + kstep, voffB);
        PG8_WAIT_V(6); PG8_BAR;
    }
    for (;;) {
        const bool has_next = S.next(ui + 1, nxt);
        const char* nA = (has_next && !GATHER) ? (const char*)g.A + (size_t)nxt.pm * tstep : cA;
        if constexpr (GATHER) { unsigned o_[2] = {gvp[0], gvp[1]}; if (has_next) gather_toks(nxt, o_); gtab[tid] = o_[0]; gtab[512 + tid] = o_[1]; } const char* nB = has_next ? (const char*)g.Bt + (size_t)nxt.pn * tstep : cB;
        for (int t = 0; t < nt; t += 2) {
            const bool last = (t == nt - 2);
            const char* a1 = cA + (size_t)(t + 1) * kstep;
            const char* a2 = last ? nA : cA + (size_t)(t + 2) * kstep; const char* b2 = last ? nB : cB + (size_t)(t + 2) * kstep;
            const char* a3 = a2 + kstep; const char* b3 = b2 + kstep;
            if (last && has_next) S.a_ready(nxt);
            if constexpr (SP2) {
            PG8_LDB(B0, 0, 0); PG8_LDB(B1, 0, 1); PG8_SCHED; PG8_LDA(At, 0, 0); PG8_STAGE_A(PG8_SA(1, 1), a1, 1, false);
            PG8_WAIT_V(8); PG8_WAIT_L(0); PG8_BAR; PG8_MMA(0, 0, At, B0); PG8_MMA(0, 1, At, B1); PG8_BAR; PG8_SCHED;
            PG8_LDA(At, 0, 1); PG8_STAGE(PG8_SB(0, 0), b2, voffB); PG8_STAGE(PG8_SB(0, 1), b2 + hstep, voffB); PG8_STAGE_A(PG8_SA(0, 0), a2, 0, last);
            PG8_WAIT_V(8); PG8_WAIT_L(0); PG8_BAR; PG8_MMA(1, 0, At, B0); PG8_MMA(1, 1, At, B1); PG8_BAR; PG8_SCHED;
            PG8_LDB(B0, 1, 0); PG8_LDB(B1, 1, 1); PG8_SCHED; PG8_LDA(At, 1, 0); PG8_STAGE_A(PG8_SA(0, 1), a2, 1, last);
            PG8_WAIT_V(8); PG8_WAIT_L(0); PG8_BAR; PG8_MMA(0, 0, At, B0); PG8_MMA(0, 1, At, B1); PG8_BAR; PG8_SCHED;
            PG8_LDA(At, 1, 1); PG8_STAGE(PG8_SB(1, 0), b3, voffB); PG8_STAGE(PG8_SB(1, 1), b3 + hstep, voffB); PG8_STAGE_A(PG8_SA(1, 0), a3, 0, last);
            PG8_WAIT_V(8); PG8_WAIT_L(0); PG8_BAR; PG8_MMA(1, 0, At, B0); PG8_MMA(1, 1, At, B1); PG8_BAR; PG8_SCHED;
            } else {
            PG8_LDB(B0, 0, 0); PG8_SCHED; PG8_LDA(At, 0, 0); PG8_STAGE(PG8_SA(1, 1), a1 + hstep, voffA);
            PG8_WAIT_L(8); PG8_BAR; PG8_WAIT_L(0); PG8_MMA(0, 0, At, B0); PG8_BAR; PG8_SCHED;
            PG8_LDB(B1, 0, 1); PG8_STAGE(PG8_SB(0, 0), b2, voffB);
            PG8_BAR; PG8_WAIT_L(0); PG8_MMA(0, 1, At, B1); PG8_BAR;
            PG8_LDA(At, 0, 1); PG8_STAGE(PG8_SA(0, 0), a2, voffA);
            PG8_BAR; PG8_WAIT_L(0); PG8_MMA(1, 0, At, B0); PG8_BAR; PG8_SCHED;
            PG8_STAGE(PG8_SB(0, 1), b2 + hstep, voffB);
            PG8_WAIT_V(6); PG8_BAR; PG8_MMA(1, 1, At, B1); PG8_BAR;
            PG8_LDB(B0, 1, 0); PG8_SCHED; PG8_LDA(At, 1, 0); PG8_STAGE(PG8_SA(0, 1), a2 + hstep, voffA);
            PG8_WAIT_L(8); PG8_BAR; PG8_WAIT_L(0); PG8_MMA(0, 0, At, B0); PG8_BAR; PG8_SCHED;
            PG8_LDB(B1, 1, 1); PG8_STAGE(PG8_SB(1, 0), b3, voffB);
            PG8_BAR; PG8_WAIT_L(0); PG8_MMA(0, 1, At, B1); PG8_BAR;
            PG8_LDA(At, 1, 1); PG8_STAGE(PG8_SA(1, 0), a3, voffA);
            PG8_BAR; PG8_WAIT_L(0); PG8_MMA(1, 0, At, B0); PG8_BAR; PG8_SCHED;
            PG8_STAGE(PG8_SB(1, 1), b3 + hstep, voffB);
            PG8_WAIT_V(6); PG8_BAR; PG8_MMA(1, 1, At, B1); PG8_BAR;
            }
        }
        if constexpr (ALIGN_EPI) { if (wr == 0) PG8_BAR; }
        if constexpr (!Epi::AFTER_DRAIN) { E(acc, cur, wr, wc, fr, fq); S.done(cur); }
        if (!has_next) break;
#pragma unroll
        for (int a = 0; a < 2; ++a)
#pragma unroll
            for (int b = 0; b < 2; ++b)
#pragma unroll
                for (int m = 0; m < 4; ++m)
#pragma unroll
                    for (int n = 0; n < 2; ++n) acc[a][b][m][n] = (f32x4){0.f, 0.f, 0.f, 0.f};
        cur = nxt; cA = nA; cB = nB; ++ui; vrows = cur.rows;
        if constexpr (GATHER) { gvp[0] = gtab[tid]; gvp[1] = gtab[512 + tid]; }
        if constexpr (ALIGN_EPI) { if (wr == 1) PG8_BAR; }
    }
    PG8_WAIT_V(0);
    if constexpr (!ALIGN_EPI) { if (wr == 0) PG8_BAR; }
    PG8_BAR;
    if constexpr (Epi::AFTER_DRAIN) { E.fused(acc, cur, wr, wc, fr, fq, lds, wid, lane); S.done(cur); }
#undef PG8_STAGE_A
#undef PG8_SA
#undef PG8_SB
#undef PG8_STAGE
#undef PG8_LDA
#undef PG8_LDB
#undef PG8_MMA
#undef PG8_WAIT_V
#undef PG8_WAIT_L
#undef PG8_BAR
#undef PG8_SCHED
}
}

constexpr int SEQ = 8192, DM = 2048, NPROJ = 8192, PW = 1024, AW = 1024, NH = 8, HD = 128, MBLK = 256, NBLK = 32;
constexpr int NE = 16, DE = 1024, ECAP = 8192;
constexpr float RMS_EPS = 1e-6f;
constexpr int NWAVES = 8, NTHREADS = 512;

#define GAS __attribute__((address_space(1)))
#define LAS __attribute__((address_space(3)))
typedef unsigned short bf16;
typedef unsigned v4u __attribute__((ext_vector_type(4)));
typedef unsigned v2u __attribute__((ext_vector_type(2)));
typedef float f32x4 __attribute__((ext_vector_type(4)));
typedef float f32x2 __attribute__((ext_vector_type(2)));
typedef short bf16x8 __attribute__((ext_vector_type(8)));
typedef GAS unsigned gu32;
#define RLX_AGENT __ATOMIC_RELAXED, __HIP_MEMORY_SCOPE_AGENT
#define LDS_WAIT() asm volatile("s_waitcnt lgkmcnt(0)" ::: "memory")
#define VM_WAIT() asm volatile("s_waitcnt vmcnt(0)" ::: "memory")
__device__ __forceinline__ unsigned f2bf(float f) { unsigned u = __builtin_bit_cast(unsigned, f); return (u + 0x7fffu + ((u >> 16) & 1u)) >> 16; }
__device__ __forceinline__ unsigned pk2(float lo, float hi) { unsigned r; asm("v_cvt_pk_bf16_f32 %0, %1, %2" : "=v"(r) : "v"(lo), "v"(hi)); return r; }
__device__ __forceinline__ float bf_lo(unsigned w) { return __builtin_bit_cast(float, w << 16); }
__device__ __forceinline__ float bf_hi(unsigned w) { return __builtin_bit_cast(float, w & 0xffff0000u); }
__device__ __forceinline__ float bf2f(bf16 b) { return __builtin_bit_cast(float, (unsigned)b << 16); }
__device__ __forceinline__ float shx(float v, int o, int lane) { return __builtin_bit_cast(float, __builtin_amdgcn_ds_bpermute((lane ^ o) << 2, __builtin_bit_cast(int, v))); }
__device__ __forceinline__ float wave_sum(float v) {
    const int l = lane_id();
#pragma unroll
    for (int o = 1; o < 64; o <<= 1) v += shx(v, o, l);
    return v;
}
__device__ __forceinline__ float wave_max(float v) {
    const int l = lane_id();
#pragma unroll
    for (int o = 1; o < 64; o <<= 1) v = fmaxf(v, shx(v, o, l));
    return v;
}
__device__ __forceinline__ float sigmoidf_(float x) { return __builtin_amdgcn_rcpf(1.0f + __expf(-x)); }

constexpr size_t MiB = 1u << 20;
constexpr size_t WS_CTL = 0, CTL_ZERO_BYTES = 128 * 1024;
constexpr size_t WS_TOKE = 1 * MiB;
constexpr size_t WS_TOKS = WS_TOKE + 65536;
constexpr size_t WS_ROWTOK = WS_TOKS + 65536;
constexpr size_t WS_ROWW = WS_ROWTOK + 524288;
constexpr size_t WS_SEL = 3 * MiB;
constexpr size_t WS_KMEAN = WS_SEL + 262144;
constexpr size_t WS_KMH = WS_KMEAN + 131072, WS_KML = WS_KMH + 65536;
constexpr size_t WS_KPART = WS_KML + 65536;
constexpr size_t WS_WIN = 4 * MiB, WS_WPOOL = 36 * MiB, WS_WBP = 37 * MiB, WS_WBA = 41 * MiB, WS_WOUT = 45 * MiB, WS_WGU = 53 * MiB, WS_WDN = 181 * MiB;
constexpr size_t WS_HN = 245 * MiB;
constexpr size_t WS_U = 277 * MiB, WS_Q = 293 * MiB, WS_K = 309 * MiB, WS_V = 325 * MiB, WS_SGP = 341 * MiB, WS_SGA = 373 * MiB;
constexpr size_t WS_YP = 405 * MiB, WS_AO = 421 * MiB, WS_MIXED = 437 * MiB, WS_PART = 453 * MiB;
constexpr size_t WS_PART3 = 245 * MiB, WS_ML = 261 * MiB;
constexpr size_t WS_TMP = 437 * MiB;
constexpr size_t WS_X1 = 293 * MiB;
constexpr size_t WS_H2P = 277 * MiB, WS_HID = 357 * MiB, WS_Y = 397 * MiB, WS_END = 502 * MiB;
constexpr int CW_BAR = 4096;
constexpr int CW_ATTN = 8192;
constexpr int CW_CONV = 8192 + 512;
constexpr int CW_MOEQ = 8192 + 1024;
constexpr int CW_CNT = 16384;

namespace pg8 {
struct EpiInProj {
    static constexpr bool PERM = true, AFTER_DRAIN = false;
    bf16_t *u, *q, *k, *v, *sgp, *sga; float* kpart;
    __device__ __forceinline__ void operator()(const f32x4 (&acc)[2][2][4][2], const Unit& un, int wr, int wc, int fr, int fq) const {
        if (un.pn >= 8 && un.pn < 12) {
#pragma unroll
            for (int bj = 0; bj < 2; ++bj)
#pragma unroll
                for (int n = 0; n < 2; ++n) { f32x4 s = acc[0][bj][0][n];
#pragma unroll
                    for (int m = 1; m < 4; ++m) s += acc[0][bj][m][n];
#pragma unroll
                    for (int m = 0; m < 4; ++m) s += acc[1][bj][m][n];
#pragma unroll
                    for (int o = 1; o < 16; o <<= 1) { s.x += __shfl_xor(s.x, o); s.y += __shfl_xor(s.y, o); s.z += __shfl_xor(s.z, o); s.w += __shfl_xor(s.w, o); }
                    if (fr == 0) *(f32x4*)(kpart + (size_t)(un.pm * 2 + wr) * 1024 + (un.pn - 8) * 256 + bj * HALF + wc * 32 + 8 * fq + 4 * n) = s; }
        }
        const int pn = un.pn; bf16_t* base; int ldc, colt; const bool sig = pn >= 16;
        if (pn < 16) { base = pn < 4 ? u : pn < 8 ? q : pn < 12 ? k : v; ldc = 1024; colt = (pn & 3) * 256; }
        else { base = pn < 24 ? sgp : sga; ldc = 2048; colt = (pn & 7) * 256; }
        const int row0 = un.pm * BM + wr * 64 + fr, col0 = colt + wc * 32 + 8 * fq;
#pragma unroll
        for (int ai = 0; ai < 2; ++ai)
#pragma unroll
            for (int m = 0; m < 4; ++m) { bf16_t* rowp = base + (size_t)(row0 + ai * HALF + m * 16) * ldc + col0;
#pragma unroll
                for (int bj = 0; bj < 2; ++bj) { f32x4 v0 = acc[ai][bj][m][0], v1 = acc[ai][bj][m][1];
                    if (sig) {
#pragma unroll
                        for (int i = 0; i < 4; ++i) { v0[i] = __builtin_amdgcn_rcpf(1.0f + __expf(-v0[i])); v1[i] = __builtin_amdgcn_rcpf(1.0f + __expf(-v1[i])); } }
                    u32x4 w; w.x = cvt_pk_bf16(v0[0], v0[1]); w.y = cvt_pk_bf16(v0[2], v0[3]); w.z = cvt_pk_bf16(v1[0], v1[1]); w.w = cvt_pk_bf16(v1[2], v1[3]);
                    *(u32x4*)(rowp + bj * HALF) = w; } }
    }
};
struct EpiPool {
    static constexpr bool PERM = true, AFTER_DRAIN = false;
    bf16_t* yp; const float* scale;
    __device__ __forceinline__ void operator()(const f32x4 (&acc)[2][2][4][2], const Unit& un, int wr, int wc, int fr, int fq) const {
        const int g = un.pn, row0 = (un.pm & 31) * BM + wr * 64 + fr, col0 = g * 256 + wc * 32 + 8 * fq;
#pragma unroll
        for (int bj = 0; bj < 2; ++bj) { const f32x4 s0 = *(const f32x4*)(scale + col0 + bj * HALF), s1 = *(const f32x4*)(scale + col0 + bj * HALF + 4);
#pragma unroll
            for (int ai = 0; ai < 2; ++ai)
#pragma unroll
                for (int m = 0; m < 4; ++m) { bf16_t* rowp = yp + (size_t)(row0 + ai * HALF + m * 16) * 1024 + col0 + bj * HALF;
                    const f32x4 v0 = acc[ai][bj][m][0] * s0, v1 = acc[ai][bj][m][1] * s1;
                    u32x4 w; w.x = cvt_pk_bf16(v0[0], v0[1]); w.y = cvt_pk_bf16(v0[2], v0[3]); w.z = cvt_pk_bf16(v1[0], v1[1]); w.w = cvt_pk_bf16(v1[2], v1[3]);
                    *(u32x4*)rowp = w; } }
    }
};
__device__ __forceinline__ void unpack8(const u32x4 w, float (&f)[8]) {
    f[0] = __builtin_bit_cast(float, w.x << 16); f[1] = __builtin_bit_cast(float, w.x & 0xffff0000u);
    f[2] = __builtin_bit_cast(float, w.y << 16); f[3] = __builtin_bit_cast(float, w.y & 0xffff0000u);
    f[4] = __builtin_bit_cast(float, w.z << 16); f[5] = __builtin_bit_cast(float, w.z & 0xffff0000u);
    f[6] = __builtin_bit_cast(float, w.w << 16); f[7] = __builtin_bit_cast(float, w.w & 0xffff0000u);
}
struct EpiBranch {
    static constexpr bool PERM = true, AFTER_DRAIN = false;
    const bf16_t* sgp; bf16_t* tmp; long sg_step, out_step;
    __device__ __forceinline__ void operator()(const f32x4 (&acc)[2][2][4][2], const Unit& un, int wr, int wc, int fr, int fq) const {
        const bool second = un.pm >= 32; const int pm = second ? un.pm - 32 : un.pm, pn = second ? un.pn - 8 : un.pn;
        const bf16_t* sg = sgp + (second ? sg_step : 0); bf16_t* outp = tmp + (second ? out_step : 0);
        const int row0 = pm * BM + wr * 64 + fr, col0 = pn * BM + wc * 32 + 8 * fq;
#pragma unroll
        for (int ai = 0; ai < 2; ++ai) { u32x4 gv[4][2], tv[4][2];
#pragma unroll
            for (int m = 0; m < 4; ++m)
#pragma unroll
                for (int bj = 0; bj < 2; ++bj) gv[m][bj] = *(const u32x4*)(sg + (size_t)(row0 + ai * HALF + m * 16) * 2048 + col0 + bj * HALF);
            if (second) {
#pragma unroll
                for (int m = 0; m < 4; ++m)
#pragma unroll
                    for (int bj = 0; bj < 2; ++bj) tv[m][bj] = *(const u32x4*)(tmp + (size_t)(row0 + ai * HALF + m * 16) * 2048 + col0 + bj * HALF);
            } else {
#pragma unroll
                for (int m = 0; m < 4; ++m)
#pragma unroll
                    for (int bj = 0; bj < 2; ++bj) tv[m][bj] = u32x4{0u, 0u, 0u, 0u};
            }
#pragma unroll
            for (int m = 0; m < 4; ++m)
#pragma unroll
                for (int bj = 0; bj < 2; ++bj) { float g[8], t[8]; unpack8(gv[m][bj], g); unpack8(tv[m][bj], t);
                    const f32x4 a0 = acc[ai][bj][m][0], a1 = acc[ai][bj][m][1];
                    const float r[8] = {a0[0] * g[0] + t[0], a0[1] * g[1] + t[1], a0[2] * g[2] + t[2], a0[3] * g[3] + t[3], a1[0] * g[4] + t[4], a1[1] * g[5] + t[5], a1[2] * g[6] + t[6], a1[3] * g[7] + t[7]};
                    u32x4 w; w.x = cvt_pk_bf16(r[0], r[1]); w.y = cvt_pk_bf16(r[2], r[3]); w.z = cvt_pk_bf16(r[4], r[5]); w.w = cvt_pk_bf16(r[6], r[7]);
                    *(u32x4*)(outp + (size_t)(row0 + ai * HALF + m * 16) * 2048 + col0 + bj * HALF) = w; } }
    }
};
struct BranchOrder {
    StaticOrder so; int nc;
    __device__ __forceinline__ void init(int G, int c) { so.init(8192, 2048, G, c); nc = c < so.nwg ? (so.nwg - 1 - c) / G + 1 : 0; }
    __device__ __forceinline__ bool next(int i, Unit& u) const {
        if (i >= 2 * nc) return false; const bool second = i >= nc; (void)so.next(second ? i - nc : i, u); if (second) { u.pm += 32; u.pn += 8; } return true; }
    __device__ __forceinline__ void a_ready(const Unit&) const {}
    __device__ __forceinline__ void done(const Unit&) const {}
};
struct EpiResid {
    static constexpr bool PERM = true, AFTER_DRAIN = false;
    const float* x; bf16_t* x1;
    __device__ __forceinline__ void operator()(const f32x4 (&acc)[2][2][4][2], const Unit& un, int wr, int wc, int fr, int fq) const {
        const int row0 = un.pm * BM + wr * 64 + fr, col0 = un.pn * BM + wc * 32 + 8 * fq;
#pragma unroll
        for (int ai = 0; ai < 2; ++ai) { f32x4 xv[4][2][2];
#pragma unroll
            for (int m = 0; m < 4; ++m)
#pragma unroll
                for (int bj = 0; bj < 2; ++bj)
#pragma unroll
                    for (int n = 0; n < 2; ++n) xv[m][bj][n] = *(const f32x4*)(x + (size_t)(row0 + ai * HALF + m * 16) * 2048 + col0 + bj * HALF + n * 4);
#pragma unroll
            for (int m = 0; m < 4; ++m)
#pragma unroll
                for (int bj = 0; bj < 2; ++bj) { const f32x4 v0 = xv[m][bj][0] + acc[ai][bj][m][0], v1 = xv[m][bj][1] + acc[ai][bj][m][1];
                    u32x4 w; w.x = cvt_pk_bf16(v0[0], v0[1]); w.y = cvt_pk_bf16(v0[2], v0[3]); w.z = cvt_pk_bf16(v1[0], v1[1]); w.w = cvt_pk_bf16(v1[2], v1[3]);
                    *(u32x4*)(x1 + (size_t)(row0 + ai * HALF + m * 16) * 2048 + col0 + bj * HALF) = w; } }
    }
};
struct EpiGU {
    static constexpr bool PERM = false, AFTER_DRAIN = false;
    bf16_t* hid; const float* roww;
    __device__ __forceinline__ void operator()(const f32x4 (&acc)[2][2][4][2], const Unit& un, int wr, int wc, int fr, int fq) const {
        const int e = un.pn >> 3, pnl = un.pn & 7; const int row0 = un.pm * BM + wr * 64 + fr, col0 = pnl * 128 + wc * 16 + 4 * fq;
        float wv[2][4];
#pragma unroll
        for (int ai = 0; ai < 2; ++ai)
#pragma unroll
            for (int m = 0; m < 4; ++m) { const int slot = row0 + ai * HALF + m * 16 - un.row0; wv[ai][m] = slot < un.cnt ? roww[e * ECAP + slot] : 0.f; }
#pragma unroll
        for (int ai = 0; ai < 2; ++ai)
#pragma unroll
            for (int m = 0; m < 4; ++m) { const int row = row0 + ai * HALF + m * 16; const float w = wv[ai][m];
#pragma unroll
                for (int bj = 0; bj < 2; ++bj) { const f32x4 a = acc[ai][bj][m][0], uu = acc[ai][bj][m][1]; float h[4];
#pragma unroll
                    for (int i = 0; i < 4; ++i) h[i] = a[i] * __builtin_amdgcn_rcpf(1.0f + __expf(-a[i])) * uu[i] * w;
                    u32x2 o; o.x = cvt_pk_bf16(h[0], h[1]); o.y = cvt_pk_bf16(h[2], h[3]);
                    *(u32x2*)(hid + (size_t)row * DE_ + col0 + bj * 64) = o; } }
    }
    static constexpr int DE_ = 1024;
};
struct EpiDown {
    static constexpr bool PERM = true, AFTER_DRAIN = false;
    bf16_t* y;
    __device__ __forceinline__ void operator()(const f32x4 (&acc)[2][2][4][2], const Unit& un, int wr, int wc, int fr, int fq) const {
        const int pnl = un.pn & 7; const int row0 = un.pm * BM + wr * 64 + fr, col0 = pnl * 256 + wc * 32 + 8 * fq;
#pragma unroll
        for (int ai = 0; ai < 2; ++ai)
#pragma unroll
            for (int m = 0; m < 4; ++m) { bf16_t* rowp = y + (size_t)(row0 + ai * HALF + m * 16) * 2048 + col0;
#pragma unroll
                for (int bj = 0; bj < 2; ++bj) { const f32x4 v0 = acc[ai][bj][m][0], v1 = acc[ai][bj][m][1];
                    u32x4 w; w.x = cvt_pk_bf16(v0[0], v0[1]); w.y = cvt_pk_bf16(v0[2], v0[3]); w.z = cvt_pk_bf16(v1[0], v1[1]); w.w = cvt_pk_bf16(v1[2], v1[3]);
                    *(u32x4*)(rowp + bj * HALF) = w; } }
    }
};
struct PoolOrder {
    int G, c;
    __device__ __forceinline__ bool next(int i, Unit& u) const { const int L = i * G + c; if (L >= 128) return false; u.pm = L; u.pn = L >> 5; u.row0 = 0; u.cnt = 0; u.rows = 256; return true; }
    __device__ __forceinline__ void a_ready(const Unit&) const {}
    __device__ __forceinline__ void done(const Unit&) const {}
};
struct MoeOrder {
    const unsigned* cnt; int mode, G, c;
    __device__ __forceinline__ bool next(int i, Unit& u) const {
        const int lane = lane_id();
        unsigned cv = 0; if (lane < NE_) cv = __hip_atomic_load(cnt + 64 * lane, __ATOMIC_RELAXED, __HIP_MEMORY_SCOPE_AGENT);
        const int tiles = (int)((cv + 255u) >> 8); int incl = tiles;
#pragma unroll
        for (int o = 1; o < 16; o <<= 1) { const int t = __shfl_up(incl, o); if (lane >= o) incl += t; }
        const int Ttot = __shfl(incl, 15); int L = -1;
        if (G == 256 && Ttot >= 64) {
            const int n3 = 8 * (Ttot - 64), Gp = G - n3;
            if (mode == 0) { const int l = i * G + c; if (l < 512) L = l; }
            else if (mode == 1) { if (i == 0 && c < n3) L = 512 + c; }
            else if (mode == 2) { if (c >= n3 && i < 2) L = i * Gp + (c - n3); }
            else { const int r = i * G + c; if (r < 3 * n3) L = r < 2 * n3 ? 2 * Gp + r : 512 + (r - 2 * n3); }
        } else {
            if (mode == 0 || mode == 3) { const int l = i * G + c; if (l < 8 * Ttot) L = l; }
        }
        if (L < 0) return false;
        const int T = L >> 3;
        const int e = __popcll(__ballot(lane < NE_ && incl <= T));
        u.pm = __builtin_amdgcn_readfirstlane(T); u.pn = __builtin_amdgcn_readfirstlane(e * 8 + (L & 7)); u.row0 = __builtin_amdgcn_readfirstlane(__shfl(incl - tiles, e) * 256);
        u.cnt = __builtin_amdgcn_readfirstlane((int)__shfl((int)cv, e)); u.rows = 256; return true;
    }
    __device__ __forceinline__ void a_ready(const Unit&) const {}
    __device__ __forceinline__ void done(const Unit&) const {}
    static constexpr int NE_ = 16;
};
}

#define XB_TMO      128
#define XB_XCNT(j)  (256  + 64 * (j))
#define XB_XSUB(j)  (1280 + 64 * (j))
#define XB_XGEN(j)  (2304 + 64 * (j))
#define XB_TOP      3328
#define XB_TOPGEN   3392
#define XCD_BAR_WORDS 3456
#define XB_SPIN_CAP (1u << 18)

__device__ __forceinline__ unsigned xb_ld(unsigned* p)              { return __hip_atomic_load(p, __ATOMIC_RELAXED, __HIP_MEMORY_SCOPE_AGENT); }
__device__ __forceinline__ unsigned xb_add(unsigned* p, unsigned v) { return __hip_atomic_fetch_add(p, v, __ATOMIC_RELAXED, __HIP_MEMORY_SCOPE_AGENT); }
__device__ __forceinline__ unsigned xb_xcc_id() { return (unsigned)__builtin_amdgcn_s_getreg((3 << 11) | 20) & 0xFu; }
#define XB_SPIN(cond, bar) do { unsigned _sp = 0; while (cond) { __builtin_amdgcn_s_sleep(1); \
    if ((++_sp & 255u) == 0u) { if (xb_ld(&(bar)[XB_TMO])) break; if (_sp > XB_SPIN_CAP) { atomicAdd(&(bar)[XB_TMO], 1u); break; } } } } while (0)

struct XcdBarrier {
    int wave;
    unsigned* bar; unsigned x;
    volatile LAS unsigned* st;
};

__device__ __forceinline__ XcdBarrier xcd_barrier_post(unsigned* bar, volatile LAS unsigned* st, int wave) {
    XcdBarrier b; b.wave = wave; b.bar = bar; b.x = xb_xcc_id(); b.st = st;
    if (b.wave == 0 && lane_id() == 0) (void)xb_add(&bar[XB_XCNT(b.x)], 1u);
    return b;
}
__device__ __forceinline__ void xcd_barrier_complete(unsigned* bar, unsigned x, unsigned& nloc, unsigned& nx) {
    const unsigned G = gridDim.x * gridDim.y * gridDim.z;
    unsigned sum, cnt, mine, sp = 0u;
    for (;;) {
        sum = 0u; cnt = 0u; mine = 0u;
#pragma unroll
        for (unsigned j = 0; j < 16; ++j) { const unsigned c = xb_ld(&bar[XB_XCNT(j)]); sum += c; cnt += (c > 0u) ? 1u : 0u; mine = (j == x) ? c : mine; }
        if (sum == G) break;
        __builtin_amdgcn_s_sleep(1);
        if ((++sp & 255u) == 0u) { if (xb_ld(&bar[XB_TMO])) break; if (sp > XB_SPIN_CAP) { atomicAdd(&bar[XB_TMO], 1u); break; } }
    }
    nloc = mine > 0u ? mine : 1u; nx = cnt > 0u ? cnt : 1u;
}

__device__ __forceinline__ void xcd_barrier(const XcdBarrier& b) {
    asm volatile("s_waitcnt vmcnt(0)" ::: "memory");
    __syncthreads();
    if (b.wave == 0 && lane_id() == 0) {
        unsigned* bar = b.bar;
        __builtin_amdgcn_s_waitcnt(0);
        unsigned nloc = b.st[0], nx = b.st[1];
        if (nloc == 0u) { xcd_barrier_complete(bar, b.x, nloc, nx); b.st[0] = nloc; b.st[1] = nx; }
        const unsigned old = xb_add(&bar[XB_XSUB(b.x)], 1u);
        const unsigned gen = old / nloc;
        if (old + 1u == (gen + 1u) * nloc) {
            __builtin_amdgcn_fence(__ATOMIC_RELEASE, "agent");
            asm volatile("s_waitcnt vmcnt(0)" ::: "memory");
            const unsigned og = xb_add(&bar[XB_TOP], 1u);
            const unsigned tg = og / nx;
            if (og + 1u == (tg + 1u) * nx) xb_add(&bar[XB_TOPGEN], 1u);
            else XB_SPIN(xb_ld(&bar[XB_TOPGEN]) == tg, bar);
            __builtin_amdgcn_fence(__ATOMIC_ACQUIRE, "agent");
            xb_add(&bar[XB_XGEN(b.x)], 1u);
            asm volatile("s_waitcnt vmcnt(0)" ::: "memory");
        } else {
            XB_SPIN(xb_ld(&bar[XB_XGEN(b.x)]) == gen, bar);
            __builtin_amdgcn_fence(__ATOMIC_ACQUIRE, "agent");
            asm volatile("s_waitcnt vmcnt(0)" ::: "memory");
        }
    }
    __syncthreads();
}


constexpr int RING_OFF = 0, RING_BYTES = 139264;
constexpr int LDSCTL_OFF = RING_BYTES, MISC_OFF = LDSCTL_OFF + 320;
constexpr int LDS_BYTES = 147456;

struct Args { const float* in[17]; float* out; unsigned char* ws; int ph_lo, ph_hi; };

struct Ctx {
    LAS unsigned char* lds; int tid, lane, wave, G, bid, gw, ngw;
};

struct TrDesc { const float* src; bf16* dst; int N, K, mode, n0; };
__device__ __forceinline__ TrDesc tr_desc(const float* W, int K, int N, bf16* WT, int mode, int tile) {
    const int nblk = N >> 6, kb = tile / nblk, nb = tile - kb * nblk; TrDesc d; d.src = W + (size_t)(kb * 64) * N + nb * 64; d.dst = WT + kb * 64; d.N = N; d.K = K; d.mode = mode; d.n0 = nb * 64; return d;
}
__device__ __forceinline__ void tr_load(const TrDesc& d, f32x4 (&v)[16], int lane) {
    const unsigned lo = (unsigned)((lane >> 4) * d.N + 4 * (lane & 15)) * 4u;
    const char* p = (const char*)d.src;
#pragma unroll
    for (int i = 0; i < 16; ++i) v[i] = __builtin_nontemporal_load((const f32x4*)(p + (size_t)(16 * i) * d.N + lo));
}
__device__ __forceinline__ void tr_store(const TrDesc& d, const f32x4 (&v)[16], LAS float* scr, int lane) {
    asm volatile("" ::: "memory"); __builtin_amdgcn_sched_barrier(0);
    {   const unsigned wa = (unsigned)(uintptr_t)(scr + (lane >> 4) * 65 + 4 * (lane & 15));
#pragma unroll
        for (int i = 0; i < 16; ++i) {
            asm volatile("ds_write_b32 %0, %1 offset:%2" :: "v"(wa), "v"(v[i].x), "n"(i * 1040 + 0) : "memory");
            asm volatile("ds_write_b32 %0, %1 offset:%2" :: "v"(wa), "v"(v[i].y), "n"(i * 1040 + 4) : "memory");
            asm volatile("ds_write_b32 %0, %1 offset:%2" :: "v"(wa), "v"(v[i].z), "n"(i * 1040 + 8) : "memory");
            asm volatile("ds_write_b32 %0, %1 offset:%2" :: "v"(wa), "v"(v[i].w), "n"(i * 1040 + 12) : "memory"); } }
    LDS_WAIT(); asm volatile("" ::: "memory");
    const int c = lane >> 3;
    const int rowbase = d.mode == 0 ? d.n0 : (d.n0 >> 4) * 32 + (d.mode == 2 ? 16 : 0);
    const unsigned so = (unsigned)((lane & 7) * d.K + 8 * c) * 2u;
    char* q = (char*)(d.dst + (size_t)rowbase * d.K);
#pragma unroll
    for (int j = 0; j < 8; ++j) { const LAS float* s = scr + (8 * c) * 65 + (lane & 7) + 8 * j;
        v4u o; o.x = pk2(s[0 * 65], s[1 * 65]); o.y = pk2(s[2 * 65], s[3 * 65]); o.z = pk2(s[4 * 65], s[5 * 65]); o.w = pk2(s[6 * 65], s[7 * 65]);
        const int rowj = d.mode == 0 ? 8 * j : (j >> 1) * 32 + 8 * (j & 1);
        __builtin_nontemporal_store(o, (v4u*)(q + (size_t)(2 * rowj) * d.K + so)); }
    LDS_WAIT(); asm volatile("" ::: "memory");
}
__device__ __forceinline__ void rms_row_bf16(const float* xrow, const float* g, bf16* orow, int lane) {
    f32x4 v[8]; float s = 0.f;
#pragma unroll
    for (int j = 0; j < 4; ++j) { const float* p = xrow + 8 * (lane + 64 * j); v[2 * j] = __builtin_nontemporal_load((const f32x4*)p); v[2 * j + 1] = __builtin_nontemporal_load((const f32x4*)(p + 4)); }
#pragma unroll
    for (int j = 0; j < 8; ++j) s += (v[j].x * v[j].x + v[j].y * v[j].y) + (v[j].z * v[j].z + v[j].w * v[j].w);
    const float rstd = 1.0f / sqrtf(wave_sum(s) * (1.0f / DM) + RMS_EPS);
#pragma unroll
    for (int j = 0; j < 4; ++j) { const float* gp = g + 8 * (lane + 64 * j); const f32x4 g0 = *(const f32x4*)gp, g1 = *(const f32x4*)(gp + 4);
        const f32x4 a = v[2 * j] * rstd * g0, b = v[2 * j + 1] * rstd * g1;
        v4u o; o.x = pk2(a.x, a.y); o.y = pk2(a.z, a.w); o.z = pk2(b.x, b.y); o.w = pk2(b.z, b.w);
        *(v4u*)(orow + 8 * (lane + 64 * j)) = o; }
}
__device__ __forceinline__ TrDesc p0_desc(const Args& a, int r) {
    unsigned char* ws = a.ws;
    constexpr int T_IN = (DM / 64) * (NPROJ / 64), T_POOL = 4 * 4 * 4, T_BP = (PW / 64) * (DM / 64);
    if (r < T_IN) return tr_desc(a.in[2], DM, NPROJ, (bf16*)(ws + WS_WIN), 0, r); r -= T_IN;
    if (r < T_POOL) { const int g = r >> 4; return tr_desc(a.in[3] + (size_t)g * 65536, 256, 256, (bf16*)(ws + WS_WPOOL) + (size_t)g * 65536, 0, r & 15); } r -= T_POOL;
    if (r < T_BP) return tr_desc(a.in[5], PW, DM, (bf16*)(ws + WS_WBP), 0, r); r -= T_BP;
    if (r < T_BP) return tr_desc(a.in[6], AW, DM, (bf16*)(ws + WS_WBA), 0, r); r -= T_BP;
    return tr_desc(a.in[7], DM, DM, (bf16*)(ws + WS_WOUT), 0, r);
}
__device__ __forceinline__ void p0_prologue(const Ctx& C, const Args& a) {
    LAS float* scr = (LAS float*)(C.lds + C.wave * 16640);
    constexpr int NT = (DM / 64) * (NPROJ / 64) + 64 + 2 * (PW / 64) * (DM / 64) + (DM / 64) * (DM / 64);
    int it = C.gw;
    if (it < NT) {
        f32x4 va[16], vb[16]; TrDesc d0 = p0_desc(a, it); tr_load(d0, va, C.lane);
        for (;;) { const int nx = it + C.ngw; const bool more = nx < NT; TrDesc d1 = d0;
            if (more) { d1 = p0_desc(a, nx); tr_load(d1, vb, C.lane); }
            tr_store(d0, va, scr, C.lane);
            if (!more) break;
            d0 = d1; it = nx;
#pragma unroll
            for (int i = 0; i < 16; ++i) va[i] = vb[i]; }
    }
    for (int m = C.gw; m < SEQ; m += C.ngw) rms_row_bf16(a.in[0] + (size_t)m * DM, a.in[1], (bf16*)(a.ws + WS_HN) + (size_t)m * DM, C.lane);
}
__device__ __forceinline__ TrDesc moe_desc(const Args& a, int r) {
    unsigned char* ws = a.ws;
    constexpr int TPE_G = (DM / 64) * (DE / 64), TPE_D = (DE / 64) * (DM / 64), T_G = NE * TPE_G;
    if (r < T_G) { const int e = r / TPE_G; return tr_desc(a.in[13] + (size_t)e * DM * DE, DM, DE, (bf16*)(ws + WS_WGU) + (size_t)e * 2048 * DM, 1, r - e * TPE_G); } r -= T_G;
    if (r < T_G) { const int e = r / TPE_G; return tr_desc(a.in[14] + (size_t)e * DM * DE, DM, DE, (bf16*)(ws + WS_WGU) + (size_t)e * 2048 * DM, 2, r - e * TPE_G); } r -= T_G;
    const int e = r / TPE_D; return tr_desc(a.in[15] + (size_t)e * DE * DM, DE, DM, (bf16*)(ws + WS_WDN) + (size_t)e * DM * DE, 0, r - e * TPE_D);
}
template <bool CONV_CU>
__device__ __forceinline__ void conv_tiles(const Ctx& C, const Args& a, int idx) {
    LAS float* scr = (LAS float*)(C.lds + C.wave * 16640);
    constexpr int NT = 3 * NE * (DM / 64) * (DE / 64), NGW = 208 * NWAVES, TAIL_PER_WAVE = 3, NT_A = NT - TAIL_PER_WAVE * NGW, NT_8 = NT_A - 1536;
    static_assert(NT_A % 64 == 0 && NT_8 % 64 == 0 && NT_8 > 0, "whole tile groups");
    f32x4 va[16], vb[16];
    if (C.G != 256) { for (int t = C.gw; t < NT; t += C.ngw) { const TrDesc d = moe_desc(a, t); tr_load(d, va, C.lane); tr_store(d, va, scr, C.lane); } return; }
    if (!CONV_CU) {
#pragma unroll 1
        for (int s_ = 0; s_ < TAIL_PER_WAVE; ++s_) { const TrDesc d = moe_desc(a, NT_A + s_ * NGW + idx); tr_load(d, va, C.lane); tr_store(d, va, scr, C.lane); }
        return;
    }
    unsigned* ctr = (unsigned*)(a.ws + WS_CTL) + CW_CONV;
    auto pull = [&](unsigned* c, unsigned n) -> int { unsigned b0 = 0; if (C.lane == 0) b0 = __hip_atomic_fetch_add(c, n, RLX_AGENT); return __builtin_amdgcn_readfirstlane((int)b0); };
    auto first = [&](int base_) { const int b = base_ >> 3; return moe_desc(a, ((b >> 3) << 6) + (b & 7)); };
    auto sub = [](const TrDesc& m, int i) { const int sh = m.N == DM ? 2 : 1  , nbi = i & ((1 << sh) - 1), kbi = i >> sh;
        TrDesc d = m; d.src = m.src + (size_t)(kbi * 64) * m.N + nbi * 512; d.dst = m.dst + kbi * 64; d.n0 = m.n0 + nbi * 512; return d; };
    int base = pull(ctr, 8u);
    if (base < NT_8) {
        TrDesc m = first(base); tr_load(m, va, C.lane);
        for (;;) {
            const TrDesc d1 = sub(m, 1); tr_load(d1, vb, C.lane); tr_store(m, va, scr, C.lane);
            const TrDesc d2 = sub(m, 2); tr_load(d2, va, C.lane); tr_store(d1, vb, scr, C.lane);
            const TrDesc d3 = sub(m, 3); tr_load(d3, vb, C.lane); tr_store(d2, va, scr, C.lane);
            const TrDesc d4 = sub(m, 4); tr_load(d4, va, C.lane); tr_store(d3, vb, scr, C.lane);
            const TrDesc d5 = sub(m, 5); tr_load(d5, vb, C.lane); tr_store(d4, va, scr, C.lane);
            const TrDesc d6 = sub(m, 6); tr_load(d6, va, C.lane); tr_store(d5, vb, scr, C.lane);
            const TrDesc d7 = sub(m, 7); tr_load(d7, vb, C.lane); tr_store(d6, va, scr, C.lane);
            base = pull(ctr, 8u);
            if (base >= NT_8) { tr_store(d7, vb, scr, C.lane); break; }
            m = first(base); tr_load(m, va, C.lane);
            tr_store(d7, vb, scr, C.lane);
        }
    }
    for (;;) {
        const int t = pull(ctr + 64, 2u); if (t >= NT_A - NT_8) break;
        const TrDesc d0 = moe_desc(a, NT_8 + t), d1 = moe_desc(a, NT_8 + t + 1);
        tr_load(d0, va, C.lane); tr_load(d1, vb, C.lane); tr_store(d0, va, scr, C.lane); tr_store(d1, vb, scr, C.lane);
    }
}

__device__ __forceinline__ void pool_mixed_tile(const Ctx& C, const Args& a, int L) {
    unsigned char* ws = a.ws; const bf16* u = (const bf16*)(ws + WS_U); bf16* mixed = (bf16*)(ws + WS_MIXED);
    const int g = L >> 5, rt = L & 31, w = 2 << g; const int chunk = C.tid & 31, run = C.tid >> 5;
    const int r0 = rt * 256 + run * 16; const bf16* up = u + g * 256 + chunk * 8; bf16* mp = mixed + ((size_t)g * SEQ) * 256 + chunk * 8;
    float s[8], cur[8];
#pragma unroll
    for (int i = 0; i < 8; ++i) { s[i] = 0.f; cur[i] = 0.f; }
    for (int i = (r0 - w + 1 < 0 ? 0 : r0 - w + 1); i <= r0; ++i) { float f[8]; pg8::unpack8(*(const v4u*)(up + (size_t)i * PW), f);
#pragma unroll
        for (int k = 0; k < 8; ++k) { s[k] += f[k]; cur[k] = f[k]; } }
    for (int r = r0; r < r0 + 16; ++r) {
        if (r > r0) { float f[8]; pg8::unpack8(*(const v4u*)(up + (size_t)r * PW), f);
#pragma unroll
            for (int k = 0; k < 8; ++k) { s[k] += f[k]; cur[k] = f[k]; }
            if (r - w >= 0) { float o[8]; pg8::unpack8(*(const v4u*)(up + (size_t)(r - w) * PW), o);
#pragma unroll
                for (int k = 0; k < 8; ++k) s[k] -= o[k]; } }
        const float inv = 1.0f / (float)(r + 1 < w ? r + 1 : w);
        v4u o; o.x = pk2(s[0] * inv - cur[0], s[1] * inv - cur[1]); o.y = pk2(s[2] * inv - cur[2], s[3] * inv - cur[3]);
        o.z = pk2(s[4] * inv - cur[4], s[5] * inv - cur[5]); o.w = pk2(s[6] * inv - cur[6], s[7] * inv - cur[7]);
        *(v4u*)(mp + (size_t)r * 256) = o;
    }
}

__device__ __forceinline__ bool gate_better(float av, int ai, float bv, int bi) { return av > bv || (av == bv && ai < bi); }

__device__ __forceinline__ void moe_offsets(const unsigned* cnt, int lane, int& incl_tiles, int& tiles, unsigned& cv) {
    cv = 0; if (lane < NE) cv = __hip_atomic_load(cnt + 64 * lane, RLX_AGENT);
    tiles = (int)((cv + 255u) >> 8); incl_tiles = tiles;
#pragma unroll
    for (int o = 1; o < 16; o <<= 1) { const int tt = __shfl_up(incl_tiles, o); if (lane >= o) incl_tiles += tt; }
}
constexpr int TPW = 4;
__device__ __forceinline__ void reduce32(float (&v)[32], int lane) {
#pragma unroll
    for (int i = 0; i < 16; ++i) { const bool up = lane & 32; const float snd = up ? v[i] : v[i + 16], kp = up ? v[i + 16] : v[i]; v[i] = kp + shx(snd, 32, lane); }
#pragma unroll
    for (int i = 0; i < 8; ++i) { const bool up = lane & 16; const float snd = up ? v[i] : v[i + 8], kp = up ? v[i + 8] : v[i]; v[i] = kp + shx(snd, 16, lane); }
#pragma unroll
    for (int i = 0; i < 4; ++i) { const bool up = lane & 8; const float snd = up ? v[i] : v[i + 4], kp = up ? v[i + 4] : v[i]; v[i] = kp + shx(snd, 8, lane); }
#pragma unroll
    for (int i = 0; i < 2; ++i) { const bool up = lane & 4; const float snd = up ? v[i] : v[i + 2], kp = up ? v[i + 2] : v[i]; v[i] = kp + shx(snd, 4, lane); }
    { const bool up = lane & 2; const float snd = up ? v[0] : v[1], kp = up ? v[1] : v[0]; v[0] = kp + shx(snd, 2, lane); }
    v[0] += shx(v[0], 1, lane);
}
template <class Bar>
__device__ __forceinline__ void p_router(const Ctx& C, const Args& a, const Bar& bar) {
    unsigned char* ws = a.ws; const bf16* x1 = (const bf16*)(ws + WS_X1); const float* g2 = a.in[8];
    const float* wrg = a.in[9]; const float* brg = a.in[10]; const float* wre = a.in[11]; const float* bre = a.in[12];
    unsigned* cnt = (unsigned*)(ws + WS_CTL) + CW_CNT;
    int* toke = (int*)(ws + WS_TOKE); int* toks = (int*)(ws + WS_TOKS); int* rowtok = (int*)(ws + WS_ROWTOK); float* roww = (float*)(ws + WS_ROWW);
    bf16* h2 = (bf16*)(ws + WS_HN);
    const int lane = C.lane, tid = C.tid;
    LAS float* wl = (LAS float*)C.lds;
    const bf16* xp[TPW];
#pragma unroll
    for (int k = 0; k < TPW; ++k) { const int t = C.gw + k * C.ngw; xp[k] = x1 + (size_t)__builtin_amdgcn_readfirstlane(t < SEQ ? t : 0) * DM; }
    const int lo4 = 4 * lane;
    float ga[TPW][4], ssq[TPW];
#pragma unroll
    for (int k = 0; k < TPW; ++k) { ssq[k] = 0.f; ga[k][0] = 0.f; ga[k][1] = 0.f; ga[k][2] = 0.f; ga[k][3] = 0.f; }
    __syncthreads();
#pragma unroll
    for (int r = 0; r < 4; ++r) *(LAS f32x4*)(wl + (r * 512 + tid) * 4) = *(const f32x4*)(wrg + (size_t)(r * 512 + tid) * 4);
    pg8::u32x2 xn[TPW][2]; f32x4 gn[2];
#pragma unroll
    for (int jj = 0; jj < 2; ++jj) { gn[jj] = *(const f32x4*)(g2 + 256 * jj + 4 * lane);
#pragma unroll
        for (int k = 0; k < TPW; ++k) xn[k][jj] = *(const pg8::u32x2*)(xp[k] + (256 * jj + lo4)); }
    __syncthreads();
#pragma unroll 1
    for (int ch = 0; ch < 4; ++ch) {
        pg8::u32x2 xv[TPW][2]; f32x4 gg[2];
#pragma unroll
        for (int jj = 0; jj < 2; ++jj) { gg[jj] = gn[jj];
#pragma unroll
            for (int k = 0; k < TPW; ++k) xv[k][jj] = xn[k][jj]; }
        { const int cn = ch < 3 ? ch + 1 : 3;
#pragma unroll
            for (int jj = 0; jj < 2; ++jj) { gn[jj] = *(const f32x4*)(g2 + cn * 512 + 256 * jj + 4 * lane);
#pragma unroll
                for (int k = 0; k < TPW; ++k) xn[k][jj] = *(const pg8::u32x2*)(xp[k] + (cn * 512 + 256 * jj + lo4)); } }
#pragma unroll
        for (int jj = 0; jj < 2; ++jj)
#pragma unroll
            for (int i = 0; i < 4; ++i) { const f32x4 w = *(const LAS f32x4*)(wl + (ch * 512 + 256 * jj + 4 * lane + i) * 4);
#pragma unroll
                for (int k = 0; k < TPW; ++k) { const unsigned xw_ = i < 2 ? xv[k][jj].x : xv[k][jj].y; const float x = (i & 1) ? bf_hi(xw_) : bf_lo(xw_), xs = x * gg[jj][i]; ssq[k] += x * x; ga[k][0] += xs * w.x; ga[k][1] += xs * w.y; ga[k][2] += xs * w.z; ga[k][3] += xs * w.w; } }
    }
    float rstd[TPW], gwt[TPW]; int gi[TPW];
    { float v[32];
#pragma unroll
        for (int c = 0; c < 32; ++c) v[c] = 0.f;
#pragma unroll
        for (int k = 0; k < TPW; ++k) { v[5 * k] = ga[k][0]; v[5 * k + 1] = ga[k][1]; v[5 * k + 2] = ga[k][2]; v[5 * k + 3] = ga[k][3]; v[5 * k + 4] = ssq[k]; }
        reduce32(v, lane); const float vt = v[0];
#pragma unroll
        for (int k = 0; k < TPW; ++k) {
            rstd[k] = 1.0f / sqrtf(__shfl(vt, 2 * (5 * k + 4)) * (1.0f / DM) + RMS_EPS);
            float gl[4];
#pragma unroll
            for (int i = 0; i < 4; ++i) gl[i] = __shfl(vt, 2 * (5 * k + i)) * rstd[k] + brg[i];
            int g = 0; float gm = gl[0];
#pragma unroll
            for (int i = 1; i < 4; ++i) if (gl[i] > gm) { gm = gl[i]; g = i; }
            float gs = 0.f;
#pragma unroll
            for (int i = 0; i < 4; ++i) gs += __expf(gl[i] - gm);
            gi[k] = g; gwt[k] = 1.0f / gs;
            asm volatile("" : "+v"(gwt[k]));
            __builtin_amdgcn_sched_barrier(0);
        } }
    float eacc[TPW][4];
#pragma unroll
    for (int k = 0; k < TPW; ++k) { eacc[k][0] = 0.f; eacc[k][1] = 0.f; eacc[k][2] = 0.f; eacc[k][3] = 0.f; }
    {
    __syncthreads();
#pragma unroll
    for (int g = 0; g < 4; ++g)
#pragma unroll
        for (int r = 0; r < 4; ++r) *(LAS f32x4*)(wl + g * 8192 + (r * 512 + tid) * 4) = *(const f32x4*)(wre + ((size_t)g * DM + r * 512 + tid) * 4);
    pg8::u32x2 xn[TPW][2];
#pragma unroll
    for (int jj = 0; jj < 2; ++jj)
#pragma unroll
        for (int k = 0; k < TPW; ++k) xn[k][jj] = *(const pg8::u32x2*)(xp[k] + (256 * jj + lo4));
    __syncthreads();
#pragma unroll 1
    for (int ch = 0; ch < 4; ++ch) {
        pg8::u32x2 xv[TPW][2]; f32x4 gg[2];
#pragma unroll
        for (int jj = 0; jj < 2; ++jj) { gg[jj] = *(const f32x4*)(g2 + ch * 512 + 256 * jj + 4 * lane);
#pragma unroll
            for (int k = 0; k < TPW; ++k) xv[k][jj] = xn[k][jj]; }
        { const int cn = ch < 3 ? ch + 1 : 3;
#pragma unroll
            for (int jj = 0; jj < 2; ++jj)
#pragma unroll
                for (int k = 0; k < TPW; ++k) xn[k][jj] = *(const pg8::u32x2*)(xp[k] + (cn * 512 + 256 * jj + lo4)); }
#pragma unroll
        for (int k = 0; k < TPW; ++k) { const int t = C.gw + k * C.ngw; const LAS float* wp = wl + gi[k] * 8192 + ch * 2048;
#pragma unroll
            for (int jj = 0; jj < 2; ++jj) { float hs[4];
#pragma unroll
                for (int i = 0; i < 4; ++i) { const f32x4 w = *(const LAS f32x4*)(wp + (256 * jj + 4 * lane + i) * 4); const unsigned xw_ = i < 2 ? xv[k][jj].x : xv[k][jj].y; const float x = (i & 1) ? bf_hi(xw_) : bf_lo(xw_), xs = x * gg[jj][i];
                    eacc[k][0] += xs * w.x; eacc[k][1] += xs * w.y; eacc[k][2] += xs * w.z; eacc[k][3] += xs * w.w; hs[i] = x * rstd[k] * gg[jj][i]; }
                if (t < SEQ) { v2u o; o.x = pk2(hs[0], hs[1]); o.y = pk2(hs[2], hs[3]); *(v2u*)(h2 + (size_t)t * DM + ch * 512 + 256 * jj + 4 * lane) = o; } }
            __builtin_amdgcn_sched_barrier(0); }
    }
    }
    { float v[32];
#pragma unroll
        for (int c = 0; c < 32; ++c) v[c] = 0.f;
#pragma unroll
        for (int k = 0; k < TPW; ++k) { v[4 * k] = eacc[k][0]; v[4 * k + 1] = eacc[k][1]; v[4 * k + 2] = eacc[k][2]; v[4 * k + 3] = eacc[k][3]; }
        reduce32(v, lane_id()); const float vt = v[0];
#pragma unroll
        for (int k = 0; k < TPW; ++k) {
            const int t = C.gw + k * C.ngw;
            float el[4];
#pragma unroll
            for (int i = 0; i < 4; ++i) el[i] = __shfl(vt, 2 * (4 * k + i)) * rstd[k] + bre[gi[k] * 4 + i];
            int i0 = 0; float v0 = el[0];
#pragma unroll
            for (int i = 1; i < 4; ++i) if (el[i] > v0) { v0 = el[i]; i0 = i; }
            int i1 = -1; float v1 = -3.0e38f;
#pragma unroll
            for (int i = 0; i < 4; ++i) if (i != i0 && el[i] > v1) { v1 = el[i]; i1 = i; }
            const float e1 = __expf(v1 - v0), den = 1.0f / (1.0f + e1);
            const float w0 = den * gwt[k], w1 = e1 * den * gwt[k];
            const int ea = gi[k] * 4 + i0, eb = gi[k] * 4 + i1;
            if (lane == 0 && t < SEQ) { const int xa = (int)__hip_atomic_fetch_add(cnt + 64 * ea, 1u, RLX_AGENT), xb = (int)__hip_atomic_fetch_add(cnt + 64 * eb, 1u, RLX_AGENT);
                roww[ea * ECAP + xa] = w0; roww[eb * ECAP + xb] = w1; rowtok[ea * ECAP + xa] = t; rowtok[eb * ECAP + xb] = t;
                toke[2 * t] = ea; toke[2 * t + 1] = eb; toks[2 * t] = xa; toks[2 * t + 1] = xb; }
            __builtin_amdgcn_sched_barrier(0);
        } }
}
struct FinRow { v4u x[4], ya[4], yb[4]; };
__device__ __forceinline__ void fin_load(FinRow& r, const bf16* xr, const bf16* ya, const bf16* yb, int lane) {
#pragma unroll
    for (int j = 0; j < 4; ++j) { const int c0 = 8 * (lane + 64 * j); r.x[j] = __builtin_nontemporal_load((const v4u*)(xr + c0));
        r.ya[j] = __builtin_nontemporal_load((const v4u*)(ya + c0)); r.yb[j] = __builtin_nontemporal_load((const v4u*)(yb + c0)); }
}
__device__ __forceinline__ void p8_final(const Ctx& C, const Args& a) {
    unsigned char* ws = a.ws; float* out = a.out; const float* gf = a.in[16]; const bf16* y = (const bf16*)(ws + WS_Y); const bf16* x1 = (const bf16*)(ws + WS_X1);
    const int* toke = (const int*)(ws + WS_TOKE); const int* toks = (const int*)(ws + WS_TOKS); const unsigned* cnt = (const unsigned*)(ws + WS_CTL) + CW_CNT;
    const int lane = C.lane;
    int incl, tiles; unsigned cv; moe_offsets(cnt, lane, incl, tiles, cv);
    auto rowof = [&](int e, int slot) { return (__shfl(incl, e) - __shfl(tiles, e)) * 256 + slot; };
    int t = C.gw; if (t >= SEQ) return;
    FinRow cur, nxt;
    { const int ra = rowof(toke[2 * t], toks[2 * t]), rb = rowof(toke[2 * t + 1], toks[2 * t + 1]); fin_load(cur, x1 + (size_t)t * DM, y + (size_t)ra * DM, y + (size_t)rb * DM, lane); }
    for (;;) {
        const int tn = t + C.ngw; const bool more = tn < SEQ;
        if (more) { const int ra = rowof(toke[2 * tn], toks[2 * tn]), rb = rowof(toke[2 * tn + 1], toks[2 * tn + 1]); fin_load(nxt, x1 + (size_t)tn * DM, y + (size_t)ra * DM, y + (size_t)rb * DM, lane); }
        float* xr = out + (size_t)t * DM; float hv[32]; float s = 0.f;
#pragma unroll
        for (int j = 0; j < 4; ++j) { float fa[8], fb[8], fx[8]; pg8::unpack8(cur.ya[j], fa); pg8::unpack8(cur.yb[j], fb); pg8::unpack8(cur.x[j], fx);
#pragma unroll
            for (int i = 0; i < 8; ++i) hv[8 * j + i] = fx[i] + fa[i] + fb[i]; }
#pragma unroll
        for (int i = 0; i < 32; ++i) s += hv[i] * hv[i];
        const float rstd = 1.0f / sqrtf(wave_sum(s) * (1.0f / DM) + RMS_EPS);
#pragma unroll
        for (int j = 0; j < 4; ++j) { const int c0 = 8 * (lane + 64 * j); const f32x4 g0 = *(const f32x4*)(gf + c0), g1 = *(const f32x4*)(gf + c0 + 4);
            __builtin_nontemporal_store((f32x4){hv[8 * j] * rstd * g0.x, hv[8 * j + 1] * rstd * g0.y, hv[8 * j + 2] * rstd * g0.z, hv[8 * j + 3] * rstd * g0.w}, (f32x4*)(xr + c0));
            __builtin_nontemporal_store((f32x4){hv[8 * j + 4] * rstd * g1.x, hv[8 * j + 5] * rstd * g1.y, hv[8 * j + 6] * rstd * g1.z, hv[8 * j + 7] * rstd * g1.w}, (f32x4*)(xr + c0 + 4)); }
        if (!more) break;
        t = tn; cur = nxt;
    }
}

namespace moba {
typedef float f32x16 __attribute__((ext_vector_type(16)));
typedef short s16x4 __attribute__((ext_vector_type(4)));
typedef short v4i16_t __attribute__((ext_vector_type(4)));
constexpr int LK = 0, LV = 65536, LLIST = 131072, LWC = LLIST + 6144;
constexpr int MAXBLK = 12;
constexpr float LOG2E = 1.4426950408889634f, C1 = 0.08838834764831845f * 1.4426950408889634f;
constexpr int TARGET = 448, MAXENT = 192;
struct Tab { int nB, n; unsigned e[MAXENT]; };
constexpr Tab make_tab() {
    Tab t{}; int n = 0; float cost[MAXENT] = {};
    for (int j = 0; j < 31; ++j) { int b = j + 1;
        while (b < 32) { float acc = 0.f; const int lo = b; while (b < 32 && acc < (float)TARGET && b - lo < MAXBLK) { acc += b <= 3 ? 256.f : 768.f / (float)b; ++b; } t.e[n] = (unsigned)j | ((unsigned)lo << 8) | ((unsigned)b << 16); cost[n] = acc; ++n; } }
    for (int i = 1; i < n; ++i) { const unsigned ke = t.e[i]; const float kc = cost[i]; int k = i - 1; while (k >= 0 && cost[k] < kc) { t.e[k + 1] = t.e[k]; cost[k + 1] = cost[k]; --k; } t.e[k + 1] = ke; cost[k + 1] = kc; }
    t.nB = n;
    for (int b = 31; b >= 0; --b) { t.e[n] = (unsigned)b | ((unsigned)b << 8) | ((unsigned)(b + 1) << 16); ++n; }
    t.n = n; return t;
}
__device__ const Tab g_tab = make_tab();

__device__ __forceinline__ int crow(int r, int hf) { return (r & 3) + 8 * (r >> 2) + 4 * hf; }
__device__ __forceinline__ s16x4 vtr(const LAS unsigned char* p) { return __builtin_bit_cast(s16x4, __builtin_amdgcn_ds_read_tr16_b64_v4i16((LAS v4i16_t*)p)); }

__device__ __forceinline__ void load_kv(LAS unsigned char* lds, const bf16* K, const bf16* V, int h, int j, int wave, int lane) {
#pragma unroll
    for (int i = 0; i < 8; ++i) { const int p = wave * 8 + i; const int key = 4 * p + (lane >> 4), cp = lane & 15;
        const bf16* src = K + (size_t)(j * 256 + key) * AW + h * HD + ((cp ^ (key & 15)) * 8);
        __builtin_amdgcn_global_load_lds((const unsigned*)src, (LAS unsigned*)(lds + LK + p * 1024), 16, 0, 0); }
#pragma unroll
    for (int i = 0; i < 8; ++i) { const int p = wave * 8 + i; const int q4 = p >> 4, kg = p & 15; const int key = kg * 16 + (lane >> 2), part = lane & 3;
        const bf16* src = V + (size_t)(j * 256 + key) * AW + h * HD + q4 * 32 + part * 8;
        __builtin_amdgcn_global_load_lds((const unsigned*)src, (LAS unsigned*)(lds + LV + q4 * 16384 + kg * 1024), 16, 0, 0); }
}

#define MOBA_SB() __builtin_amdgcn_sched_barrier(0)
template <bool CAUSAL>
__device__ __forceinline__ void attn_group(LAS unsigned char* lds, const LAS unsigned short* ent, int cnt, int tbase, const bf16* Q, bf16* part, bf16* part3, float* ml, int h, int j, int kmax, int lane) {
    const int ql = lane & 31, hf = lane >> 5;
    const unsigned en = ent[ql < cnt ? ql : 0];
    const int tq = tbase + (int)(en & 0xfffu), slot = (int)(en >> 12);
    bf16x8 qf[8]; { const bf16* qp = Q + (size_t)tq * AW + h * HD + 8 * hf;
#pragma unroll
        for (int s = 0; s < 8; ++s) qf[s] = *(const bf16x8*)(qp + 16 * s); }
    const float slope2 = exp2f(-(float)(h + 1)) * LOG2E;
    const float tb = (float)(j * 256 + 4 * hf - tq);
    f32x16 o[4];
#pragma unroll
    for (int d = 0; d < 4; ++d)
#pragma unroll
        for (int r = 0; r < 16; ++r) o[d][r] = 0.f;
    float m_run = -1e30f, l_run = 0.f;
    const LAS unsigned char* kbase = lds + LK + ql * 256;
    const LAS unsigned char* vbase = lds + LV + (4 * hf + ((lane & 15) >> 2)) * 64 + ((lane >> 4) & 1) * 32 + (lane & 3) * 8;
    const int kq = ql & 15;
#define MOBA_KF(idx) (*(const LAS bf16x8*)(kbase + ((idx) >> 3) * 8192 + (((2 * ((idx) & 7) + hf) ^ kq) * 16)))
#pragma unroll
    for (int half = 0; half < 2; ++half) {
        if (CAUSAL && half * 128 > kmax) break;
        f32x16 st[4];
#pragma unroll
        for (int kt = 0; kt < 4; ++kt)
#pragma unroll
            for (int r = 0; r < 16; ++r) st[kt][r] = 0.f;
        bf16x8 kr[8];
#pragma unroll
        for (int i = 0; i < 3; ++i) kr[i] = MOBA_KF(half * 32 + i);
#pragma unroll
        for (int i = 0; i < 32; ++i) {
            if (i + 3 < 32) kr[(i + 3) & 7] = MOBA_KF(half * 32 + i + 3);
            if ((i & 3) == 0) MOBA_SB();
            const int kt = i >> 3, s = i & 7;
            if (!(CAUSAL && (half * 4 + kt) * 32 > kmax)) st[kt] = __builtin_amdgcn_mfma_f32_32x32x16_bf16(kr[i & 7], qf[s], st[kt], 0, 0, 0);
        }
#pragma unroll
        for (int kt = 0; kt < 4; ++kt) {
            const int ktt = half * 4 + kt;
            if (CAUSAL && ktt * 32 > kmax) {
#pragma unroll
                for (int r = 0; r < 16; ++r) st[kt][r] = -1e30f;
            } else {
                const float tbk = tb + (float)(ktt * 32);
#pragma unroll
                for (int r = 0; r < 16; ++r) { const float rel = tbk + (float)((r & 3) + 8 * (r >> 2));
                    float s2 = st[kt][r] * C1 + slope2 * rel; if (CAUSAL && rel > 0.f) s2 = -1e30f; st[kt][r] = s2; }
            }
        }
        float mx = -1e30f;
#pragma unroll
        for (int kt = 0; kt < 4; ++kt)
#pragma unroll
            for (int r = 0; r < 16; ++r) mx = fmaxf(mx, st[kt][r]);
        mx = fmaxf(mx, __shfl_xor(mx, 32));
        const float m_new = fmaxf(m_run, mx), alpha = __builtin_amdgcn_exp2f(m_run - m_new);
        m_run = m_new; l_run *= alpha;
        if (half == 1) {
#pragma unroll
            for (int d = 0; d < 4; ++d)
#pragma unroll
                for (int r = 0; r < 16; ++r) o[d][r] *= alpha; }
        float ls = 0.f;
        s16x4 vr[8];
#define MOBA_VF(slot, idx) do { const LAS unsigned char* vp_ = vbase + ((idx) & 3) * 16384 + (half * 8 + ((idx) >> 2)) * 1024; vr[2 * (slot)] = vtr(vp_); vr[2 * (slot) + 1] = vtr(vp_ + 512); } while (0)
        MOBA_VF(0, 0); MOBA_VF(1, 1);
#pragma unroll
        for (int kt = 0; kt < 4; ++kt) {
            const int ktt = half * 4 + kt;
            const bool skip = CAUSAL && ktt * 32 > kmax;
            float p[16];
            if (!skip) {
#pragma unroll
                for (int r = 0; r < 16; ++r) { p[r] = __builtin_amdgcn_exp2f(st[kt][r] - m_new); ls += p[r]; } }
            else {
#pragma unroll
                for (int r = 0; r < 16; ++r) p[r] = 0.f; }
#pragma unroll
            for (int s2 = 0; s2 < 2; ++s2) {
                v4u pw; pw.x = pg8::cvt_pk_bf16(p[8 * s2 + 0], p[8 * s2 + 1]); pw.y = pg8::cvt_pk_bf16(p[8 * s2 + 2], p[8 * s2 + 3]); pw.z = pg8::cvt_pk_bf16(p[8 * s2 + 4], p[8 * s2 + 5]); pw.w = pg8::cvt_pk_bf16(p[8 * s2 + 6], p[8 * s2 + 7]);
                const bf16x8 pf = __builtin_bit_cast(bf16x8, pw);
#pragma unroll
                for (int d = 0; d < 4; ++d) {
                    const int idx = (kt * 2 + s2) * 4 + d;
                    if (idx + 2 < 32) MOBA_VF((idx + 2) & 3, idx + 2);
                    if ((idx & 1) == 0) MOBA_SB();
                    const s16x4 lo = vr[2 * (idx & 3)], hi = vr[2 * (idx & 3) + 1];
                    const bf16x8 vf = (bf16x8){lo[0], lo[1], lo[2], lo[3], hi[0], hi[1], hi[2], hi[3]};
                    if (!skip) o[d] = __builtin_amdgcn_mfma_f32_32x32x16_bf16(vf, pf, o[d], 0, 0, 0);
                }
            }
        }
#undef MOBA_VF
        l_run += ls;
    }
#undef MOBA_KF
    const float l_tot = l_run + __shfl_xor(l_run, 32);
    if (ql < cnt) {
        const float inv = 1.0f / l_tot;
        bf16* pp = (slot == 3 ? part3 : part + (size_t)slot * SEQ * AW) + (size_t)tq * AW + h * HD + 4 * hf;
#pragma unroll
        for (int d = 0; d < 4; ++d)
#pragma unroll
            for (int rq = 0; rq < 4; ++rq) { v2u w; w.x = pg8::cvt_pk_bf16(o[d][4 * rq] * inv, o[d][4 * rq + 1] * inv); w.y = pg8::cvt_pk_bf16(o[d][4 * rq + 2] * inv, o[d][4 * rq + 3] * inv);
                *(v2u*)(pp + 32 * d + 8 * rq) = w; }
        if (hf == 0) *(f32x2*)(ml + ((size_t)slot * SEQ + tq) * (2 * NH) + 2 * h) = (f32x2){m_run, l_tot};
    }
}
}

__device__ __forceinline__ bf16* part_ptr(unsigned char* ws) { return (bf16*)(ws + WS_PART); }
__device__ __forceinline__ float* ml_ptr(unsigned char* ws) { return (float*)(ws + WS_ML); }

__device__ __forceinline__ void p_attn(const Ctx& C, const Args& a, int rep) {
    using namespace moba;
    unsigned char* ws = a.ws; LAS unsigned char* lds = C.lds;
    const bf16* Q = (const bf16*)(ws + WS_Q); const bf16* K = (const bf16*)(ws + WS_K); const bf16* V = (const bf16*)(ws + WS_V);
    const unsigned* sel = (const unsigned*)(ws + WS_SEL); bf16* part = part_ptr(ws); bf16* part3 = (bf16*)(ws + WS_PART3); float* ml = ml_ptr(ws);
    unsigned* ctr = (unsigned*)(ws + WS_CTL) + CW_ATTN + 64 * rep;
    LAS unsigned short* lst = (LAS unsigned short*)(lds + LLIST); volatile LAS int* wc = (volatile LAS int*)(lds + LWC);
    const int NU = g_tab.n * NH; const int tid = C.tid, lane = C.lane, wave = C.wave;
    int u = C.bid;
    while (u < NU) {
        const unsigned ent = g_tab.e[u >> 3]; const int h = u & 7, j = (int)(ent & 0xff), blo = (int)((ent >> 8) & 0xff), bhi = (int)(ent >> 16);
        if (tid == 0) wc[16] = (int)(C.G + __hip_atomic_fetch_add(ctr, 1u, RLX_AGENT));
        const bool causal = blo == j; const int t_lo = blo * 256; int n = 256;
        const int nt = causal ? 0 : (bhi - blo) * 256;
        unsigned spv[MAXBLK / 2];
#pragma unroll
        for (int i = 0; i < MAXBLK / 2; ++i) { const int tr = i * 512 + tid; spv[i] = 0xffffffffu; if (tr < nt) spv[i] = sel[(t_lo + tr) * NH + h]; }
        load_kv(lds, K, V, h, j, wave, lane);
        if (causal) { if (tid < 256) lst[tid] = (unsigned short)(tid | (3 << 12)); }
        else {
            int slot[MAXBLK / 2]; int before[MAXBLK / 2]; int mycnt = 0;
#pragma unroll
            for (int i = 0; i < MAXBLK / 2; ++i) { const unsigned sp = spv[i]; slot[i] = (int)(sp & 0xff) == j ? 0 : (int)((sp >> 8) & 0xff) == j ? 1 : (int)((sp >> 16) & 0xff) == j ? 2 : -1; }
#pragma unroll
            for (int i = 0; i < MAXBLK / 2; ++i) { const unsigned long long bal = __ballot(slot[i] >= 0); before[i] = mycnt + __popcll(bal & ((1ull << lane) - 1ull)); mycnt += __popcll(bal); }
            if (lane == 0) wc[wave] = mycnt;
            __syncthreads();
            int base = 0, tot = 0;
#pragma unroll
            for (int w = 0; w < 8; ++w) { const int c = wc[w]; if (w < wave) base += c; tot += c; }
#pragma unroll
            for (int i = 0; i < MAXBLK / 2; ++i) if (slot[i] >= 0) lst[base + before[i]] = (unsigned short)((i * 512 + tid) | (slot[i] << 12));
            n = tot;
        }
        asm volatile("s_waitcnt vmcnt(0)" ::: "memory"); __syncthreads();
        if (causal) attn_group<true>(lds, lst + wave * 32, 32, t_lo, Q, part, part3, ml, h, j, wave * 32 + 31, lane);
        else { const int ng = (n + 31) >> 5;
            for (int g = wave; g < ng; g += 8) { const int c = n - g * 32; attn_group<false>(lds, lst + g * 32, c < 32 ? c : 32, t_lo, Q, part, part3, ml, h, j, 255, lane); } }
        __syncthreads();
        u = wc[16];
        __syncthreads();
    }
}

__device__ __forceinline__ void p_combine(const Ctx& C, const Args& a) {
    unsigned char* ws = a.ws; const unsigned* sel = (const unsigned*)(ws + WS_SEL); const bf16* part = part_ptr(ws); const bf16* part3 = (const bf16*)(ws + WS_PART3); const float* ml = ml_ptr(ws); bf16* ao = (bf16*)(ws + WS_AO);
    const int lane = C.lane, h = lane >> 3, dc = lane & 7;
    for (int t0 = C.gw; t0 < SEQ; t0 += 2 * C.ngw) {
        f32x2 mv[2][4]; v4u pv[2][4][2]; bool val[2][4];
#pragma unroll
        for (int k = 0; k < 2; ++k) { const int t = t0 + k * C.ngw; const bool tv = t < SEQ; const int tt = tv ? t : 0; const unsigned sp = sel[tt * NH + h]; const int own = tt >> 8;
#pragma unroll
            for (int s = 0; s < 4; ++s) { val[k][s] = tv && (s == 3 || (int)((sp >> (8 * s)) & 0xff) < own); } }
#pragma unroll
        for (int k = 0; k < 2; ++k) { const int t = t0 + k * C.ngw; const int tt = t < SEQ ? t : 0;
#pragma unroll
            for (int s = 0; s < 4; ++s) { mv[k][s] = (f32x2){-1e30f, 0.f}; pv[k][s][0] = (v4u){0u, 0u, 0u, 0u}; pv[k][s][1] = (v4u){0u, 0u, 0u, 0u};
                if (val[k][s]) { mv[k][s] = *(const f32x2*)(ml + ((size_t)s * SEQ + tt) * (2 * NH) + 2 * h);
                    const bf16* pp = (s == 3 ? part3 : part + (size_t)s * SEQ * AW) + (size_t)tt * AW + h * HD + dc * 16;
                    pv[k][s][0] = __builtin_nontemporal_load((const v4u*)pp); pv[k][s][1] = __builtin_nontemporal_load((const v4u*)(pp + 8)); } } }
#pragma unroll
        for (int k = 0; k < 2; ++k) { const int t = t0 + k * C.ngw;
            float M = -1e30f;
#pragma unroll
            for (int s = 0; s < 4; ++s) M = fmaxf(M, mv[k][s].x);
            float w[4], L = 0.f;
#pragma unroll
            for (int s = 0; s < 4; ++s) { w[s] = mv[k][s].y * exp2f(mv[k][s].x - M); L += w[s]; }
            const float invL = 1.0f / L; float acc[16];
#pragma unroll
            for (int i = 0; i < 16; ++i) acc[i] = 0.f;
#pragma unroll
            for (int s = 0; s < 4; ++s) { float f0[8], f1[8]; pg8::unpack8(pv[k][s][0], f0); pg8::unpack8(pv[k][s][1], f1); const float ws_ = w[s] * invL;
#pragma unroll
                for (int i = 0; i < 8; ++i) { acc[i] += ws_ * f0[i]; acc[8 + i] += ws_ * f1[i]; } }
            if (t < SEQ) { v4u o0, o1; o0.x = pk2(acc[0], acc[1]); o0.y = pk2(acc[2], acc[3]); o0.z = pk2(acc[4], acc[5]); o0.w = pk2(acc[6], acc[7]);
                o1.x = pk2(acc[8], acc[9]); o1.y = pk2(acc[10], acc[11]); o1.z = pk2(acc[12], acc[13]); o1.w = pk2(acc[14], acc[15]);
                bf16* op = ao + (size_t)t * AW + h * HD + dc * 16; *(v4u*)op = o0; *(v4u*)(op + 8) = o1; }
        }
    }
}

__device__ __forceinline__ void p_gate_mfma(const Ctx& C, const Args& a) {
    using moba::f32x16;
    unsigned char* ws = a.ws; const bf16* Q = (const bf16*)(ws + WS_Q); const float* kpart = (const float*)(ws + WS_KPART); unsigned* sel = (unsigned*)(ws + WS_SEL);
    const int lane = C.lane, ql = lane & 31, hf = lane >> 5;
    const bool split = C.G == 256; const int g0 = split ? C.gw - 128 * NWAVES : C.gw, gstep = split ? 128 * NWAVES : C.ngw;
    if (split && C.bid < 128) return;
    for (int it = g0; it < (SEQ / 32) * NH; it += gstep) {
        const int tile = it >> 3, h = it & 7, tq = tile * 32 + ql, own = tile >> 3;
        f32x16 acc;
#pragma unroll
        for (int r = 0; r < 16; ++r) acc[r] = 0.f;
        const bf16* qp = Q + (size_t)tq * AW + h * HD + 8 * hf; const float* kp = kpart + (size_t)ql * 2048 + h * HD + 8 * hf;
#pragma unroll
        for (int s = 0; s < 8; ++s) { const bf16x8 qf = *(const bf16x8*)(qp + 16 * s);
            const f32x4 p0 = *(const f32x4*)(kp + 16 * s), p1 = *(const f32x4*)(kp + 16 * s + 4), r0 = *(const f32x4*)(kp + 1024 + 16 * s), r1 = *(const f32x4*)(kp + 1024 + 16 * s + 4);
            const f32x4 m0 = (p0 + r0) * (1.0f / MBLK), m1 = (p1 + r1) * (1.0f / MBLK);
            const float mm[8] = {m0.x, m0.y, m0.z, m0.w, m1.x, m1.y, m1.z, m1.w}; unsigned hb[8], lb[8];
#pragma unroll
            for (int i = 0; i < 8; ++i) { hb[i] = f2bf(mm[i]); lb[i] = f2bf(mm[i] - __builtin_bit_cast(float, hb[i] << 16)); }
            v4u hw, lw; hw.x = hb[0] | (hb[1] << 16); hw.y = hb[2] | (hb[3] << 16); hw.z = hb[4] | (hb[5] << 16); hw.w = hb[6] | (hb[7] << 16);
            lw.x = lb[0] | (lb[1] << 16); lw.y = lb[2] | (lb[3] << 16); lw.z = lb[4] | (lb[5] << 16); lw.w = lb[6] | (lb[7] << 16);
            acc = __builtin_amdgcn_mfma_f32_32x32x16_bf16(__builtin_bit_cast(bf16x8, hw), qf, acc, 0, 0, 0); acc = __builtin_amdgcn_mfma_f32_32x32x16_bf16(__builtin_bit_cast(bf16x8, lw), qf, acc, 0, 0, 0); }
        float g[16];
#pragma unroll
        for (int r = 0; r < 16; ++r) g[r] = moba::crow(r, hf) < own ? acc[r] : -1e30f;
        unsigned packed = 0;
#pragma unroll
        for (int rd = 0; rd < 3; ++rd) {
            float bv = g[0]; int bi = moba::crow(0, hf);
#pragma unroll
            for (int r = 1; r < 16; ++r) { const int idx = moba::crow(r, hf); if (gate_better(g[r], idx, bv, bi)) { bv = g[r]; bi = idx; } }
            { const float ov = __shfl_xor(bv, 32); const int oi = __shfl_xor(bi, 32); if (gate_better(ov, oi, bv, bi)) { bv = ov; bi = oi; } }
            packed |= (unsigned)bi << (8 * rd);
#pragma unroll
            for (int r = 0; r < 16; ++r) if (moba::crow(r, hf) == bi) g[r] = -3.0e38f;
        }
        if (hf == 0) sel[tq * NH + h] = packed;
    }
}

__device__ __forceinline__ Ctx phase_ctx(const Ctx& C0) { Ctx C = C0; C.lane = lane_id(); asm volatile("" : "+v"(C.lane)); C.tid = C0.wave * 64 + C.lane; C.gw = C.bid * NWAVES + C.wave; return C; }
__device__ __forceinline__ Args phase_args(const Args& a0) { Args a = a0; GAS unsigned char* w = (GAS unsigned char*)a0.ws; asm volatile("" : "+s"(w)); a.ws = (unsigned char*)w; return a; }
#ifndef SKIP_GU
#define SKIP_GU true
#endif
#ifndef SKIP_DN
#define SKIP_DN true
#endif
struct BarRef { const XcdBarrier* b; __device__ __forceinline__ void sync() const { xcd_barrier(*b); } };
__global__ void __launch_bounds__(NTHREADS, 2) mk_fwd(Args args) {
    extern __shared__ __attribute__((aligned(16))) unsigned char lds[];
    Ctx C0; C0.lds = (LAS unsigned char*)lds; C0.tid = threadIdx.x; C0.lane = C0.tid & 63; C0.wave = __builtin_amdgcn_readfirstlane(C0.tid >> 6);
    C0.G = gridDim.x; C0.bid = blockIdx.x; C0.gw = C0.bid * NWAVES + C0.wave; C0.ngw = C0.G * NWAVES;
    LAS unsigned char* ring = C0.lds + RING_OFF;
    for (int u = C0.tid; u < (LDS_BYTES - LDSCTL_OFF) / 4; u += NTHREADS) ((LAS unsigned*)(C0.lds + LDSCTL_OFF))[u] = 0u;
    __syncthreads();
    volatile LAS unsigned* MISC = (volatile LAS unsigned*)(C0.lds + MISC_OFF);
    XcdBarrier bar = xcd_barrier_post((unsigned*)(args.ws + WS_CTL) + CW_BAR, MISC + 8, C0.wave);
#define SEAM() xcd_barrier(bar)
    { const Ctx C = phase_ctx(C0); const Args A = phase_args(args); p0_prologue(C, A); }
    SEAM();
    { const Ctx C = phase_ctx(C0); const Args A = phase_args(args); unsigned char* ws = A.ws;
        const int grp = C.bid >> 3; const bool conv_cu = (C.G == 256) && (grp % 5 == 4);
        if (!conv_cu) {
            const int Gg = C.G == 256 ? 208 : C.G, cg = C.G == 256 ? C.bid - 8 * ((grp + 1) / 5) : C.bid;
            pg8::Gemm g{(const bf16*)(ws + WS_HN), (const bf16*)(ws + WS_WIN), SEQ, NPROJ, DM}; pg8::StaticOrder S; S.init(SEQ, NPROJ, Gg, cg);
            pg8::EpiInProj E{(bf16*)(ws + WS_U), (bf16*)(ws + WS_Q), (bf16*)(ws + WS_K), (bf16*)(ws + WS_V), (bf16*)(ws + WS_SGP), (bf16*)(ws + WS_SGA), (float*)(ws + WS_KPART)};
            pg8::gemm_phase<pg8::EpiInProj, pg8::StaticOrder, true, true>(ring, g, S, E, C.wave);
            conv_tiles<false>(C, A, cg * NWAVES + C.wave);
        } else conv_tiles<true>(C, A, 0);
    }
    SEAM();
    { const Ctx C = phase_ctx(C0); const Args A = phase_args(args); unsigned char* ws = A.ws;
        for (int L = C.bid; L < 128; L += C.G) pool_mixed_tile(C, A, L);
        VM_WAIT(); __syncthreads();
        pg8::Gemm g{(const bf16*)(ws + WS_MIXED), (const bf16*)(ws + WS_WPOOL), 4 * SEQ, 256, 256}; pg8::PoolOrder S{C.G, C.bid};
        pg8::EpiPool E{(bf16*)(ws + WS_YP), A.in[4]};
        pg8::gemm_phase<pg8::EpiPool, pg8::PoolOrder, false, true>(ring, g, S, E, C.wave);
        p_gate_mfma(C, A);
    }
    SEAM();
    { const Ctx C = phase_ctx(C0); const Args A = phase_args(args); p_attn(C, A, 0); }
    SEAM();
    { const Ctx C = phase_ctx(C0); const Args A = phase_args(args); p_combine(C, A); }
    SEAM();
    { const Ctx C = phase_ctx(C0); const Args A = phase_args(args); unsigned char* ws = A.ws;
        pg8::Gemm g{(const bf16*)(ws + WS_YP), (const bf16*)(ws + WS_WBP), 2 * SEQ, 2 * DM, PW}; pg8::BranchOrder S; S.init(C.G, C.bid);
        pg8::EpiBranch E{(const bf16*)(ws + WS_SGP), (bf16*)(ws + WS_TMP), (long)((WS_SGA - WS_SGP) / 2), ((long)WS_HN - (long)WS_TMP) / 2};
        pg8::gemm_phase<pg8::EpiBranch, pg8::BranchOrder, true, true>(ring, g, S, E, C.wave);
    }
    SEAM();
    { const Ctx C = phase_ctx(C0); const Args A = phase_args(args); unsigned char* ws = A.ws;
        pg8::Gemm g{(const bf16*)(ws + WS_HN), (const bf16*)(ws + WS_WOUT), SEQ, DM, DM}; pg8::StaticOrder S; S.init(SEQ, DM, C.G, C.bid);
        pg8::EpiResid E{A.in[0], (bf16*)(ws + WS_X1)};
        pg8::gemm_phase<pg8::EpiResid, pg8::StaticOrder, true, true>(ring, g, S, E, C.wave);
    }
    SEAM();
    { const Ctx C = phase_ctx(C0); const Args A = phase_args(args); BarRef br{&bar}; p_router(C, A, br); }
    SEAM();
    { const Ctx C = phase_ctx(C0); const Args A = phase_args(args); unsigned char* ws = A.ws;
        pg8::Gemm g{(const bf16*)(ws + WS_HN), (const bf16*)(ws + WS_WGU), 0, 0, DM, (const int*)(ws + WS_ROWTOK)}; pg8::MoeOrder S{(const unsigned*)(ws + WS_CTL) + CW_CNT, 0, C.G, C.bid};
        pg8::EpiGU E{(bf16*)(ws + WS_HID), (const float*)(ws + WS_ROWW)};
        pg8::gemm_phase<pg8::EpiGU, pg8::MoeOrder, true, true, false, true>(ring, g, S, E, C.wave);
    }
    SEAM();
    { const Ctx C = phase_ctx(C0); const Args A = phase_args(args); unsigned char* ws = A.ws;
        { pg8::Gemm g{(const bf16*)(ws + WS_HN), (const bf16*)(ws + WS_WGU), 0, 0, DM, (const int*)(ws + WS_ROWTOK)}; pg8::MoeOrder S{(const unsigned*)(ws + WS_CTL) + CW_CNT, 1, C.G, C.bid};
          pg8::EpiGU E{(bf16*)(ws + WS_HID), (const float*)(ws + WS_ROWW)};
          pg8::gemm_phase<pg8::EpiGU, pg8::MoeOrder, true, true, false, true>(ring, g, S, E, C.wave); }
        { pg8::Gemm g{(const bf16*)(ws + WS_HID), (const bf16*)(ws + WS_WDN), 0, 0, DE}; pg8::MoeOrder S{(const unsigned*)(ws + WS_CTL) + CW_CNT, 2, C.G, C.bid};
          pg8::EpiDown E{(bf16*)(ws + WS_Y)};
          pg8::gemm_phase<pg8::EpiDown, pg8::MoeOrder, true, true>(ring, g, S, E, C.wave); }
    }
    SEAM();
    { const Ctx C = phase_ctx(C0); const Args A = phase_args(args); unsigned char* ws = A.ws;
        pg8::Gemm g{(const bf16*)(ws + WS_HID), (const bf16*)(ws + WS_WDN), 0, 0, DE}; pg8::MoeOrder S{(const unsigned*)(ws + WS_CTL) + CW_CNT, 3, C.G, C.bid};
        pg8::EpiDown E{(bf16*)(ws + WS_Y)};
        pg8::gemm_phase<pg8::EpiDown, pg8::MoeOrder, true, true>(ring, g, S, E, C.wave);
    }
    SEAM();
    { const Ctx C = phase_ctx(C0); const Args A = phase_args(args); p8_final(C, A); }
#undef SEAM
}

#ifndef MK_N_LAUNCHES
#define MK_N_LAUNCHES 1
#endif
extern "C" void kernel_launch(void* const* d_in, const int* in_sizes, int n_in, void* d_out, int out_size, void* d_ws, size_t ws_size, hipStream_t stream) {
    static int grid = 0;
    if (grid == 0) {
        if (n_in != 17 || out_size != SEQ * DM || ws_size < WS_END) { fprintf(stderr, "kernel_launch: unexpected shapes (n_in %d out %d ws %zu)\n", n_in, out_size, ws_size); grid = -1; return; }
        int dev = 0, cus = 0, per_cu = 0;
        if (hipGetDevice(&dev) != hipSuccess || hipDeviceGetAttribute(&cus, hipDeviceAttributeMultiprocessorCount, dev) != hipSuccess) { grid = -1; return; }
        if (hipFuncSetAttribute((const void*)mk_fwd, hipFuncAttributeMaxDynamicSharedMemorySize, LDS_BYTES) != hipSuccess) { fprintf(stderr, "kernel_launch: hipFuncSetAttribute failed\n"); grid = -1; return; }
        if (hipOccupancyMaxActiveBlocksPerMultiprocessor(&per_cu, (const void*)mk_fwd, NTHREADS, LDS_BYTES) != hipSuccess || per_cu < 1) { fprintf(stderr, "kernel_launch: occupancy query failed (%d)\n", per_cu); (void)hipGetLastError(); per_cu = 1; }
        if (per_cu > 1) per_cu = 1;
        grid = cus * per_cu;
    }
    if (grid < 0) return;
    (void)hipMemsetAsync((char*)d_ws + WS_CTL, 0, CTL_ZERO_BYTES, stream);
    Args a{};
    for (int i = 0; i < 17; ++i) a.in[i] = (const float*)d_in[i];
    a.out = (float*)d_out; a.ws = (unsigned char*)d_ws;
    if (MK_N_LAUNCHES == 1) {
        a.ph_lo = 0; a.ph_hi = 0; void* kargs[] = {&a};
        hipError_t e = hipLaunchCooperativeKernel((const void*)mk_fwd, dim3(grid), dim3(NTHREADS), kargs, LDS_BYTES, stream);
        if (e != hipSuccess) fprintf(stderr, "kernel_launch: cooperative launch failed: %s (grid %d)\n", hipGetErrorString(e), grid);
    } else {
        fprintf(stderr, "kernel_launch: multi-launch build not supported in this version\n");
    }
}
```

```cpp
#include <hip/hip_runtime.h>
#include <cstdio>
#include <cstdint>

__device__ __forceinline__ int lane_id() { int l; asm volatile("v_mbcnt_lo_u32_b32 %0, -1, 0\n\tv_mbcnt_hi_u32_b32 %0, -1, %0" : "=v"(l)); return l; }
namespace pg8 {
#define PG8_LAS __attribute__((address_space(3)))
typedef unsigned short bf16_t;
typedef short bf16x8 __attribute__((ext_vector_type(8)));
typedef float f32x4 __attribute__((ext_vector_type(4)));
typedef unsigned u32x4 __attribute__((ext_vector_type(4)));
typedef unsigned u32x2 __attribute__((ext_vector_type(2)));
constexpr int BM = 256, BK = 64, HALF = 128, HTB = HALF * BK * 2  , STAGE_BYTES = 8 * HTB, NXCD = 8, WGM = 8;

__host__ __device__ __forceinline__ int lds_byte(int r, int c) { const int st = (r >> 4) * 2 + (c >> 5), rr = r & 15, cc = c & 31, ob = rr * 64 + cc * 2; return st * 1024 + (ob ^ (((ob >> 9) & 1) << 5)); }
__host__ __device__ __forceinline__ void stage_rc(int b, int& R, int& C) { const int st = b / 1024, sb = b % 1024, swz = sb ^ (((sb >> 9) & 1) << 5); R = (st >> 1) * 16 + swz / 64; C = (st & 1) * 32 + (swz % 64) / 2; }
__host__ __device__ __forceinline__ int perm32(int rho) { const int n = rho >> 4, i = rho & 15; return 8 * (i >> 2) + 4 * n + (i & 3); }

struct Unit { int pm, pn, row0, cnt, rows; };
struct Gemm { const bf16_t* A; const bf16_t* Bt; int M, N, K; const int* rowtok; };

struct StaticOrder {
    int nM, nN, nwg, G, c;
    __host__ __device__ void init(int M, int N, int G_, int c_) { nM = M / BM; nN = N / BM; nwg = nM * nN; G = G_; c = c_; }
    __host__ __device__ bool next(int i, Unit& u) const {
        const long L = (long)i * G + c; if (L >= nwg) return false;
        int wgid = (int)L; { const int q = nwg / NXCD, r = nwg % NXCD, xcd = wgid % NXCD, off = wgid / NXCD; wgid = (xcd < r ? xcd * (q + 1) : r * (q + 1) + (xcd - r) * q) + off; }
        const int nig = WGM * nN, gid = wgid / nig, fm = gid * WGM, gsz = (nM - fm) < WGM ? (nM - fm) : WGM;
        u.pm = fm + ((wgid % nig) % gsz); u.pn = (wgid % nig) / gsz; u.row0 = 0; u.cnt = 0; u.rows = 256; return true;
    }
    __device__ __forceinline__ void a_ready(const Unit&) const {}
    __device__ __forceinline__ void done(const Unit&) const {}
};

__device__ __forceinline__ unsigned cvt_pk_bf16(float lo, float hi) { unsigned r; asm volatile("v_cvt_pk_bf16_f32 %0, %1, %2" : "=v"(r) : "v"(lo), "v"(hi)); return r; }

template <class Epi, class Sched, bool ALIGN_EPI = false, bool SP2 = false, bool SKIP = false, bool GATHER = false>
__device__ __forceinline__ void gemm_phase(PG8_LAS unsigned char* lds, const Gemm g, const Sched& S, const Epi& E, int wave_in) {
    int tid_ = wave_in * 64 + lane_id(); asm volatile("" : "+v"(tid_));
    const int tid = tid_, wid = __builtin_amdgcn_readfirstlane(tid >> 6), lane = tid & 63, wr = wid >> 2, wc = wid & 3, fr = lane & 15, fq = lane >> 4;
    const int K = g.K, nt = K / BK;
    unsigned voffA[2], voffB[2];
#pragma unroll
    for (int i = 0; i < 2; ++i) { int R, C; stage_rc(tid * 16 + i * 8192, R, C); const int Rb = Epi::PERM ? ((R & ~31) + perm32(R & 31)) : R;
        voffA[i] = (unsigned)(R * K + C) * 2u; voffB[i] = (unsigned)(Rb * K + C) * 2u; }
    unsigned gvp[2];
    PG8_LAS unsigned* gtab = (PG8_LAS unsigned*)(lds + STAGE_BYTES);
    auto gather_toks = [&](const Unit& u, unsigned (&o)[2]) {
#pragma unroll
        for (int h = 0; h < 2; ++h) { unsigned tk_[2];
#pragma unroll
            for (int i = 0; i < 2; ++i) { int R, C; stage_rc(tid * 16 + i * 8192, R, C); const int slot = u.pm * BM - u.row0 + h * HALF + R;
                tk_[i] = slot < u.cnt ? (unsigned)g.rowtok[(u.pn >> 3) * 8192 + slot] : 0u; }
            o[h] = tk_[0] | (tk_[1] << 16); } };
    auto gather_off = [&](unsigned packed, int i) -> unsigned { int R, C; stage_rc(tid * 16 + i * 8192, R, C); const unsigned tok = i ? (packed >> 16) : (packed & 0xffffu); return (tok * (unsigned)K + (unsigned)C) * 2u; };
    const size_t kstep = (size_t)(BK * 2);
    const size_t hstep = (size_t)HALF * K * 2;
    const size_t tstep = 2 * hstep;
    const unsigned ldsw = (unsigned)wid * 1024u;
    const int aoff = lds_byte(wr * 64 + fr, fq * 8), boff = lds_byte(wc * 32 + fr, fq * 8);
#define PG8_SA(b, h) (((b) * 2 + (h)) * HTB)
#define PG8_SB(b, h) ((4 + (b) * 2 + (h)) * HTB)
#define PG8_STAGE(bufoff, gbase, voff) do { _Pragma("unroll") for (int _i = 0; _i < 2; ++_i) \
        __builtin_amdgcn_global_load_lds((const unsigned*)((const char*)(gbase) + (voff)[_i]), (PG8_LAS unsigned*)(lds + (bufoff) + ldsw + _i * 8192), 16, 0, 0); } while (0)
#define PG8_LDA(dst, b, h) do { _Pragma("unroll") for (int m = 0; m < 4; ++m) _Pragma("unroll") for (int k = 0; k < 2; ++k) dst[m][k] = *(const PG8_LAS bf16x8*)(lds + PG8_SA(b, h) + aoff + m * 2048 + k * 1024); } while (0)
#define PG8_LDB(dst, b, h) do { _Pragma("unroll") for (int n = 0; n < 2; ++n) _Pragma("unroll") for (int k = 0; k < 2; ++k) dst[n][k] = *(const PG8_LAS bf16x8*)(lds + PG8_SB(b, h) + boff + n * 2048 + k * 1024); } while (0)
#define PG8_MMA(ai, bj, At, Bt) do { __builtin_amdgcn_s_setprio(1); _Pragma("unroll") for (int m = 0; m < 4; ++m) { if (!SKIP || (ai) * 128 + wr * 64 + m * 16 < vrows) { _Pragma("unroll") for (int n = 0; n < 2; ++n) _Pragma("unroll") for (int k = 0; k < 2; ++k) \
        acc[ai][bj][m][n] = __builtin_amdgcn_mfma_f32_16x16x32_bf16(Bt[n][k], At[m][k], acc[ai][bj][m][n], 0, 0, 0); } } __builtin_amdgcn_s_setprio(0); } while (0)
#define PG8_WAIT_V(n) asm volatile("s_waitcnt vmcnt(" #n ")" ::: "memory")
#define PG8_WAIT_L(n) asm volatile("s_waitcnt lgkmcnt(" #n ")" ::: "memory")
#define PG8_BAR __builtin_amdgcn_s_barrier()
#define PG8_SCHED __builtin_amdgcn_sched_barrier(0)
    Unit cur, nxt; int ui = 0;
    if (!S.next(0, cur)) return;
    int vrows = cur.rows;
    f32x4 acc[2][2][4][2];
#pragma unroll
    for (int a = 0; a < 2; ++a)
#pragma unroll
        for (int b = 0; b < 2; ++b)
#pragma unroll
            for (int m = 0; m < 4; ++m)
#pragma unroll
                for (int n = 0; n < 2; ++n) acc[a][b][m][n] = (f32x4){0.f, 0.f, 0.f, 0.f};
    bf16x8 At[4][2], B0[2][2], B1[2][2];
    const char* cA = (const char*)g.A + (GATHER ? (size_t)0 : (size_t)cur.pm * tstep); const char* cB = (const char*)g.Bt + (size_t)cur.pn * tstep;
    if constexpr (GATHER) gather_toks(cur, gvp);
#define PG8_STAGE_A(bufoff, ptr, half, nextu) do { if constexpr (!GATHER) { PG8_STAGE(bufoff, (ptr) + ((half) ? hstep : 0), voffA); } else { \
        const unsigned p_ = (nextu) ? gtab[(half) * 512 + tid] : gvp[half]; unsigned o_[2]; o_[0] = gather_off(p_, 0); o_[1] = gather_off(p_, 1); PG8_STAGE(bufoff, ptr, o_); } } while (0)
    S.a_ready(cur);
    if constexpr (SP2) {
        PG8_STAGE(PG8_SB(0, 0), cB, voffB); PG8_STAGE(PG8_SB(0, 1), cB + hstep, voffB); PG8_STAGE_A(PG8_SA(0, 0), cA, 0, false); PG8_STAGE_A(PG8_SA(0, 1), cA, 1, false);
        if (wr == 1) PG8_BAR;
        PG8_WAIT_V(2); PG8_BAR;
        PG8_STAGE(PG8_SB(1, 0), cB + kstep, voffB); PG8_STAGE_A(PG8_SA(1, 0), cA + kstep, 0, false); PG8_STAGE(PG8_SB(1, 1), cB + hstep + kstep, voffB);
        PG8_WAIT_V(6); PG8_BAR;
    } else {
        PG8_STAGE(PG8_SB(0, 0), cB, voffB); PG8_STAGE(PG8_SA(0, 0), cA, voffA); PG8_STAGE(PG8_SB(0, 1), cB + hstep, voffB); PG8_STAGE(PG8_SA(0, 1), cA + hstep, voffA);
        if (wr == 1) PG8_BAR;
        PG8_WAIT_V(4); PG8_BAR;
        PG8_STAGE(PG8_SB(1, 0), cB + kstep, voffB); PG8_STAGE(PG8_SA(1, 0), cA + kstep, voffA); PG8_STAGE(PG8_SB(1, 1), cB + hstep + kstep, voffB);
        PG8_WAIT_V(6); PG8_BAR;
    }
    for (;;) {
        const bool has_next = S.next(ui + 1, nxt);
        const char* nA = (has_next && !GATHER) ? (const char*)g.A + (size_t)nxt.pm * tstep : cA;
        if constexpr (GATHER) { unsigned o_[2] = {gvp[0], gvp[1]}; if (has_next) gather_toks(nxt, o_); gtab[tid] = o_[0]; gtab[512 + tid] = o_[1]; } const char* nB = has_next ? (const char*)g.Bt + (size_t)nxt.pn * tstep : cB;
        for (int t = 0; t < nt; t += 2) {
            const bool last = (t == nt - 2);
            const char* a1 = cA + (size_t)(t + 1) * kstep;
            const char* a2 = last ? nA : cA + (size_t)(t + 2) * kstep; const char* b2 = last ? nB : cB + (size_t)(t + 2) * kstep;
            const char* a3 = a2 + kstep; const char* b3 = b2 + kstep;
            if (last && has_next) S.a_ready(nxt);
            if constexpr (SP2) {
            PG8_LDB(B0, 0, 0); PG8_LDB(B1, 0, 1); PG8_SCHED; PG8_LDA(At, 0, 0); PG8_STAGE_A(PG8_SA(1, 1), a1, 1, false);
            PG8_WAIT_V(8); PG8_WAIT_L(0); PG8_BAR; PG8_MMA(0, 0, At, B0); PG8_MMA(0, 1, At, B1); PG8_BAR; PG8_SCHED;
            PG8_LDA(At, 0, 1); PG8_STAGE(PG8_SB(0, 0), b2, voffB); PG8_STAGE(PG8_SB(0, 1), b2 + hstep, voffB); PG8_STAGE_A(PG8_SA(0, 0), a2, 0, last);
            PG8_WAIT_V(8); PG8_WAIT_L(0); PG8_BAR; PG8_MMA(1, 0, At, B0); PG8_MMA(1, 1, At, B1); PG8_BAR; PG8_SCHED;
            PG8_LDB(B0, 1, 0); PG8_LDB(B1, 1, 1); PG8_SCHED; PG8_LDA(At, 1, 0); PG8_STAGE_A(PG8_SA(0, 1), a2, 1, last);
            PG8_WAIT_V(8); PG8_WAIT_L(0); PG8_BAR; PG8_MMA(0, 0, At, B0); PG8_MMA(0, 1, At, B1); PG8_BAR; PG8_SCHED;
            PG8_LDA(At, 1, 1); PG8_STAGE(PG8_SB(1, 0), b3, voffB); PG8_STAGE(PG8_SB(1, 1), b3 + hstep, voffB); PG8_STAGE_A(PG8_SA(1, 0), a3, 0, last);
            PG8_WAIT_V(8); PG8_WAIT_L(0); PG8_BAR; PG8_MMA(1, 0, At, B0); PG8_MMA(1, 1, At, B1); PG8_BAR; PG8_SCHED;
            } else {
            PG8_LDB(B0, 0, 0); PG8_SCHED; PG8_LDA(At, 0, 0); PG8_STAGE(PG8_SA(1, 1), a1 + hstep, voffA);
            PG8_WAIT_L(8); PG8_BAR; PG8_WAIT_L(0); PG8_MMA(0, 0, At, B0); PG8_BAR; PG8_SCHED;
            PG8_LDB(B1, 0, 1); PG8_STAGE(PG8_SB(0, 0), b2, voffB);
            PG8_BAR; PG8_WAIT_L(0); PG8_MMA(0, 1, At, B1); PG8_BAR;
            PG8_LDA(At, 0, 1); PG8_STAGE(PG8_SA(0, 0), a2, voffA);
            PG8_BAR; PG8_WAIT_L(0); PG8_MMA(1, 0, At, B0); PG8_BAR; PG8_SCHED;
            PG8_STAGE(PG8_SB(0, 1), b2 + hstep, voffB);
            PG8_WAIT_V(6); PG8_BAR; PG8_MMA(1, 1, At, B1); PG8_BAR;
            PG8_LDB(B0, 1, 0); PG8_SCHED; PG8_LDA(At, 1, 0); PG8_STAGE(PG8_SA(0, 1), a2 + hstep, voffA);
            PG8_WAIT_L(8); PG8_BAR; PG8_WAIT_L(0); PG8_MMA(0, 0, At, B0); PG8_BAR; PG8_SCHED;
            PG8_LDB(B1, 1, 1); PG8_STAGE(PG8_SB(1, 0), b3, voffB);
            PG8_BAR; PG8_WAIT_L(0); PG8_MMA(0, 1, At, B1); PG8_BAR;
            PG8_LDA(At, 1, 1); PG8_STAGE(PG8_SA(1, 0), a3, voffA);
            PG8_BAR; PG8_WAIT_L(0); PG8_MMA(1, 0, At, B0); PG8_BAR; PG8_SCHED;
            PG8_STAGE(PG8_SB(1, 1), b3 + hstep, voffB);
            PG8_WAIT_V(6); PG8_BAR; PG8_MMA(1, 1, At, B1); PG8_BAR;
            }
        }
        if constexpr (ALIGN_EPI) { if (wr == 0) PG8_BAR; }
        if constexpr (!Epi::AFTER_DRAIN) { E(acc, cur, wr, wc, fr, fq); S.done(cur); }
        if (!has_next) break;
#pragma unroll
        for (int a = 0; a < 2; ++a)
#pragma unroll
            for (int b = 0; b < 2; ++b)
#pragma unroll
                for (int m = 0; m < 4; ++m)
#pragma unroll
                    for (int n = 0; n < 2; ++n) acc[a][b][m][n] = (f32x4){0.f, 0.f, 0.f, 0.f};
        cur = nxt; cA = nA; cB = nB; ++ui; vrows = cur.rows;
        if constexpr (GATHER) { gvp[0] = gtab[tid]; gvp[1] = gtab[512 + tid]; }
        if constexpr (ALIGN_EPI) { if (wr == 1) PG8_BAR; }
    }
    PG8_WAIT_V(0);
    if constexpr (!ALIGN_EPI) { if (wr == 0) PG8_BAR; }
    PG8_BAR;
    if constexpr (Epi::AFTER_DRAIN) { E.fused(acc, cur, wr, wc, fr, fq, lds, wid, lane); S.done(cur); }
#undef PG8_STAGE_A
#undef PG8_SA
#undef PG8_SB
#undef PG8_STAGE
#undef PG8_LDA
#undef PG8_LDB
#undef PG8_MMA
#undef PG8_WAIT_V
#undef PG8_WAIT_L
#undef PG8_BAR
#undef PG8_SCHED
}
}

constexpr int SEQ = 8192, DM = 2048, NPROJ = 8192, PW = 1024, AW = 1024, NH = 8, HD = 128, MBLK = 256, NBLK = 32;
constexpr int NE = 16, DE = 1024, ECAP = 8192;
constexpr float RMS_EPS = 1e-6f;
constexpr int NWAVES = 8, NTHREADS = 512;

#define GAS __attribute__((address_space(1)))
#define LAS __attribute__((address_space(3)))
typedef unsigned short bf16;
typedef unsigned v4u __attribute__((ext_vector_type(4)));
typedef unsigned v2u __attribute__((ext_vector_type(2)));
typedef float f32x4 __attribute__((ext_vector_type(4)));
typedef float f32x2 __attribute__((ext_vector_type(2)));
typedef short bf16x8 __attribute__((ext_vector_type(8)));
typedef GAS unsigned gu32;
#define RLX_AGENT __ATOMIC_RELAXED, __HIP_MEMORY_SCOPE_AGENT
#define LDS_WAIT() asm volatile("s_waitcnt lgkmcnt(0)" ::: "memory")
#define VM_WAIT() asm volatile("s_waitcnt vmcnt(0)" ::: "memory")
__device__ __forceinline__ unsigned f2bf(float f) { unsigned u = __builtin_bit_cast(unsigned, f); return (u + 0x7fffu + ((u >> 16) & 1u)) >> 16; }
__device__ __forceinline__ unsigned pk2(float lo, float hi) { unsigned r; asm("v_cvt_pk_bf16_f32 %0, %1, %2" : "=v"(r) : "v"(lo), "v"(hi)); return r; }
__device__ __forceinline__ float bf_lo(unsigned w) { return __builtin_bit_cast(float, w << 16); }
__device__ __forceinline__ float bf_hi(unsigned w) { return __builtin_bit_cast(float, w & 0xffff0000u); }
__device__ __forceinline__ float bf2f(bf16 b) { return __builtin_bit_cast(float, (unsigned)b << 16); }
__device__ __forceinline__ float shx(float v, int o, int lane) { return __builtin_bit_cast(float, __builtin_amdgcn_ds_bpermute((lane ^ o) << 2, __builtin_bit_cast(int, v))); }
__device__ __forceinline__ float wave_sum(float v) {
    const int l = lane_id();
#pragma unroll
    for (int o = 1; o < 64; o <<= 1) v += shx(v, o, l);
    return v;
}
__device__ __forceinline__ float wave_max(float v) {
    const int l = lane_id();
#pragma unroll
    for (int o = 1; o < 64; o <<= 1) v = fmaxf(v, shx(v, o, l));
    return v;
}
__device__ __forceinline__ float sigmoidf_(float x) { return __builtin_amdgcn_rcpf(1.0f + __expf(-x)); }

constexpr size_t MiB = 1u << 20;
constexpr size_t WS_CTL = 0, CTL_ZERO_BYTES = 128 * 1024;
constexpr size_t WS_TOKE = 1 * MiB;
constexpr size_t WS_TOKS = WS_TOKE + 65536;
constexpr size_t WS_ROWTOK = WS_TOKS + 65536;
constexpr size_t WS_ROWW = WS_ROWTOK + 524288;
constexpr size_t WS_SEL = 3 * MiB;
constexpr size_t WS_KMEAN = WS_SEL + 262144;
constexpr size_t WS_KMH = WS_KMEAN + 131072, WS_KML = WS_KMH + 65536;
constexpr size_t WS_KPART = WS_KML + 65536;
constexpr size_t WS_WIN = 4 * MiB, WS_WPOOL = 36 * MiB, WS_WBP = 37 * MiB, WS_WBA = 41 * MiB, WS_WOUT = 45 * MiB, WS_WGU = 53 * MiB, WS_WDN = 181 * MiB;
constexpr size_t WS_HN = 245 * MiB;
constexpr size_t WS_U = 277 * MiB, WS_Q = 293 * MiB, WS_K = 309 * MiB, WS_V = 325 * MiB, WS_SGP = 341 * MiB, WS_SGA = 373 * MiB;
constexpr size_t WS_YP = 405 * MiB, WS_AO = 421 * MiB, WS_MIXED = 437 * MiB, WS_PART = 453 * MiB;
constexpr size_t WS_PART3 = 245 * MiB, WS_ML = 261 * MiB;
constexpr size_t WS_TMP = 437 * MiB;
constexpr size_t WS_X1 = 293 * MiB;
constexpr size_t WS_H2P = 277 * MiB, WS_HID = 357 * MiB, WS_Y = 397 * MiB, WS_END = 502 * MiB;
constexpr int CW_BAR = 4096;
constexpr int CW_ATTN = 8192;
constexpr int CW_CONV = 8192 + 512;
constexpr int CW_MOEQ = 8192 + 1024;
constexpr int CW_CNT = 16384;

namespace pg8 {
struct EpiInProj {
    static constexpr bool PERM = true, AFTER_DRAIN = false;
    bf16_t *u, *q, *k, *v, *sgp, *sga; float* kpart;
    __device__ __forceinline__ void operator()(const f32x4 (&acc)[2][2][4][2], const Unit& un, int wr, int wc, int fr, int fq) const {
        if (un.pn >= 8 && un.pn < 12) {
#pragma unroll
            for (int bj = 0; bj < 2; ++bj)
#pragma unroll
                for (int n = 0; n < 2; ++n) { f32x4 s = acc[0][bj][0][n];
#pragma unroll
                    for (int m = 1; m < 4; ++m) s += acc[0][bj][m][n];
#pragma unroll
                    for (int m = 0; m < 4; ++m) s += acc[1][bj][m][n];
#pragma unroll
                    for (int o = 1; o < 16; o <<= 1) { s.x += __shfl_xor(s.x, o); s.y += __shfl_xor(s.y, o); s.z += __shfl_xor(s.z, o); s.w += __shfl_xor(s.w, o); }
                    if (fr == 0) *(f32x4*)(kpart + (size_t)(un.pm * 2 + wr) * 1024 + (un.pn - 8) * 256 + bj * HALF + wc * 32 + 8 * fq + 4 * n) = s; }
        }
        const int pn = un.pn; bf16_t* base; int ldc, colt; const bool sig = pn >= 16;
        if (pn < 16) { base = pn < 4 ? u : pn < 8 ? q : pn < 12 ? k : v; ldc = 1024; colt = (pn & 3) * 256; }
        else { base = pn < 24 ? sgp : sga; ldc = 2048; colt = (pn & 7) * 256; }
        const int row0 = un.pm * BM + wr * 64 + fr, col0 = colt + wc * 32 + 8 * fq;
#pragma unroll
        for (int ai = 0; ai < 2; ++ai)
#pragma unroll
            for (int m = 0; m < 4; ++m) { bf16_t* rowp = base + (size_t)(row0 + ai * HALF + m * 16) * ldc + col0;
#pragma unroll
                for (int bj = 0; bj < 2; ++bj) { f32x4 v0 = acc[ai][bj][m][0], v1 = acc[ai][bj][m][1];
                    if (sig) {
#pragma unroll
                        for (int i = 0; i < 4; ++i) { v0[i] = __builtin_amdgcn_rcpf(1.0f + __expf(-v0[i])); v1[i] = __builtin_amdgcn_rcpf(1.0f + __expf(-v1[i])); } }
                    u32x4 w; w.x = cvt_pk_bf16(v0[0], v0[1]); w.y = cvt_pk_bf16(v0[2], v0[3]); w.z = cvt_pk_bf16(v1[0], v1[1]); w.w = cvt_pk_bf16(v1[2], v1[3]);
                    *(u32x4*)(rowp + bj * HALF) = w; } }
    }
};
struct EpiPool {
    static constexpr bool PERM = true, AFTER_DRAIN = false;
    bf16_t* yp; const float* scale;
    __device__ __forceinline__ void operator()(const f32x4 (&acc)[2][2][4][2], const Unit& un, int wr, int wc, int fr, int fq) const {
        const int g = un.pn, row0 = (un.pm & 31) * BM + wr * 64 + fr, col0 = g * 256 + wc * 32 + 8 * fq;
#pragma unroll
        for (int bj = 0; bj < 2; ++bj) { const f32x4 s0 = *(const f32x4*)(scale + col0 + bj * HALF), s1 = *(const f32x4*)(scale + col0 + bj * HALF + 4);
#pragma unroll
            for (int ai = 0; ai < 2; ++ai)
#pragma unroll
                for (int m = 0; m < 4; ++m) { bf16_t* rowp = yp + (size_t)(row0 + ai * HALF + m * 16) * 1024 + col0 + bj * HALF;
                    const f32x4 v0 = acc[ai][bj][m][0] * s0, v1 = acc[ai][bj][m][1] * s1;
                    u32x4 w; w.x = cvt_pk_bf16(v0[0], v0[1]); w.y = cvt_pk_bf16(v0[2], v0[3]); w.z = cvt_pk_bf16(v1[0], v1[1]); w.w = cvt_pk_bf16(v1[2], v1[3]);
                    *(u32x4*)rowp = w; } }
    }
};
__device__ __forceinline__ void unpack8(const u32x4 w, float (&f)[8]) {
    f[0] = __builtin_bit_cast(float, w.x << 16); f[1] = __builtin_bit_cast(float, w.x & 0xffff0000u);
    f[2] = __builtin_bit_cast(float, w.y << 16); f[3] = __builtin_bit_cast(float, w.y & 0xffff0000u);
    f[4] = __builtin_bit_cast(float, w.z << 16); f[5] = __builtin_bit_cast(float, w.z & 0xffff0000u);
    f[6] = __builtin_bit_cast(float, w.w << 16); f[7] = __builtin_bit_cast(float, w.w & 0xffff0000u);
}
struct EpiBranch {
    static constexpr bool PERM = true, AFTER_DRAIN = false;
    const bf16_t* sgp; bf16_t* tmp; long sg_step, out_step;
    __device__ __forceinline__ void operator()(const f32x4 (&acc)[2][2][4][2], const Unit& un, int wr, int wc, int fr, int fq) const {
        const bool second = un.pm >= 32; const int pm = second ? un.pm - 32 : un.pm, pn = second ? un.pn - 8 : un.pn;
        const bf16_t* sg = sgp + (second ? sg_step : 0); bf16_t* outp = tmp + (second ? out_step : 0);
        const int row0 = pm * BM + wr * 64 + fr, col0 = pn * BM + wc * 32 + 8 * fq;
#pragma unroll
        for (int ai = 0; ai < 2; ++ai) { u32x4 gv[4][2], tv[4][2];
#pragma unroll
            for (int m = 0; m < 4; ++m)
#pragma unroll
                for (int bj = 0; bj < 2; ++bj) gv[m][bj] = *(const u32x4*)(sg + (size_t)(row0 + ai * HALF + m * 16) * 2048 + col0 + bj * HALF);
            if (second) {
#pragma unroll
                for (int m = 0; m < 4; ++m)
#pragma unroll
                    for (int bj = 0; bj < 2; ++bj) tv[m][bj] = *(const u32x4*)(tmp + (size_t)(row0 + ai * HALF + m * 16) * 2048 + col0 + bj * HALF);
            } else {
#pragma unroll
                for (int m = 0; m < 4; ++m)
#pragma unroll
                    for (int bj = 0; bj < 2; ++bj) tv[m][bj] = u32x4{0u, 0u, 0u, 0u};
            }
#pragma unroll
            for (int m = 0; m < 4; ++m)
#pragma unroll
                for (int bj = 0; bj < 2; ++bj) { float g[8], t[8]; unpack8(gv[m][bj], g); unpack8(tv[m][bj], t);
                    const f32x4 a0 = acc[ai][bj][m][0], a1 = acc[ai][bj][m][1];
                    const float r[8] = {a0[0] * g[0] + t[0], a0[1] * g[1] + t[1], a0[2] * g[2] + t[2], a0[3] * g[3] + t[3], a1[0] * g[4] + t[4], a1[1] * g[5] + t[5], a1[2] * g[6] + t[6], a1[3] * g[7] + t[7]};
                    u32x4 w; w.x = cvt_pk_bf16(r[0], r[1]); w.y = cvt_pk_bf16(r[2], r[3]); w.z = cvt_pk_bf16(r[4], r[5]); w.w = cvt_pk_bf16(r[6], r[7]);
                    *(u32x4*)(outp + (size_t)(row0 + ai * HALF + m * 16) * 2048 + col0 + bj * HALF) = w; } }
    }
};
struct BranchOrder {
    StaticOrder so; int nc;
    __device__ __forceinline__ void init(int G, int c) { so.init(8192, 2048, G, c); nc = c < so.nwg ? (so.nwg - 1 - c) / G + 1 : 0; }
    __device__ __forceinline__ bool next(int i, Unit& u) const {
        if (i >= 2 * nc) return false; const bool second = i >= nc; (void)so.next(second ? i - nc : i, u); if (second) { u.pm += 32; u.pn += 8; } return true; }
    __device__ __forceinline__ void a_ready(const Unit&) const {}
    __device__ __forceinline__ void done(const Unit&) const {}
};
struct EpiResid {
    static constexpr bool PERM = true, AFTER_DRAIN = false;
    const float* x; bf16_t* x1;
    __device__ __forceinline__ void operator()(const f32x4 (&acc)[2][2][4][2], const Unit& un, int wr, int wc, int fr, int fq) const {
        const int row0 = un.pm * BM + wr * 64 + fr, col0 = un.pn * BM + wc * 32 + 8 * fq;
#pragma unroll
        for (int ai = 0; ai < 2; ++ai) { f32x4 xv[4][2][2];
#pragma unroll
            for (int m = 0; m < 4; ++m)
#pragma unroll
                for (int bj = 0; bj < 2; ++bj)
#pragma unroll
                    for (int n = 0; n < 2; ++n) xv[m][bj][n] = *(const f32x4*)(x + (size_t)(row0 + ai * HALF + m * 16) * 2048 + col0 + bj * HALF + n * 4);
#pragma unroll
            for (int m = 0; m < 4; ++m)
#pragma unroll
                for (int bj = 0; bj < 2; ++bj) { const f32x4 v0 = xv[m][bj][0] + acc[ai][bj][m][0], v1 = xv[m][bj][1] + acc[ai][bj][m][1];
                    u32x4 w; w.x = cvt_pk_bf16(v0[0], v0[1]); w.y = cvt_pk_bf16(v0[2], v0[3]); w.z = cvt_pk_bf16(v1[0], v1[1]); w.w = cvt_pk_bf16(v1[2], v1[3]);
                    *(u32x4*)(x1 + (size_t)(row0 + ai * HALF + m * 16) * 2048 + col0 + bj * HALF) = w; } }
    }
};
struct EpiGU {
    static constexpr bool PERM = false, AFTER_DRAIN = false;
    bf16_t* hid; const float* roww;
    __device__ __forceinline__ void operator()(const f32x4 (&acc)[2][2][4][2], const Unit& un, int wr, int wc, int fr, int fq) const {
        const int e = un.pn >> 3, pnl = un.pn & 7; const int row0 = un.pm * BM + wr * 64 + fr, col0 = pnl * 128 + wc * 16 + 4 * fq;
        float wv[2][4];
#pragma unroll
        for (int ai = 0; ai < 2; ++ai)
#pragma unroll
            for (int m = 0; m < 4; ++m) { const int slot = row0 + ai * HALF + m * 16 - un.row0; wv[ai][m] = slot < un.cnt ? roww[e * ECAP + slot] : 0.f; }
#pragma unroll
        for (int ai = 0; ai < 2; ++ai)
#pragma unroll
            for (int m = 0; m < 4; ++m) { const int row = row0 + ai * HALF + m * 16; const float w = wv[ai][m];
#pragma unroll
                for (int bj = 0; bj < 2; ++bj) { const f32x4 a = acc[ai][bj][m][0], uu = acc[ai][bj][m][1]; float h[4];
#pragma unroll
                    for (int i = 0; i < 4; ++i) h[i] = a[i] * __builtin_amdgcn_rcpf(1.0f + __expf(-a[i])) * uu[i] * w;
                    u32x2 o; o.x = cvt_pk_bf16(h[0], h[1]); o.y = cvt_pk_bf16(h[2], h[3]);
                    *(u32x2*)(hid + (size_t)row * DE_ + col0 + bj * 64) = o; } }
    }
    static constexpr int DE_ = 1024;
};
struct EpiDown {
    static constexpr bool PERM = true, AFTER_DRAIN = false;
    bf16_t* y;
    __device__ __forceinline__ void operator()(const f32x4 (&acc)[2][2][4][2], const Unit& un, int wr, int wc, int fr, int fq) const {
        const int pnl = un.pn & 7; const int row0 = un.pm * BM + wr * 64 + fr, col0 = pnl * 256 + wc * 32 + 8 * fq;
#pragma unroll
        for (int ai = 0; ai < 2; ++ai)
#pragma unroll
            for (int m = 0; m < 4; ++m) { bf16_t* rowp = y + (size_t)(row0 + ai * HALF + m * 16) * 2048 + col0;
#pragma unroll
                for (int bj = 0; bj < 2; ++bj) { const f32x4 v0 = acc[ai][bj][m][0], v1 = acc[ai][bj][m][1];
                    u32x4 w; w.x = cvt_pk_bf16(v0[0], v0[1]); w.y = cvt_pk_bf16(v0[2], v0[3]); w.z = cvt_pk_bf16(v1[0], v1[1]); w.w = cvt_pk_bf16(v1[2], v1[3]);
                    *(u32x4*)(rowp + bj * HALF) = w; } }
    }
};
struct PoolOrder {
    int G, c;
    __device__ __forceinline__ bool next(int i, Unit& u) const { const int L = i * G + c; if (L >= 128) return false; u.pm = L; u.pn = L >> 5; u.row0 = 0; u.cnt = 0; u.rows = 256; return true; }
    __device__ __forceinline__ void a_ready(const Unit&) const {}
    __device__ __forceinline__ void done(const Unit&) const {}
};
struct MoeOrder {
    const unsigned* cnt; int mode, G, c;
    __device__ __forceinline__ bool next(int i, Unit& u) const {
        const int lane = lane_id();
        unsigned cv = 0; if (lane < NE_) cv = __hip_atomic_load(cnt + 64 * lane, __ATOMIC_RELAXED, __HIP_MEMORY_SCOPE_AGENT);
        const int tiles = (int)((cv + 255u) >> 8); int incl = tiles;
#pragma unroll
        for (int o = 1; o < 16; o <<= 1) { const int t = __shfl_up(incl, o); if (lane >= o) incl += t; }
        const int Ttot = __shfl(incl, 15); int L = -1;
        if (G == 256 && Ttot >= 64) {
            const int n3 = 8 * (Ttot - 64), Gp = G - n3;
            if (mode == 0) { const int l = i * G + c; if (l < 512) L = l; }
            else if (mode == 1) { if (i == 0 && c < n3) L = 512 + c; }
            else if (mode == 2) { if (c >= n3 && i < 2) L = i * Gp + (c - n3); }
            else { const int r = i * G + c; if (r < 3 * n3) L = r < 2 * n3 ? 2 * Gp + r : 512 + (r - 2 * n3); }
        } else {
            if (mode == 0 || mode == 3) { const int l = i * G + c; if (l < 8 * Ttot) L = l; }
        }
        if (L < 0) return false;
        const int T = L >> 3;
        const int e = __popcll(__ballot(lane < NE_ && incl <= T));
        u.pm = __builtin_amdgcn_readfirstlane(T); u.pn = __builtin_amdgcn_readfirstlane(e * 8 + (L & 7)); u.row0 = __builtin_amdgcn_readfirstlane(__shfl(incl - tiles, e) * 256);
        u.cnt = __builtin_amdgcn_readfirstlane((int)__shfl((int)cv, e)); u.rows = 256; return true;
    }
    __device__ __forceinline__ void a_ready(const Unit&) const {}
    __device__ __forceinline__ void done(const Unit&) const {}
    static constexpr int NE_ = 16;
};
}

#define XB_TMO      128
#define XB_XCNT(j)  (256  + 64 * (j))
#define XB_XSUB(j)  (1280 + 64 * (j))
#define XB_XGEN(j)  (2304 + 64 * (j))
#define XB_TOP      3328
#define XB_TOPGEN   3392
#define XCD_BAR_WORDS 3456
#define XB_SPIN_CAP (1u << 18)

__device__ __forceinline__ unsigned xb_ld(unsigned* p)              { return __hip_atomic_load(p, __ATOMIC_RELAXED, __HIP_MEMORY_SCOPE_AGENT); }
__device__ __forceinline__ unsigned xb_add(unsigned* p, unsigned v) { return __hip_atomic_fetch_add(p, v, __ATOMIC_RELAXED, __HIP_MEMORY_SCOPE_AGENT); }
__device__ __forceinline__ unsigned xb_xcc_id() { return (unsigned)__builtin_amdgcn_s_getreg((3 << 11) | 20) & 0xFu; }
#define XB_SPIN(cond, bar) do { unsigned _sp = 0; while (cond) { __builtin_amdgcn_s_sleep(1); \
    if ((++_sp & 255u) == 0u) { if (xb_ld(&(bar)[XB_TMO])) break; if (_sp > XB_SPIN_CAP) { atomicAdd(&(bar)[XB_TMO], 1u); break; } } } } while (0)

struct XcdBarrier {
    int wave;
    unsigned* bar; unsigned x;
    volatile LAS unsigned* st;
};

__device__ __forceinline__ XcdBarrier xcd_barrier_post(unsigned* bar, volatile LAS unsigned* st, int wave) {
    XcdBarrier b; b.wave = wave; b.bar = bar; b.x = xb_xcc_id(); b.st = st;
    if (b.wave == 0 && lane_id() == 0) (void)xb_add(&bar[XB_XCNT(b.x)], 1u);
    return b;
}
__device__ __forceinline__ void xcd_barrier_complete(unsigned* bar, unsigned x, unsigned& nloc, unsigned& nx) {
    const unsigned G = gridDim.x * gridDim.y * gridDim.z;
    unsigned sum, cnt, mine, sp = 0u;
    for (;;) {
        sum = 0u; cnt = 0u; mine = 0u;
#pragma unroll
        for (unsigned j = 0; j < 16; ++j) { const unsigned c = xb_ld(&bar[XB_XCNT(j)]); sum += c; cnt += (c > 0u) ? 1u : 0u; mine = (j == x) ? c : mine; }
        if (sum == G) break;
        __builtin_amdgcn_s_sleep(1);
        if ((++sp & 255u) == 0u) { if (xb_ld(&bar[XB_TMO])) break; if (sp > XB_SPIN_CAP) { atomicAdd(&bar[XB_TMO], 1u); break; } }
    }
    nloc = mine > 0u ? mine : 1u; nx = cnt > 0u ? cnt : 1u;
}

__device__ __forceinline__ void xcd_barrier(const XcdBarrier& b) {
    asm volatile("s_waitcnt vmcnt(0)" ::: "memory");
    __syncthreads();
    if (b.wave == 0 && lane_id() == 0) {
        unsigned* bar = b.bar;
        __builtin_amdgcn_s_waitcnt(0);
        unsigned nloc = b.st[0], nx = b.st[1];
        if (nloc == 0u) { xcd_barrier_complete(bar, b.x, nloc, nx); b.st[0] = nloc; b.st[1] = nx; }
        const unsigned old = xb_add(&bar[XB_XSUB(b.x)], 1u);
        const unsigned gen = old / nloc;
        if (old + 1u == (gen + 1u) * nloc) {
            __builtin_amdgcn_fence(__ATOMIC_RELEASE, "agent");
            asm volatile("s_waitcnt vmcnt(0)" ::: "memory");
            const unsigned og = xb_add(&bar[XB_TOP], 1u);
            const unsigned tg = og / nx;
            if (og + 1u == (tg + 1u) * nx) xb_add(&bar[XB_TOPGEN], 1u);
            else XB_SPIN(xb_ld(&bar[XB_TOPGEN]) == tg, bar);
            __builtin_amdgcn_fence(__ATOMIC_ACQUIRE, "agent");
            xb_add(&bar[XB_XGEN(b.x)], 1u);
            asm volatile("s_waitcnt vmcnt(0)" ::: "memory");
        } else {
            XB_SPIN(xb_ld(&bar[XB_XGEN(b.x)]) == gen, bar);
            __builtin_amdgcn_fence(__ATOMIC_ACQUIRE, "agent");
            asm volatile("s_waitcnt vmcnt(0)" ::: "memory");
        }
    }
    __syncthreads();
}


constexpr int RING_OFF = 0, RING_BYTES = 139264;
constexpr int LDSCTL_OFF = RING_BYTES, MISC_OFF = LDSCTL_OFF + 320;
constexpr int LDS_BYTES = 147456;

struct Args { const float* in[17]; float* out; unsigned char* ws; int ph_lo, ph_hi; };

struct Ctx {
    LAS unsigned char* lds; int tid, lane, wave, G, bid, gw, ngw;
};

struct TrDesc { const float* src; bf16* dst; int N, K, mode, n0; };
__device__ __forceinline__ TrDesc tr_desc(const float* W, int K, int N, bf16* WT, int mode, int tile) {
    const int nblk = N >> 6, kb = tile / nblk, nb = tile - kb * nblk; TrDesc d; d.src = W + (size_t)(kb * 64) * N + nb * 64; d.dst = WT + kb * 64; d.N = N; d.K = K; d.mode = mode; d.n0 = nb * 64; return d;
}
__device__ __forceinline__ void tr_load(const TrDesc& d, f32x4 (&v)[16], int lane) {
    const unsigned lo = (unsigned)((lane >> 4) * d.N + 4 * (lane & 15)) * 4u;
    const char* p = (const char*)d.src;
#pragma unroll
    for (int i = 0; i < 16; ++i) v[i] = __builtin_nontemporal_load((const f32x4*)(p + (size_t)(16 * i) * d.N + lo));
}
__device__ __forceinline__ void tr_store(const TrDesc& d, const f32x4 (&v)[16], LAS float* scr, int lane) {
    asm volatile("" ::: "memory"); __builtin_amdgcn_sched_barrier(0);
    {   const unsigned wa = (unsigned)(uintptr_t)(scr + (lane >> 4) * 65 + 4 * (lane & 15));
#pragma unroll
        for (int i = 0; i < 16; ++i) {
            asm volatile("ds_write_b32 %0, %1 offset:%2" :: "v"(wa), "v"(v[i].x), "n"(i * 1040 + 0) : "memory");
            asm volatile("ds_write_b32 %0, %1 offset:%2" :: "v"(wa), "v"(v[i].y), "n"(i * 1040 + 4) : "memory");
            asm volatile("ds_write_b32 %0, %1 offset:%2" :: "v"(wa), "v"(v[i].z), "n"(i * 1040 + 8) : "memory");
            asm volatile("ds_write_b32 %0, %1 offset:%2" :: "v"(wa), "v"(v[i].w), "n"(i * 1040 + 12) : "memory"); } }
    LDS_WAIT(); asm volatile("" ::: "memory");
    const int c = lane >> 3;
    const int rowbase = d.mode == 0 ? d.n0 : (d.n0 >> 4) * 32 + (d.mode == 2 ? 16 : 0);
    const unsigned so = (unsigned)((lane & 7) * d.K + 8 * c) * 2u;
    char* q = (char*)(d.dst + (size_t)rowbase * d.K);
#pragma unroll
    for (int j = 0; j < 8; ++j) { const LAS float* s = scr + (8 * c) * 65 + (lane & 7) + 8 * j;
        v4u o; o.x = pk2(s[0 * 65], s[1 * 65]); o.y = pk2(s[2 * 65], s[3 * 65]); o.z = pk2(s[4 * 65], s[5 * 65]); o.w = pk2(s[6 * 65], s[7 * 65]);
        const int rowj = d.mode == 0 ? 8 * j : (j >> 1) * 32 + 8 * (j & 1);
        __builtin_nontemporal_store(o, (v4u*)(q + (size_t)(2 * rowj) * d.K + so)); }
    LDS_WAIT(); asm volatile("" ::: "memory");
}
__device__ __forceinline__ void rms_row_bf16(const float* xrow, const float* g, bf16* orow, int lane) {
    f32x4 v[8]; float s = 0.f;
#pragma unroll
    for (int j = 0; j < 4; ++j) { const float* p = xrow + 8 * (lane + 64 * j); v[2 * j] = __builtin_nontemporal_load((const f32x4*)p); v[2 * j + 1] = __builtin_nontemporal_load((const f32x4*)(p + 4)); }
#pragma unroll
    for (int j = 0; j < 8; ++j) s += (v[j].x * v[j].x + v[j].y * v[j].y) + (v[j].z * v[j].z + v[j].w * v[j].w);
    const float rstd = 1.0f / sqrtf(wave_sum(s) * (1.0f / DM) + RMS_EPS);
#pragma unroll
    for (int j = 0; j < 4; ++j) { const float* gp = g + 8 * (lane + 64 * j); const f32x4 g0 = *(const f32x4*)gp, g1 = *(const f32x4*)(gp + 4);
        const f32x4 a = v[2 * j] * rstd * g0, b = v[2 * j + 1] * rstd * g1;
        v4u o; o.x = pk2(a.x, a.y); o.y = pk2(a.z, a.w); o.z = pk2(b.x, b.y); o.w = pk2(b.z, b.w);
        *(v4u*)(orow + 8 * (lane + 64 * j)) = o; }
}
__device__ __forceinline__ TrDesc p0_desc(const Args& a, int r) {
    unsigned char* ws = a.ws;
    constexpr int T_IN = (DM / 64) * (NPROJ / 64), T_POOL = 4 * 4 * 4, T_BP = (PW / 64) * (DM / 64);
    if (r < T_IN) return tr_desc(a.in[2], DM, NPROJ, (bf16*)(ws + WS_WIN), 0, r); r -= T_IN;
    if (r < T_POOL) { const int g = r >> 4; return tr_desc(a.in[3] + (size_t)g * 65536, 256, 256, (bf16*)(ws + WS_WPOOL) + (size_t)g * 65536, 0, r & 15); } r -= T_POOL;
    if (r < T_BP) return tr_desc(a.in[5], PW, DM, (bf16*)(ws + WS_WBP), 0, r); r -= T_BP;
    if (r < T_BP) return tr_desc(a.in[6], AW, DM, (bf16*)(ws + WS_WBA), 0, r); r -= T_BP;
    return tr_desc(a.in[7], DM, DM, (bf16*)(ws + WS_WOUT), 0, r);
}
__device__ __forceinline__ void p0_prologue(const Ctx& C, const Args& a) {
    LAS float* scr = (LAS float*)(C.lds + C.wave * 16640);
    constexpr int NT = (DM / 64) * (NPROJ / 64) + 64 + 2 * (PW / 64) * (DM / 64) + (DM / 64) * (DM / 64);
    int it = C.gw;
    if (it < NT) {
        f32x4 va[16], vb[16]; TrDesc d0 = p0_desc(a, it); tr_load(d0, va, C.lane);
        for (;;) { const int nx = it + C.ngw; const bool more = nx < NT; TrDesc d1 = d0;
            if (more) { d1 = p0_desc(a, nx); tr_load(d1, vb, C.lane); }
            tr_store(d0, va, scr, C.lane);
            if (!more) break;
            d0 = d1; it = nx;
#pragma unroll
            for (int i = 0; i < 16; ++i) va[i] = vb[i]; }
    }
    for (int m = C.gw; m < SEQ; m += C.ngw) rms_row_bf16(a.in[0] + (size_t)m * DM, a.in[1], (bf16*)(a.ws + WS_HN) + (size_t)m * DM, C.lane);
}
__device__ __forceinline__ TrDesc moe_desc(const Args& a, int r) {
    unsigned char* ws = a.ws;
    constexpr int TPE_G = (DM / 64) * (DE / 64), TPE_D = (DE / 64) * (DM / 64), T_G = NE * TPE_G;
    if (r < T_G) { const int e = r / TPE_G; return tr_desc(a.in[13] + (size_t)e * DM * DE, DM, DE, (bf16*)(ws + WS_WGU) + (size_t)e * 2048 * DM, 1, r - e * TPE_G); } r -= T_G;
    if (r < T_G) { const int e = r / TPE_G; return tr_desc(a.in[14] + (size_t)e * DM * DE, DM, DE, (bf16*)(ws + WS_WGU) + (size_t)e * 2048 * DM, 2, r - e * TPE_G); } r -= T_G;
    const int e = r / TPE_D; return tr_desc(a.in[15] + (size_t)e * DE * DM, DE, DM, (bf16*)(ws + WS_WDN) + (size_t)e * DM * DE, 0, r - e * TPE_D);
}
template <bool CONV_CU>
__device__ __forceinline__ void conv_tiles(const Ctx& C, const Args& a, int idx) {
    LAS float* scr = (LAS float*)(C.lds + C.wave * 16640);
    constexpr int NT = 3 * NE * (DM / 64) * (DE / 64), NGW = 208 * NWAVES, TAIL_PER_WAVE = 3, NT_A = NT - TAIL_PER_WAVE * NGW, NT_8 = NT_A - 1536;
    static_assert(NT_A % 64 == 0 && NT_8 % 64 == 0 && NT_8 > 0, "whole tile groups");
    f32x4 va[16], vb[16];
    if (C.G != 256) { for (int t = C.gw; t < NT; t += C.ngw) { const TrDesc d = moe_desc(a, t); tr_load(d, va, C.lane); tr_store(d, va, scr, C.lane); } return; }
    if (!CONV_CU) {
#pragma unroll 1
        for (int s_ = 0; s_ < TAIL_PER_WAVE; ++s_) { const TrDesc d = moe_desc(a, NT_A + s_ * NGW + idx); tr_load(d, va, C.lane); tr_store(d, va, scr, C.lane); }
        return;
    }
    unsigned* ctr = (unsigned*)(a.ws + WS_CTL) + CW_CONV;
    auto pull = [&](unsigned* c, unsigned n) -> int { unsigned b0 = 0; if (C.lane == 0) b0 = __hip_atomic_fetch_add(c, n, RLX_AGENT); return __builtin_amdgcn_readfirstlane((int)b0); };
    auto first = [&](int base_) { const int b = base_ >> 3; return moe_desc(a, ((b >> 3) << 6) + (b & 7)); };
    auto sub = [](const TrDesc& m, int i) { const int sh = m.N == DM ? 2 : 1  , nbi = i & ((1 << sh) - 1), kbi = i >> sh;
        TrDesc d = m; d.src = m.src + (size_t)(kbi * 64) * m.N + nbi * 512; d.dst = m.dst + kbi * 64; d.n0 = m.n0 + nbi * 512; return d; };
    int base = pull(ctr, 8u);
    if (base < NT_8) {
        TrDesc m = first(base); tr_load(m, va, C.lane);
        for (;;) {
            const TrDesc d1 = sub(m, 1); tr_load(d1, vb, C.lane); tr_store(m, va, scr, C.lane);
            const TrDesc d2 = sub(m, 2); tr_load(d2, va, C.lane); tr_store(d1, vb, scr, C.lane);
            const TrDesc d3 = sub(m, 3); tr_load(d3, vb, C.lane); tr_store(d2, va, scr, C.lane);
            const TrDesc d4 = sub(m, 4); tr_load(d4, va, C.lane); tr_store(d3, vb, scr, C.lane);
            const TrDesc d5 = sub(m, 5); tr_load(d5, vb, C.lane); tr_store(d4, va, scr, C.lane);
            const TrDesc d6 = sub(m, 6); tr_load(d6, va, C.lane); tr_store(d5, vb, scr, C.lane);
            const TrDesc d7 = sub(m, 7); tr_load(d7, vb, C.lane); tr_store(d6, va, scr, C.lane);
            base = pull(ctr, 8u);
            if (base >= NT_8) { tr_store(d7, vb, scr, C.lane); break; }
            m = first(base); tr_load(m, va, C.lane);
            tr_store(d7, vb, scr, C.lane);
        }
    }
    for (;;) {
        const int t = pull(ctr + 64, 2u); if (t >= NT_A - NT_8) break;
        const TrDesc d0 = moe_desc(a, NT_8 + t), d1 = moe_desc(a, NT_8 + t + 1);
        tr_load(d0, va, C.lane); tr_load(d1, vb, C.lane); tr_store(d0, va, scr, C.lane); tr_store(d1, vb, scr, C.lane);
    }
}

template <int G_>
__device__ __forceinline__ void pool_mixed_rows(const bf16* up, bf16* mp, int r0) {
    constexpr int W = 2 << G_, NR = W + 15;
    v4u raw[NR];
#pragma unroll
    for (int j = 0; j < NR; ++j) { const int i = r0 - W + 1 + j; raw[j] = i >= 0 ? *(const v4u*)(up + (size_t)i * PW) : (v4u){0u, 0u, 0u, 0u}; }
    float s[8];
#pragma unroll
    for (int k = 0; k < 8; ++k) s[k] = 0.f;
#pragma unroll
    for (int j = 0; j < W - 1; ++j) { float f[8]; pg8::unpack8(raw[j], f);
#pragma unroll
        for (int k = 0; k < 8; ++k) s[k] += f[k]; }
#pragma unroll
    for (int q = 0; q < 16; ++q) { const int r = r0 + q; float cur[8]; pg8::unpack8(raw[W - 1 + q], cur);
#pragma unroll
        for (int k = 0; k < 8; ++k) s[k] += cur[k];
        if (q > 0) { float o[8]; pg8::unpack8(raw[q - 1], o);
#pragma unroll
            for (int k = 0; k < 8; ++k) s[k] -= o[k]; }
        const float inv = 1.0f / (float)(r + 1 < W ? r + 1 : W);
        v4u o; o.x = pk2(s[0] * inv - cur[0], s[1] * inv - cur[1]); o.y = pk2(s[2] * inv - cur[2], s[3] * inv - cur[3]);
        o.z = pk2(s[4] * inv - cur[4], s[5] * inv - cur[5]); o.w = pk2(s[6] * inv - cur[6], s[7] * inv - cur[7]);
        *(v4u*)(mp + (size_t)r * 256) = o; }
}
__device__ __forceinline__ void pool_mixed_tile(const Ctx& C, const Args& a, int L) {
    unsigned char* ws = a.ws; const bf16* u = (const bf16*)(ws + WS_U); bf16* mixed = (bf16*)(ws + WS_MIXED);
    const int g = L >> 5, rt = L & 31; const int chunk = C.tid & 31, run = C.tid >> 5;
    const int r0 = rt * 256 + run * 16; const bf16* up = u + g * 256 + chunk * 8; bf16* mp = mixed + ((size_t)g * SEQ) * 256 + chunk * 8;
    if (g == 0) pool_mixed_rows<0>(up, mp, r0); else if (g == 1) pool_mixed_rows<1>(up, mp, r0); else if (g == 2) pool_mixed_rows<2>(up, mp, r0); else pool_mixed_rows<3>(up, mp, r0);
}

__device__ __forceinline__ bool gate_better(float av, int ai, float bv, int bi) { return av > bv || (av == bv && ai < bi); }

__device__ __forceinline__ void moe_offsets(const unsigned* cnt, int lane, int& incl_tiles, int& tiles, unsigned& cv) {
    cv = 0; if (lane < NE) cv = __hip_atomic_load(cnt + 64 * lane, RLX_AGENT);
    tiles = (int)((cv + 255u) >> 8); incl_tiles = tiles;
#pragma unroll
    for (int o = 1; o < 16; o <<= 1) { const int tt = __shfl_up(incl_tiles, o); if (lane >= o) incl_tiles += tt; }
}
constexpr int TPW = 4;
__device__ __forceinline__ void reduce32(float (&v)[32], int lane) {
#pragma unroll
    for (int i = 0; i < 16; ++i) { const bool up = lane & 32; const float snd = up ? v[i] : v[i + 16], kp = up ? v[i + 16] : v[i]; v[i] = kp + shx(snd, 32, lane); }
#pragma unroll
    for (int i = 0; i < 8; ++i) { const bool up = lane & 16; const float snd = up ? v[i] : v[i + 8], kp = up ? v[i + 8] : v[i]; v[i] = kp + shx(snd, 16, lane); }
#pragma unroll
    for (int i = 0; i < 4; ++i) { const bool up = lane & 8; const float snd = up ? v[i] : v[i + 4], kp = up ? v[i + 4] : v[i]; v[i] = kp + shx(snd, 8, lane); }
#pragma unroll
    for (int i = 0; i < 2; ++i) { const bool up = lane & 4; const float snd = up ? v[i] : v[i + 2], kp = up ? v[i + 2] : v[i]; v[i] = kp + shx(snd, 4, lane); }
    { const bool up = lane & 2; const float snd = up ? v[0] : v[1], kp = up ? v[1] : v[0]; v[0] = kp + shx(snd, 2, lane); }
    v[0] += shx(v[0], 1, lane);
}
template <class Bar>
__device__ __forceinline__ void p_router(const Ctx& C, const Args& a, const Bar& bar) {
    unsigned char* ws = a.ws; const bf16* x1 = (const bf16*)(ws + WS_X1); const float* g2 = a.in[8];
    const float* wrg = a.in[9]; const float* brg = a.in[10]; const float* wre = a.in[11]; const float* bre = a.in[12];
    unsigned* cnt = (unsigned*)(ws + WS_CTL) + CW_CNT;
    int* toke = (int*)(ws + WS_TOKE); int* toks = (int*)(ws + WS_TOKS); int* rowtok = (int*)(ws + WS_ROWTOK); float* roww = (float*)(ws + WS_ROWW);
    bf16* h2 = (bf16*)(ws + WS_HN);
    const int lane = C.lane, tid = C.tid;
    LAS float* wl = (LAS float*)C.lds;
    const bf16* xp[TPW];
#pragma unroll
    for (int k = 0; k < TPW; ++k) { const int t = C.gw + k * C.ngw; xp[k] = x1 + (size_t)__builtin_amdgcn_readfirstlane(t < SEQ ? t : 0) * DM; }
    const int lo4 = 4 * lane;
    float ga[TPW][4], ssq[TPW];
#pragma unroll
    for (int k = 0; k < TPW; ++k) { ssq[k] = 0.f; ga[k][0] = 0.f; ga[k][1] = 0.f; ga[k][2] = 0.f; ga[k][3] = 0.f; }
    __syncthreads();
#pragma unroll
    for (int r = 0; r < 4; ++r) *(LAS f32x4*)(wl + (r * 512 + tid) * 4) = *(const f32x4*)(wrg + (size_t)(r * 512 + tid) * 4);
    pg8::u32x2 xn[TPW][2]; f32x4 gn[2];
#pragma unroll
    for (int jj = 0; jj < 2; ++jj) { gn[jj] = *(const f32x4*)(g2 + 256 * jj + 4 * lane);
#pragma unroll
        for (int k = 0; k < TPW; ++k) xn[k][jj] = *(const pg8::u32x2*)(xp[k] + (256 * jj + lo4)); }
    __syncthreads();
#pragma unroll 1
    for (int ch = 0; ch < 4; ++ch) {
        pg8::u32x2 xv[TPW][2]; f32x4 gg[2];
#pragma unroll
        for (int jj = 0; jj < 2; ++jj) { gg[jj] = gn[jj];
#pragma unroll
            for (int k = 0; k < TPW; ++k) xv[k][jj] = xn[k][jj]; }
        { const int cn = ch < 3 ? ch + 1 : 3;
#pragma unroll
            for (int jj = 0; jj < 2; ++jj) { gn[jj] = *(const f32x4*)(g2 + cn * 512 + 256 * jj + 4 * lane);
#pragma unroll
                for (int k = 0; k < TPW; ++k) xn[k][jj] = *(const pg8::u32x2*)(xp[k] + (cn * 512 + 256 * jj + lo4)); } }
#pragma unroll
        for (int jj = 0; jj < 2; ++jj)
#pragma unroll
            for (int i = 0; i < 4; ++i) { const f32x4 w = *(const LAS f32x4*)(wl + (ch * 512 + 256 * jj + 4 * lane + i) * 4);
#pragma unroll
                for (int k = 0; k < TPW; ++k) { const unsigned xw_ = i < 2 ? xv[k][jj].x : xv[k][jj].y; const float x = (i & 1) ? bf_hi(xw_) : bf_lo(xw_), xs = x * gg[jj][i]; ssq[k] += x * x; ga[k][0] += xs * w.x; ga[k][1] += xs * w.y; ga[k][2] += xs * w.z; ga[k][3] += xs * w.w; } }
    }
    float rstd[TPW], gwt[TPW]; int gi[TPW];
    { float v[32];
#pragma unroll
        for (int c = 0; c < 32; ++c) v[c] = 0.f;
#pragma unroll
        for (int k = 0; k < TPW; ++k) { v[5 * k] = ga[k][0]; v[5 * k + 1] = ga[k][1]; v[5 * k + 2] = ga[k][2]; v[5 * k + 3] = ga[k][3]; v[5 * k + 4] = ssq[k]; }
        reduce32(v, lane); const float vt = v[0];
#pragma unroll
        for (int k = 0; k < TPW; ++k) {
            rstd[k] = 1.0f / sqrtf(__shfl(vt, 2 * (5 * k + 4)) * (1.0f / DM) + RMS_EPS);
            float gl[4];
#pragma unroll
            for (int i = 0; i < 4; ++i) gl[i] = __shfl(vt, 2 * (5 * k + i)) * rstd[k] + brg[i];
            int g = 0; float gm = gl[0];
#pragma unroll
            for (int i = 1; i < 4; ++i) if (gl[i] > gm) { gm = gl[i]; g = i; }
            float gs = 0.f;
#pragma unroll
            for (int i = 0; i < 4; ++i) gs += __expf(gl[i] - gm);
            gi[k] = g; gwt[k] = 1.0f / gs;
            asm volatile("" : "+v"(gwt[k]));
            __builtin_amdgcn_sched_barrier(0);
        } }
    float eacc[TPW][4];
#pragma unroll
    for (int k = 0; k < TPW; ++k) { eacc[k][0] = 0.f; eacc[k][1] = 0.f; eacc[k][2] = 0.f; eacc[k][3] = 0.f; }
    {
    __syncthreads();
#pragma unroll
    for (int g = 0; g < 4; ++g)
#pragma unroll
        for (int r = 0; r < 4; ++r) *(LAS f32x4*)(wl + g * 8192 + (r * 512 + tid) * 4) = *(const f32x4*)(wre + ((size_t)g * DM + r * 512 + tid) * 4);
    pg8::u32x2 xn[TPW][2];
#pragma unroll
    for (int jj = 0; jj < 2; ++jj)
#pragma unroll
        for (int k = 0; k < TPW; ++k) xn[k][jj] = *(const pg8::u32x2*)(xp[k] + (256 * jj + lo4));
    __syncthreads();
#pragma unroll 1
    for (int ch = 0; ch < 4; ++ch) {
        pg8::u32x2 xv[TPW][2]; f32x4 gg[2];
#pragma unroll
        for (int jj = 0; jj < 2; ++jj) { gg[jj] = *(const f32x4*)(g2 + ch * 512 + 256 * jj + 4 * lane);
#pragma unroll
            for (int k = 0; k < TPW; ++k) xv[k][jj] = xn[k][jj]; }
        { const int cn = ch < 3 ? ch + 1 : 3;
#pragma unroll
            for (int jj = 0; jj < 2; ++jj)
#pragma unroll
                for (int k = 0; k < TPW; ++k) xn[k][jj] = *(const pg8::u32x2*)(xp[k] + (cn * 512 + 256 * jj + lo4)); }
#pragma unroll
        for (int k = 0; k < TPW; ++k) { const int t = C.gw + k * C.ngw; const LAS float* wp = wl + gi[k] * 8192 + ch * 2048;
#pragma unroll
            for (int jj = 0; jj < 2; ++jj) { float hs[4];
#pragma unroll
                for (int i = 0; i < 4; ++i) { const f32x4 w = *(const LAS f32x4*)(wp + (256 * jj + 4 * lane + i) * 4); const unsigned xw_ = i < 2 ? xv[k][jj].x : xv[k][jj].y; const float x = (i & 1) ? bf_hi(xw_) : bf_lo(xw_), xs = x * gg[jj][i];
                    eacc[k][0] += xs * w.x; eacc[k][1] += xs * w.y; eacc[k][2] += xs * w.z; eacc[k][3] += xs * w.w; hs[i] = x * rstd[k] * gg[jj][i]; }
                if (t < SEQ) { v2u o; o.x = pk2(hs[0], hs[1]); o.y = pk2(hs[2], hs[3]); *(v2u*)(h2 + (size_t)t * DM + ch * 512 + 256 * jj + 4 * lane) = o; } }
            __builtin_amdgcn_sched_barrier(0); }
    }
    }
    { float v[32];
#pragma unroll
        for (int c = 0; c < 32; ++c) v[c] = 0.f;
#pragma unroll
        for (int k = 0; k < TPW; ++k) { v[4 * k] = eacc[k][0]; v[4 * k + 1] = eacc[k][1]; v[4 * k + 2] = eacc[k][2]; v[4 * k + 3] = eacc[k][3]; }
        reduce32(v, lane_id()); const float vt = v[0];
#pragma unroll
        for (int k = 0; k < TPW; ++k) {
            const int t = C.gw + k * C.ngw;
            float el[4];
#pragma unroll
            for (int i = 0; i < 4; ++i) el[i] = __shfl(vt, 2 * (4 * k + i)) * rstd[k] + bre[gi[k] * 4 + i];
            int i0 = 0; float v0 = el[0];
#pragma unroll
            for (int i = 1; i < 4; ++i) if (el[i] > v0) { v0 = el[i]; i0 = i; }
            int i1 = -1; float v1 = -3.0e38f;
#pragma unroll
            for (int i = 0; i < 4; ++i) if (i != i0 && el[i] > v1) { v1 = el[i]; i1 = i; }
            const float e1 = __expf(v1 - v0), den = 1.0f / (1.0f + e1);
            const float w0 = den * gwt[k], w1 = e1 * den * gwt[k];
            const int ea = gi[k] * 4 + i0, eb = gi[k] * 4 + i1;
            if (lane == 0 && t < SEQ) { const int xa = (int)__hip_atomic_fetch_add(cnt + 64 * ea, 1u, RLX_AGENT), xb = (int)__hip_atomic_fetch_add(cnt + 64 * eb, 1u, RLX_AGENT);
                roww[ea * ECAP + xa] = w0; roww[eb * ECAP + xb] = w1; rowtok[ea * ECAP + xa] = t; rowtok[eb * ECAP + xb] = t;
                toke[2 * t] = ea; toke[2 * t + 1] = eb; toks[2 * t] = xa; toks[2 * t + 1] = xb; }
            __builtin_amdgcn_sched_barrier(0);
        } }
}
struct FinRow { v4u x[4], ya[4], yb[4]; };
__device__ __forceinline__ void fin_load(FinRow& r, const bf16* xr, const bf16* ya, const bf16* yb, int lane) {
#pragma unroll
    for (int j = 0; j < 4; ++j) { const int c0 = 8 * (lane + 64 * j); r.x[j] = __builtin_nontemporal_load((const v4u*)(xr + c0));
        r.ya[j] = __builtin_nontemporal_load((const v4u*)(ya + c0)); r.yb[j] = __builtin_nontemporal_load((const v4u*)(yb + c0)); }
}
__device__ __forceinline__ void p8_final(const Ctx& C, const Args& a) {
    unsigned char* ws = a.ws; float* out = a.out; const float* gf = a.in[16]; const bf16* y = (const bf16*)(ws + WS_Y); const bf16* x1 = (const bf16*)(ws + WS_X1);
    const int* toke = (const int*)(ws + WS_TOKE); const int* toks = (const int*)(ws + WS_TOKS); const unsigned* cnt = (const unsigned*)(ws + WS_CTL) + CW_CNT;
    const int lane = C.lane;
    int incl, tiles; unsigned cv; moe_offsets(cnt, lane, incl, tiles, cv);
    auto rowof = [&](int e, int slot) { return (__shfl(incl, e) - __shfl(tiles, e)) * 256 + slot; };
    int t = C.gw; if (t >= SEQ) return;
    FinRow cur, nxt;
    { const int ra = rowof(toke[2 * t], toks[2 * t]), rb = rowof(toke[2 * t + 1], toks[2 * t + 1]); fin_load(cur, x1 + (size_t)t * DM, y + (size_t)ra * DM, y + (size_t)rb * DM, lane); }
    for (;;) {
        const int tn = t + C.ngw; const bool more = tn < SEQ;
        if (more) { const int ra = rowof(toke[2 * tn], toks[2 * tn]), rb = rowof(toke[2 * tn + 1], toks[2 * tn + 1]); fin_load(nxt, x1 + (size_t)tn * DM, y + (size_t)ra * DM, y + (size_t)rb * DM, lane); }
        float* xr = out + (size_t)t * DM; float hv[32]; float s = 0.f;
#pragma unroll
        for (int j = 0; j < 4; ++j) { float fa[8], fb[8], fx[8]; pg8::unpack8(cur.ya[j], fa); pg8::unpack8(cur.yb[j], fb); pg8::unpack8(cur.x[j], fx);
#pragma unroll
            for (int i = 0; i < 8; ++i) hv[8 * j + i] = fx[i] + fa[i] + fb[i]; }
#pragma unroll
        for (int i = 0; i < 32; ++i) s += hv[i] * hv[i];
        const float rstd = 1.0f / sqrtf(wave_sum(s) * (1.0f / DM) + RMS_EPS);
#pragma unroll
        for (int j = 0; j < 4; ++j) { const int c0 = 8 * (lane + 64 * j); const f32x4 g0 = *(const f32x4*)(gf + c0), g1 = *(const f32x4*)(gf + c0 + 4);
            __builtin_nontemporal_store((f32x4){hv[8 * j] * rstd * g0.x, hv[8 * j + 1] * rstd * g0.y, hv[8 * j + 2] * rstd * g0.z, hv[8 * j + 3] * rstd * g0.w}, (f32x4*)(xr + c0));
            __builtin_nontemporal_store((f32x4){hv[8 * j + 4] * rstd * g1.x, hv[8 * j + 5] * rstd * g1.y, hv[8 * j + 6] * rstd * g1.z, hv[8 * j + 7] * rstd * g1.w}, (f32x4*)(xr + c0 + 4)); }
        if (!more) break;
        t = tn; cur = nxt;
    }
}

namespace moba {
typedef float f32x16 __attribute__((ext_vector_type(16)));
typedef short s16x4 __attribute__((ext_vector_type(4)));
typedef short v4i16_t __attribute__((ext_vector_type(4)));
constexpr int LK = 0, LV = 65536, LLIST = 131072, LWC = LLIST + 6144;
constexpr int MAXBLK = 12;
constexpr float LOG2E = 1.4426950408889634f, C1 = 0.08838834764831845f * 1.4426950408889634f;
constexpr int TARGET = 448, MAXENT = 192;
struct Tab { int nB, n; unsigned e[MAXENT]; };
constexpr Tab make_tab() {
    Tab t{}; int n = 0; float cost[MAXENT] = {};
    for (int j = 0; j < 31; ++j) { int b = j + 1;
        while (b < 32) { float acc = 0.f; const int lo = b; while (b < 32 && acc < (float)TARGET && b - lo < MAXBLK) { acc += b <= 3 ? 256.f : 768.f / (float)b; ++b; } t.e[n] = (unsigned)j | ((unsigned)lo << 8) | ((unsigned)b << 16); cost[n] = acc; ++n; } }
    for (int i = 1; i < n; ++i) { const unsigned ke = t.e[i]; const float kc = cost[i]; int k = i - 1; while (k >= 0 && cost[k] < kc) { t.e[k + 1] = t.e[k]; cost[k + 1] = cost[k]; --k; } t.e[k + 1] = ke; cost[k + 1] = kc; }
    t.nB = n;
    for (int b = 31; b >= 0; --b) { t.e[n] = (unsigned)b | ((unsigned)b << 8) | ((unsigned)(b + 1) << 16); ++n; }
    t.n = n; return t;
}
__device__ const Tab g_tab = make_tab();

__device__ __forceinline__ int crow(int r, int hf) { return (r & 3) + 8 * (r >> 2) + 4 * hf; }
__device__ __forceinline__ s16x4 vtr(const LAS unsigned char* p) { return __builtin_bit_cast(s16x4, __builtin_amdgcn_ds_read_tr16_b64_v4i16((LAS v4i16_t*)p)); }

__device__ __forceinline__ void load_kv(LAS unsigned char* lds, const bf16* K, const bf16* V, int h, int j, int wave, int lane) {
#pragma unroll
    for (int i = 0; i < 8; ++i) { const int p = wave * 8 + i; const int key = 4 * p + (lane >> 4), cp = lane & 15;
        const bf16* src = K + (size_t)(j * 256 + key) * AW + h * HD + ((cp ^ (key & 15)) * 8);
        __builtin_amdgcn_global_load_lds((const unsigned*)src, (LAS unsigned*)(lds + LK + p * 1024), 16, 0, 0); }
#pragma unroll
    for (int i = 0; i < 8; ++i) { const int p = wave * 8 + i; const int q4 = p >> 4, kg = p & 15; const int key = kg * 16 + (lane >> 2), part = lane & 3;
        const bf16* src = V + (size_t)(j * 256 + key) * AW + h * HD + q4 * 32 + part * 8;
        __builtin_amdgcn_global_load_lds((const unsigned*)src, (LAS unsigned*)(lds + LV + q4 * 16384 + kg * 1024), 16, 0, 0); }
}

#define MOBA_SB() __builtin_amdgcn_sched_barrier(0)
template <bool CAUSAL>
__device__ __forceinline__ void attn_group(LAS unsigned char* lds, const LAS unsigned short* ent, int cnt, int tbase, const bf16* Q, bf16* part, bf16* part3, float* ml, int h, int j, int kmax, int lane) {
    const int ql = lane & 31, hf = lane >> 5;
    const unsigned en = ent[ql < cnt ? ql : 0];
    const int tq = tbase + (int)(en & 0xfffu), slot = (int)(en >> 12);
    bf16x8 qf[8]; { const bf16* qp = Q + (size_t)tq * AW + h * HD + 8 * hf;
#pragma unroll
        for (int s = 0; s < 8; ++s) qf[s] = *(const bf16x8*)(qp + 16 * s); }
    const float slope2 = exp2f(-(float)(h + 1)) * LOG2E;
    const float tb = (float)(j * 256 + 4 * hf - tq);
    f32x16 o[4];
#pragma unroll
    for (int d = 0; d < 4; ++d)
#pragma unroll
        for (int r = 0; r < 16; ++r) o[d][r] = 0.f;
    float m_run = -1e30f, l_run = 0.f;
    const LAS unsigned char* kbase = lds + LK + ql * 256;
    const LAS unsigned char* vbase = lds + LV + (4 * hf + ((lane & 15) >> 2)) * 64 + ((lane >> 4) & 1) * 32 + (lane & 3) * 8;
    const int kq = ql & 15;
#define MOBA_KF(idx) (*(const LAS bf16x8*)(kbase + ((idx) >> 3) * 8192 + (((2 * ((idx) & 7) + hf) ^ kq) * 16)))
#pragma unroll
    for (int half = 0; half < 2; ++half) {
        if (CAUSAL && half * 128 > kmax) break;
        f32x16 st[4];
#pragma unroll
        for (int kt = 0; kt < 4; ++kt)
#pragma unroll
            for (int r = 0; r < 16; ++r) st[kt][r] = 0.f;
        bf16x8 kr[8];
#pragma unroll
        for (int i = 0; i < 3; ++i) kr[i] = MOBA_KF(half * 32 + i);
#pragma unroll
        for (int i = 0; i < 32; ++i) {
            if (i + 3 < 32) kr[(i + 3) & 7] = MOBA_KF(half * 32 + i + 3);
            if ((i & 3) == 0) MOBA_SB();
            const int kt = i >> 3, s = i & 7;
            if (!(CAUSAL && (half * 4 + kt) * 32 > kmax)) st[kt] = __builtin_amdgcn_mfma_f32_32x32x16_bf16(kr[i & 7], qf[s], st[kt], 0, 0, 0);
        }
#pragma unroll
        for (int kt = 0; kt < 4; ++kt) {
            const int ktt = half * 4 + kt;
            if (CAUSAL && ktt * 32 > kmax) {
#pragma unroll
                for (int r = 0; r < 16; ++r) st[kt][r] = -1e30f;
            } else {
                const float tbk = tb + (float)(ktt * 32);
#pragma unroll
                for (int r = 0; r < 16; ++r) { const float rel = tbk + (float)((r & 3) + 8 * (r >> 2));
                    float s2 = st[kt][r] * C1 + slope2 * rel; if (CAUSAL && rel > 0.f) s2 = -1e30f; st[kt][r] = s2; }
            }
        }
        float mx = -1e30f;
#pragma unroll
        for (int kt = 0; kt < 4; ++kt)
#pragma unroll
            for (int r = 0; r < 16; ++r) mx = fmaxf(mx, st[kt][r]);
        mx = fmaxf(mx, __shfl_xor(mx, 32));
        const float m_new = fmaxf(m_run, mx), alpha = __builtin_amdgcn_exp2f(m_run - m_new);
        m_run = m_new; l_run *= alpha;
        if (half == 1) {
#pragma unroll
            for (int d = 0; d < 4; ++d)
#pragma unroll
                for (int r = 0; r < 16; ++r) o[d][r] *= alpha; }
        float ls = 0.f;
        s16x4 vr[8];
#define MOBA_VF(slot, idx) do { const LAS unsigned char* vp_ = vbase + ((idx) & 3) * 16384 + (half * 8 + ((idx) >> 2)) * 1024; vr[2 * (slot)] = vtr(vp_); vr[2 * (slot) + 1] = vtr(vp_ + 512); } while (0)
        MOBA_VF(0, 0); MOBA_VF(1, 1);
#pragma unroll
        for (int kt = 0; kt < 4; ++kt) {
            const int ktt = half * 4 + kt;
            const bool skip = CAUSAL && ktt * 32 > kmax;
            float p[16];
            if (!skip) {
#pragma unroll
                for (int r = 0; r < 16; ++r) { p[r] = __builtin_amdgcn_exp2f(st[kt][r] - m_new); ls += p[r]; } }
            else {
#pragma unroll
                for (int r = 0; r < 16; ++r) p[r] = 0.f; }
#pragma unroll
            for (int s2 = 0; s2 < 2; ++s2) {
                v4u pw; pw.x = pg8::cvt_pk_bf16(p[8 * s2 + 0], p[8 * s2 + 1]); pw.y = pg8::cvt_pk_bf16(p[8 * s2 + 2], p[8 * s2 + 3]); pw.z = pg8::cvt_pk_bf16(p[8 * s2 + 4], p[8 * s2 + 5]); pw.w = pg8::cvt_pk_bf16(p[8 * s2 + 6], p[8 * s2 + 7]);
                const bf16x8 pf = __builtin_bit_cast(bf16x8, pw);
#pragma unroll
                for (int d = 0; d < 4; ++d) {
                    const int idx = (kt * 2 + s2) * 4 + d;
                    if (idx + 2 < 32) MOBA_VF((idx + 2) & 3, idx + 2);
                    if ((idx & 1) == 0) MOBA_SB();
                    const s16x4 lo = vr[2 * (idx & 3)], hi = vr[2 * (idx & 3) + 1];
                    const bf16x8 vf = (bf16x8){lo[0], lo[1], lo[2], lo[3], hi[0], hi[1], hi[2], hi[3]};
                    if (!skip) o[d] = __builtin_amdgcn_mfma_f32_32x32x16_bf16(vf, pf, o[d], 0, 0, 0);
                }
            }
        }
#undef MOBA_VF
        l_run += ls;
    }
#undef MOBA_KF
    const float l_tot = l_run + __shfl_xor(l_run, 32);
    if (ql < cnt) {
        const float inv = 1.0f / l_tot;
        bf16* pp = (slot == 3 ? part3 : part + (size_t)slot * SEQ * AW) + (size_t)tq * AW + h * HD + 4 * hf;
#pragma unroll
        for (int d = 0; d < 4; ++d)
#pragma unroll
            for (int rq = 0; rq < 4; ++rq) { v2u w; w.x = pg8::cvt_pk_bf16(o[d][4 * rq] * inv, o[d][4 * rq + 1] * inv); w.y = pg8::cvt_pk_bf16(o[d][4 * rq + 2] * inv, o[d][4 * rq + 3] * inv);
                *(v2u*)(pp + 32 * d + 8 * rq) = w; }
        if (hf == 0) *(f32x2*)(ml + ((size_t)slot * SEQ + tq) * (2 * NH) + 2 * h) = (f32x2){m_run, l_tot};
    }
}
}

__device__ __forceinline__ bf16* part_ptr(unsigned char* ws) { return (bf16*)(ws + WS_PART); }
__device__ __forceinline__ float* ml_ptr(unsigned char* ws) { return (float*)(ws + WS_ML); }

__device__ __forceinline__ void p_attn(const Ctx& C, const Args& a, int rep) {
    using namespace moba;
    unsigned char* ws = a.ws; LAS unsigned char* lds = C.lds;
    const bf16* Q = (const bf16*)(ws + WS_Q); const bf16* K = (const bf16*)(ws + WS_K); const bf16* V = (const bf16*)(ws + WS_V);
    const unsigned* sel = (const unsigned*)(ws + WS_SEL); bf16* part = part_ptr(ws); bf16* part3 = (bf16*)(ws + WS_PART3); float* ml = ml_ptr(ws);
    unsigned* ctr = (unsigned*)(ws + WS_CTL) + CW_ATTN + 64 * rep;
    LAS unsigned short* lst = (LAS unsigned short*)(lds + LLIST); volatile LAS int* wc = (volatile LAS int*)(lds + LWC);
    const int NU = g_tab.n * NH; const int tid = C.tid, lane = C.lane, wave = C.wave;
    int u = C.bid;
    while (u < NU) {
        const unsigned ent = g_tab.e[u >> 3]; const int h = u & 7, j = (int)(ent & 0xff), blo = (int)((ent >> 8) & 0xff), bhi = (int)(ent >> 16);
        if (tid == 0) wc[16] = (int)(C.G + __hip_atomic_fetch_add(ctr, 1u, RLX_AGENT));
        const bool causal = blo == j; const int t_lo = blo * 256; int n = 256;
        const int nt = causal ? 0 : (bhi - blo) * 256;
        unsigned spv[MAXBLK / 2];
#pragma unroll
        for (int i = 0; i < MAXBLK / 2; ++i) { const int tr = i * 512 + tid; spv[i] = 0xffffffffu; if (tr < nt) spv[i] = sel[(t_lo + tr) * NH + h]; }
        load_kv(lds, K, V, h, j, wave, lane);
        if (causal) { if (tid < 256) lst[tid] = (unsigned short)(tid | (3 << 12)); }
        else {
            int slot[MAXBLK / 2]; int before[MAXBLK / 2]; int mycnt = 0;
#pragma unroll
            for (int i = 0; i < MAXBLK / 2; ++i) { const unsigned sp = spv[i]; slot[i] = (int)(sp & 0xff) == j ? 0 : (int)((sp >> 8) & 0xff) == j ? 1 : (int)((sp >> 16) & 0xff) == j ? 2 : -1; }
#pragma unroll
            for (int i = 0; i < MAXBLK / 2; ++i) { const unsigned long long bal = __ballot(slot[i] >= 0); before[i] = mycnt + __popcll(bal & ((1ull << lane) - 1ull)); mycnt += __popcll(bal); }
            if (lane == 0) wc[wave] = mycnt;
            __syncthreads();
            int base = 0, tot = 0;
#pragma unroll
            for (int w = 0; w < 8; ++w) { const int c = wc[w]; if (w < wave) base += c; tot += c; }
#pragma unroll
            for (int i = 0; i < MAXBLK / 2; ++i) if (slot[i] >= 0) lst[base + before[i]] = (unsigned short)((i * 512 + tid) | (slot[i] << 12));
            n = tot;
        }
        asm volatile("s_waitcnt vmcnt(0)" ::: "memory"); __syncthreads();
        if (causal) attn_group<true>(lds, lst + wave * 32, 32, t_lo, Q, part, part3, ml, h, j, wave * 32 + 31, lane);
        else { const int ng = (n + 31) >> 5;
            for (int g = wave; g < ng; g += 8) { const int c = n - g * 32; attn_group<false>(lds, lst + g * 32, c < 32 ? c : 32, t_lo, Q, part, part3, ml, h, j, 255, lane); } }
        __syncthreads();
        u = wc[16];
        __syncthreads();
    }
}

__device__ __forceinline__ void p_combine(const Ctx& C, const Args& a) {
    unsigned char* ws = a.ws; const unsigned* sel = (const unsigned*)(ws + WS_SEL); const bf16* part = part_ptr(ws); const bf16* part3 = (const bf16*)(ws + WS_PART3); const float* ml = ml_ptr(ws); bf16* ao = (bf16*)(ws + WS_AO);
    const int lane = C.lane, h = lane >> 3, dc = lane & 7;
    for (int t0 = C.gw; t0 < SEQ; t0 += 2 * C.ngw) {
        f32x2 mv[2][4]; v4u pv[2][4][2]; bool val[2][4];
#pragma unroll
        for (int k = 0; k < 2; ++k) { const int t = t0 + k * C.ngw; const bool tv = t < SEQ; const int tt = tv ? t : 0; const unsigned sp = sel[tt * NH + h]; const int own = tt >> 8;
#pragma unroll
            for (int s = 0; s < 4; ++s) { val[k][s] = tv && (s == 3 || (int)((sp >> (8 * s)) & 0xff) < own); } }
#pragma unroll
        for (int k = 0; k < 2; ++k) { const int t = t0 + k * C.ngw; const int tt = t < SEQ ? t : 0;
#pragma unroll
            for (int s = 0; s < 4; ++s) { mv[k][s] = (f32x2){-1e30f, 0.f}; pv[k][s][0] = (v4u){0u, 0u, 0u, 0u}; pv[k][s][1] = (v4u){0u, 0u, 0u, 0u};
                if (val[k][s]) { mv[k][s] = *(const f32x2*)(ml + ((size_t)s * SEQ + tt) * (2 * NH) + 2 * h);
                    const bf16* pp = (s == 3 ? part3 : part + (size_t)s * SEQ * AW) + (size_t)tt * AW + h * HD + dc * 16;
                    pv[k][s][0] = __builtin_nontemporal_load((const v4u*)pp); pv[k][s][1] = __builtin_nontemporal_load((const v4u*)(pp + 8)); } } }
#pragma unroll
        for (int k = 0; k < 2; ++k) { const int t = t0 + k * C.ngw;
            float M = -1e30f;
#pragma unroll
            for (int s = 0; s < 4; ++s) M = fmaxf(M, mv[k][s].x);
            float w[4], L = 0.f;
#pragma unroll
            for (int s = 0; s < 4; ++s) { w[s] = mv[k][s].y * exp2f(mv[k][s].x - M); L += w[s]; }
            const float invL = 1.0f / L; float acc[16];
#pragma unroll
            for (int i = 0; i < 16; ++i) acc[i] = 0.f;
#pragma unroll
            for (int s = 0; s < 4; ++s) { float f0[8], f1[8]; pg8::unpack8(pv[k][s][0], f0); pg8::unpack8(pv[k][s][1], f1); const float ws_ = w[s] * invL;
#pragma unroll
                for (int i = 0; i < 8; ++i) { acc[i] += ws_ * f0[i]; acc[8 + i] += ws_ * f1[i]; } }
            if (t < SEQ) { v4u o0, o1; o0.x = pk2(acc[0], acc[1]); o0.y = pk2(acc[2], acc[3]); o0.z = pk2(acc[4], acc[5]); o0.w = pk2(acc[6], acc[7]);
                o1.x = pk2(acc[8], acc[9]); o1.y = pk2(acc[10], acc[11]); o1.z = pk2(acc[12], acc[13]); o1.w = pk2(acc[14], acc[15]);
                bf16* op = ao + (size_t)t * AW + h * HD + dc * 16; *(v4u*)op = o0; *(v4u*)(op + 8) = o1; }
        }
    }
}

__device__ __forceinline__ void p_gate_mfma(const Ctx& C, const Args& a) {
    using moba::f32x16;
    unsigned char* ws = a.ws; const bf16* Q = (const bf16*)(ws + WS_Q); const float* kpart = (const float*)(ws + WS_KPART); unsigned* sel = (unsigned*)(ws + WS_SEL);
    const int lane = C.lane, ql = lane & 31, hf = lane >> 5;
    const bool split = C.G == 256; const int g0 = split ? C.gw - 128 * NWAVES : C.gw, gstep = split ? 128 * NWAVES : C.ngw;
    if (split && C.bid < 128) return;
    for (int it = g0; it < (SEQ / 32) * NH; it += gstep) {
        const int tile = it >> 3, h = it & 7, tq = tile * 32 + ql, own = tile >> 3;
        f32x16 acc;
#pragma unroll
        for (int r = 0; r < 16; ++r) acc[r] = 0.f;
        const bf16* qp = Q + (size_t)tq * AW + h * HD + 8 * hf; const float* kp = kpart + (size_t)ql * 2048 + h * HD + 8 * hf;
#pragma unroll
        for (int s = 0; s < 8; ++s) { const bf16x8 qf = *(const bf16x8*)(qp + 16 * s);
            const f32x4 p0 = *(const f32x4*)(kp + 16 * s), p1 = *(const f32x4*)(kp + 16 * s + 4), r0 = *(const f32x4*)(kp + 1024 + 16 * s), r1 = *(const f32x4*)(kp + 1024 + 16 * s + 4);
            const f32x4 m0 = (p0 + r0) * (1.0f / MBLK), m1 = (p1 + r1) * (1.0f / MBLK);
            const float mm[8] = {m0.x, m0.y, m0.z, m0.w, m1.x, m1.y, m1.z, m1.w}; unsigned hb[8], lb[8];
#pragma unroll
            for (int i = 0; i < 8; ++i) { hb[i] = f2bf(mm[i]); lb[i] = f2bf(mm[i] - __builtin_bit_cast(float, hb[i] << 16)); }
            v4u hw, lw; hw.x = hb[0] | (hb[1] << 16); hw.y = hb[2] | (hb[3] << 16); hw.z = hb[4] | (hb[5] << 16); hw.w = hb[6] | (hb[7] << 16);
            lw.x = lb[0] | (lb[1] << 16); lw.y = lb[2] | (lb[3] << 16); lw.z = lb[4] | (lb[5] << 16); lw.w = lb[6] | (lb[7] << 16);
            acc = __builtin_amdgcn_mfma_f32_32x32x16_bf16(__builtin_bit_cast(bf16x8, hw), qf, acc, 0, 0, 0); acc = __builtin_amdgcn_mfma_f32_32x32x16_bf16(__builtin_bit_cast(bf16x8, lw), qf, acc, 0, 0, 0); }
        float g[16];
#pragma unroll
        for (int r = 0; r < 16; ++r) g[r] = moba::crow(r, hf) < own ? acc[r] : -1e30f;
        unsigned packed = 0;
#pragma unroll
        for (int rd = 0; rd < 3; ++rd) {
            float bv = g[0]; int bi = moba::crow(0, hf);
#pragma unroll
            for (int r = 1; r < 16; ++r) { const int idx = moba::crow(r, hf); if (gate_better(g[r], idx, bv, bi)) { bv = g[r]; bi = idx; } }
            { const float ov = __shfl_xor(bv, 32); const int oi = __shfl_xor(bi, 32); if (gate_better(ov, oi, bv, bi)) { bv = ov; bi = oi; } }
            packed |= (unsigned)bi << (8 * rd);
#pragma unroll
            for (int r = 0; r < 16; ++r) if (moba::crow(r, hf) == bi) g[r] = -3.0e38f;
        }
        if (hf == 0) sel[tq * NH + h] = packed;
    }
}

__device__ __forceinline__ Ctx phase_ctx(const Ctx& C0) { Ctx C = C0; C.lane = lane_id(); asm volatile("" : "+v"(C.lane)); C.tid = C0.wave * 64 + C.lane; C.gw = C.bid * NWAVES + C.wave; return C; }
__device__ __forceinline__ Args phase_args(const Args& a0) { Args a = a0; GAS unsigned char* w = (GAS unsigned char*)a0.ws; asm volatile("" : "+s"(w)); a.ws = (unsigned char*)w; return a; }
#ifndef SKIP_GU
#define SKIP_GU true
#endif
#ifndef SKIP_DN
#define SKIP_DN true
#endif
struct BarRef { const XcdBarrier* b; __device__ __forceinline__ void sync() const { xcd_barrier(*b); } };
__global__ void __launch_bounds__(NTHREADS, 2) mk_fwd(Args args) {
    extern __shared__ __attribute__((aligned(16))) unsigned char lds[];
    Ctx C0; C0.lds = (LAS unsigned char*)lds; C0.tid = threadIdx.x; C0.lane = C0.tid & 63; C0.wave = __builtin_amdgcn_readfirstlane(C0.tid >> 6);
    C0.G = gridDim.x; C0.bid = blockIdx.x; C0.gw = C0.bid * NWAVES + C0.wave; C0.ngw = C0.G * NWAVES;
    LAS unsigned char* ring = C0.lds + RING_OFF;
    for (int u = C0.tid; u < (LDS_BYTES - LDSCTL_OFF) / 4; u += NTHREADS) ((LAS unsigned*)(C0.lds + LDSCTL_OFF))[u] = 0u;
    __syncthreads();
    volatile LAS unsigned* MISC = (volatile LAS unsigned*)(C0.lds + MISC_OFF);
    XcdBarrier bar = xcd_barrier_post((unsigned*)(args.ws + WS_CTL) + CW_BAR, MISC + 8, C0.wave);
#define SEAM() xcd_barrier(bar)
    { const Ctx C = phase_ctx(C0); const Args A = phase_args(args); p0_prologue(C, A); }
    SEAM();
    { const Ctx C = phase_ctx(C0); const Args A = phase_args(args); unsigned char* ws = A.ws;
        const int grp = C.bid >> 3; const bool conv_cu = (C.G == 256) && (grp % 5 == 4);
        if (!conv_cu) {
            const int Gg = C.G == 256 ? 208 : C.G, cg = C.G == 256 ? C.bid - 8 * ((grp + 1) / 5) : C.bid;
            pg8::Gemm g{(const bf16*)(ws + WS_HN), (const bf16*)(ws + WS_WIN), SEQ, NPROJ, DM}; pg8::StaticOrder S; S.init(SEQ, NPROJ, Gg, cg);
            pg8::EpiInProj E{(bf16*)(ws + WS_U), (bf16*)(ws + WS_Q), (bf16*)(ws + WS_K), (bf16*)(ws + WS_V), (bf16*)(ws + WS_SGP), (bf16*)(ws + WS_SGA), (float*)(ws + WS_KPART)};
            pg8::gemm_phase<pg8::EpiInProj, pg8::StaticOrder, true, true>(ring, g, S, E, C.wave);
            conv_tiles<false>(C, A, cg * NWAVES + C.wave);
        } else conv_tiles<true>(C, A, 0);
    }
    SEAM();
    { const Ctx C = phase_ctx(C0); const Args A = phase_args(args); unsigned char* ws = A.ws;
        for (int L = C.bid; L < 128; L += C.G) pool_mixed_tile(C, A, L);
        VM_WAIT(); __syncthreads();
        pg8::Gemm g{(const bf16*)(ws + WS_MIXED), (const bf16*)(ws + WS_WPOOL), 4 * SEQ, 256, 256}; pg8::PoolOrder S{C.G, C.bid};
        pg8::EpiPool E{(bf16*)(ws + WS_YP), A.in[4]};
        pg8::gemm_phase<pg8::EpiPool, pg8::PoolOrder, false, true>(ring, g, S, E, C.wave);
        p_gate_mfma(C, A);
    }
    SEAM();
    { const Ctx C = phase_ctx(C0); const Args A = phase_args(args); p_attn(C, A, 0); }
    SEAM();
    { const Ctx C = phase_ctx(C0); const Args A = phase_args(args); p_combine(C, A); }
    SEAM();
    { const Ctx C = phase_ctx(C0); const Args A = phase_args(args); unsigned char* ws = A.ws;
        pg8::Gemm g{(const bf16*)(ws + WS_YP), (const bf16*)(ws + WS_WBP), 2 * SEQ, 2 * DM, PW}; pg8::BranchOrder S; S.init(C.G, C.bid);
        pg8::EpiBranch E{(const bf16*)(ws + WS_SGP), (bf16*)(ws + WS_TMP), (long)((WS_SGA - WS_SGP) / 2), ((long)WS_HN - (long)WS_TMP) / 2};
        pg8::gemm_phase<pg8::EpiBranch, pg8::BranchOrder, true, true>(ring, g, S, E, C.wave);
    }
    SEAM();
    { const Ctx C = phase_ctx(C0); const Args A = phase_args(args); unsigned char* ws = A.ws;
        pg8::Gemm g{(const bf16*)(ws + WS_HN), (const bf16*)(ws + WS_WOUT), SEQ, DM, DM}; pg8::StaticOrder S; S.init(SEQ, DM, C.G, C.bid);
        pg8::EpiResid E{A.in[0], (bf16*)(ws + WS_X1)};
        pg8::gemm_phase<pg8::EpiResid, pg8::StaticOrder, true, true>(ring, g, S, E, C.wave);
    }
    SEAM();
    { const Ctx C = phase_ctx(C0); const Args A = phase_args(args); BarRef br{&bar}; p_router(C, A, br); }
    SEAM();
    { const Ctx C = phase_ctx(C0); const Args A = phase_args(args); unsigned char* ws = A.ws;
        pg8::Gemm g{(const bf16*)(ws + WS_HN), (const bf16*)(ws + WS_WGU), 0, 0, DM, (const int*)(ws + WS_ROWTOK)}; pg8::MoeOrder S{(const unsigned*)(ws + WS_CTL) + CW_CNT, 0, C.G, C.bid};
        pg8::EpiGU E{(bf16*)(ws + WS_HID), (const float*)(ws + WS_ROWW)};
        pg8::gemm_phase<pg8::EpiGU, pg8::MoeOrder, true, true, false, true>(ring, g, S, E, C.wave);
    }
    SEAM();
    { const Ctx C = phase_ctx(C0); const Args A = phase_args(args); unsigned char* ws = A.ws;
        { pg8::Gemm g{(const bf16*)(ws + WS_HN), (const bf16*)(ws + WS_WGU), 0, 0, DM, (const int*)(ws + WS_ROWTOK)}; pg8::MoeOrder S{(const unsigned*)(ws + WS_CTL) + CW_CNT, 1, C.G, C.bid};
          pg8::EpiGU E{(bf16*)(ws + WS_HID), (const float*)(ws + WS_ROWW)};
          pg8::gemm_phase<pg8::EpiGU, pg8::MoeOrder, true, true, false, true>(ring, g, S, E, C.wave); }
        { pg8::Gemm g{(const bf16*)(ws + WS_HID), (const bf16*)(ws + WS_WDN), 0, 0, DE}; pg8::MoeOrder S{(const unsigned*)(ws + WS_CTL) + CW_CNT, 2, C.G, C.bid};
          pg8::EpiDown E{(bf16*)(ws + WS_Y)};
          pg8::gemm_phase<pg8::EpiDown, pg8::MoeOrder, true, true>(ring, g, S, E, C.wave); }
    }
    SEAM();
    { const Ctx C = phase_ctx(C0); const Args A = phase_args(args); unsigned char* ws = A.ws;
        pg8::Gemm g{(const bf16*)(ws + WS_HID), (const bf16*)(ws + WS_WDN), 0, 0, DE}; pg8::MoeOrder S{(const unsigned*)(ws + WS_CTL) + CW_CNT, 3, C.G, C.bid};
        pg8::EpiDown E{(bf16*)(ws + WS_Y)};
        pg8::gemm_phase<pg8::EpiDown, pg8::MoeOrder, true, true>(ring, g, S, E, C.wave);
    }
    SEAM();
    { const Ctx C = phase_ctx(C0); const Args A = phase_args(args); p8_final(C, A); }
#undef SEAM
}

#ifndef MK_N_LAUNCHES
#define MK_N_LAUNCHES 1
#endif
extern "C" void kernel_launch(void* const* d_in, const int* in_sizes, int n_in, void* d_out, int out_size, void* d_ws, size_t ws_size, hipStream_t stream) {
    static int grid = 0;
    if (grid == 0) {
        if (n_in != 17 || out_size != SEQ * DM || ws_size < WS_END) { fprintf(stderr, "kernel_launch: unexpected shapes (n_in %d out %d ws %zu)\n", n_in, out_size, ws_size); grid = -1; return; }
        int dev = 0, cus = 0, per_cu = 0;
        if (hipGetDevice(&dev) != hipSuccess || hipDeviceGetAttribute(&cus, hipDeviceAttributeMultiprocessorCount, dev) != hipSuccess) { grid = -1; return; }
        if (hipFuncSetAttribute((const void*)mk_fwd, hipFuncAttributeMaxDynamicSharedMemorySize, LDS_BYTES) != hipSuccess) { fprintf(stderr, "kernel_launch: hipFuncSetAttribute failed\n"); grid = -1; return; }
        if (hipOccupancyMaxActiveBlocksPerMultiprocessor(&per_cu, (const void*)mk_fwd, NTHREADS, LDS_BYTES) != hipSuccess || per_cu < 1) { fprintf(stderr, "kernel_launch: occupancy query failed (%d)\n", per_cu); (void)hipGetLastError(); per_cu = 1; }
        if (per_cu > 1) per_cu = 1;
        grid = cus * per_cu;
    }
    if (grid < 0) return;
    (void)hipMemsetAsync((char*)d_ws + WS_CTL, 0, CTL_ZERO_BYTES, stream);
    Args a{};
    for (int i = 0; i < 17; ++i) a.in[i] = (const float*)d_in[i];
    a.out = (float*)d_out; a.ws = (unsigned char*)d_ws;
    if (MK_N_LAUNCHES == 1) {
        a.ph_lo = 0; a.ph_hi = 0; void* kargs[] = {&a};
        hipError_t e = hipLaunchCooperativeKernel((const void*)mk_fwd, dim3(grid), dim3(NTHREADS), kargs, LDS_BYTES, stream);
        if (e != hipSuccess) fprintf(stderr, "kernel_launch: cooperative launch failed: %s (grid %d)\n", hipGetErrorString(e), grid);
    } else {
        fprintf(stderr, "kernel_launch: multi-launch build not supported in this version\n");
    }
}
```

```cpp
#include <hip/hip_runtime.h>
#ifndef CONV_SH0
#define CONV_SH0 4
#define CONV_SH1 2
#define CONV_SH2 12
#endif
#include <cstdio>
#include <cstdint>

__device__ __forceinline__ int lane_id() { int l; asm volatile("v_mbcnt_lo_u32_b32 %0, -1, 0\n\tv_mbcnt_hi_u32_b32 %0, -1, %0" : "=v"(l)); return l; }
__device__ __forceinline__ void xcd_barrier_wait_f(int wave, unsigned* bar, unsigned x, volatile __attribute__((address_space(3))) unsigned* st);
namespace pg8 {
#define PG8_LAS __attribute__((address_space(3)))
typedef unsigned short bf16_t;
typedef short bf16x8 __attribute__((ext_vector_type(8)));
typedef float f32x4 __attribute__((ext_vector_type(4)));
typedef unsigned u32x4 __attribute__((ext_vector_type(4)));
typedef unsigned u32x2 __attribute__((ext_vector_type(2)));
constexpr int BM = 256, BK = 64, HALF = 128, HTB = HALF * BK * 2  , STAGE_BYTES = 8 * HTB, NXCD = 8, WGM = 8;

__host__ __device__ __forceinline__ int lds_byte(int r, int c) { const int st = (r >> 4) * 2 + (c >> 5), rr = r & 15, cc = c & 31, ob = rr * 64 + cc * 2; return st * 1024 + (ob ^ (((ob >> 9) & 1) << 5)); }
__host__ __device__ __forceinline__ void stage_rc(int b, int& R, int& C) { const int st = b / 1024, sb = b % 1024, swz = sb ^ (((sb >> 9) & 1) << 5); R = (st >> 1) * 16 + swz / 64; C = (st & 1) * 32 + (swz % 64) / 2; }
__host__ __device__ __forceinline__ int perm32(int rho) { const int n = rho >> 4, i = rho & 15; return 8 * (i >> 2) + 4 * n + (i & 3); }

struct Unit { int pm, pn, row0, cnt, rows; };
struct Gemm { const bf16_t* A; const bf16_t* Bt; int M, N, K; const int* rowtok; };

struct StaticOrder {
    int nM, nN, nwg, G, c;
    __host__ __device__ __forceinline__ void init(int M, int N, int G_, int c_) { nM = M / BM; nN = N / BM; nwg = nM * nN; G = G_; c = c_; }
    __host__ __device__ __forceinline__ bool next(int i, Unit& u) const {
        const long L = (long)i * G + c; if (L >= nwg) return false;
        int wgid = (int)L; { const int q = nwg / NXCD, r = nwg % NXCD, xcd = wgid % NXCD, off = wgid / NXCD; wgid = (xcd < r ? xcd * (q + 1) : r * (q + 1) + (xcd - r) * q) + off; }
        const int nig = WGM * nN, gid = wgid / nig, fm = gid * WGM, gsz = (nM - fm) < WGM ? (nM - fm) : WGM;
        u.pm = fm + ((wgid % nig) % gsz); u.pn = (wgid % nig) / gsz; u.row0 = 0; u.cnt = 0; u.rows = 256; return true;
    }
    __device__ __forceinline__ void a_ready(const Unit&) const {}
    __device__ __forceinline__ void done(const Unit&) const {}
};

struct RangeOrder {
    StaticOrder so; int i0, i1;
    __device__ __forceinline__ bool next(int i, Unit& u) const { return i0 + i < i1 && so.next(i0 + i, u); }
    __device__ __forceinline__ void a_ready(const Unit&) const {}
    __device__ __forceinline__ void done(const Unit&) const {}
};
__device__ __forceinline__ unsigned cvt_pk_bf16(float lo, float hi) { unsigned r; asm volatile("v_cvt_pk_bf16_f32 %0, %1, %2" : "=v"(r) : "v"(lo), "v"(hi)); return r; }

template <class T, class = void> struct epi_seeds { static constexpr bool value = false; };
template <class T> struct epi_seeds<T, decltype((void)&T::seed)> { static constexpr bool value = true; };
template <class Epi, class Sched, bool ALIGN_EPI = false, bool SP2 = false, bool SKIP = false, bool GATHER = false, bool PRESEED = false>
__device__ __forceinline__ void gemm_phase(PG8_LAS unsigned char* lds, const Gemm g, const Sched& S, const Epi& E, int wave_in, f32x4 (*pre)[2][4][2] = nullptr) {
    int tid_ = wave_in * 64 + lane_id(); asm volatile("" : "+v"(tid_));
    const int tid = tid_, wid = __builtin_amdgcn_readfirstlane(tid >> 6), lane = tid & 63, wr = wid >> 2, wc = wid & 3, fr = lane & 15, fq = lane >> 4;
    const int K = g.K, nt = K / BK;
    unsigned voffA[2], voffB[2];
#pragma unroll
    for (int i = 0; i < 2; ++i) { int R, C; stage_rc(tid * 16 + i * 8192, R, C); const int Rb = Epi::PERM ? ((R & ~31) + perm32(R & 31)) : R;
        voffA[i] = (unsigned)(R * K + C) * 2u; voffB[i] = (unsigned)(Rb * K + C) * 2u; }
    unsigned gvp[2];
    PG8_LAS unsigned* gtab = (PG8_LAS unsigned*)(lds + STAGE_BYTES);
    auto gather_toks = [&](const Unit& u, unsigned (&o)[2]) {
#pragma unroll
        for (int h = 0; h < 2; ++h) { unsigned tk_[2];
#pragma unroll
            for (int i = 0; i < 2; ++i) { int R, C; stage_rc(tid * 16 + i * 8192, R, C); const int slot = u.pm * BM - u.row0 + h * HALF + R;
                tk_[i] = slot < u.cnt ? (unsigned)g.rowtok[(u.pn >> 3) * 8192 + slot] : 0u; }
            o[h] = tk_[0] | (tk_[1] << 16); } };
    auto gather_off = [&](unsigned packed, int i) -> unsigned { int R, C; stage_rc(tid * 16 + i * 8192, R, C); const unsigned tok = i ? (packed >> 16) : (packed & 0xffffu); return (tok * (unsigned)K + (unsigned)C) * 2u; };
    const size_t kstep = (size_t)(BK * 2);
    const size_t hstep = (size_t)HALF * K * 2;
    const size_t tstep = 2 * hstep;
    const unsigned ldsw = (unsigned)wid * 1024u;
    const int aoff = lds_byte(wr * 64 + fr, fq * 8), boff = lds_byte(wc * 32 + fr, fq * 8);
#define PG8_SA(b, h) (((b) * 2 + (h)) * HTB)
#define PG8_SB(b, h) ((4 + (b) * 2 + (h)) * HTB)
#define PG8_STAGE(bufoff, gbase, voff) do { _Pragma("unroll") for (int _i = 0; _i < 2; ++_i) \
        __builtin_amdgcn_global_load_lds((const unsigned*)((const char*)(gbase) + (voff)[_i]), (PG8_LAS unsigned*)(lds + (bufoff) + ldsw + _i * 8192), 16, 0, 0); } while (0)
#define PG8_LDA(dst, b, h) do { _Pragma("unroll") for (int m = 0; m < 4; ++m) _Pragma("unroll") for (int k = 0; k < 2; ++k) dst[m][k] = *(const PG8_LAS bf16x8*)(lds + PG8_SA(b, h) + aoff + m * 2048 + k * 1024); } while (0)
#define PG8_LDB(dst, b, h) do { _Pragma("unroll") for (int n = 0; n < 2; ++n) _Pragma("unroll") for (int k = 0; k < 2; ++k) dst[n][k] = *(const PG8_LAS bf16x8*)(lds + PG8_SB(b, h) + boff + n * 2048 + k * 1024); } while (0)
#define PG8_MMA(ai, bj, At, Bt) do { __builtin_amdgcn_s_setprio(1); _Pragma("unroll") for (int m = 0; m < 4; ++m) { if (!SKIP || (ai) * 128 + wr * 64 + m * 16 < vrows) { _Pragma("unroll") for (int n = 0; n < 2; ++n) _Pragma("unroll") for (int k = 0; k < 2; ++k) \
        acc[ai][bj][m][n] = __builtin_amdgcn_mfma_f32_16x16x32_bf16(Bt[n][k], At[m][k], acc[ai][bj][m][n], 0, 0, 0); } } __builtin_amdgcn_s_setprio(0); } while (0)
#define PG8_WAIT_V(n) asm volatile("s_waitcnt vmcnt(" #n ")" ::: "memory")
#define PG8_WAIT_L(n) asm volatile("s_waitcnt lgkmcnt(" #n ")" ::: "memory")
#define PG8_BAR __builtin_amdgcn_s_barrier()
#define PG8_SCHED __builtin_amdgcn_sched_barrier(0)
    Unit cur, nxt; int ui = 0;
    if (!S.next(0, cur)) return;
    int vrows = cur.rows;
    f32x4 acc[2][2][4][2];
    if constexpr (PRESEED) {
#pragma unroll
        for (int a = 0; a < 2; ++a)
#pragma unroll
            for (int b = 0; b < 2; ++b)
#pragma unroll
                for (int m = 0; m < 4; ++m)
#pragma unroll
                    for (int n = 0; n < 2; ++n) acc[a][b][m][n] = pre[a][b][m][n];
    } else if constexpr (epi_seeds<Epi>::value) E.seed(acc, cur, wr, wc, fr, fq); else {
#pragma unroll
    for (int a = 0; a < 2; ++a)
#pragma unroll
        for (int b = 0; b < 2; ++b)
#pragma unroll
            for (int m = 0; m < 4; ++m)
#pragma unroll
                for (int n = 0; n < 2; ++n) acc[a][b][m][n] = (f32x4){0.f, 0.f, 0.f, 0.f};
    }
    bf16x8 At[4][2], B0[2][2], B1[2][2];
    const char* cA = (const char*)g.A + (GATHER ? (size_t)0 : (size_t)cur.pm * tstep); const char* cB = (const char*)g.Bt + (size_t)cur.pn * tstep;
    if constexpr (GATHER) gather_toks(cur, gvp);
#define PG8_STAGE_A(bufoff, ptr, half, nextu) do { if constexpr (!GATHER) { PG8_STAGE(bufoff, (ptr) + ((half) ? hstep : 0), voffA); } else { \
        const unsigned p_ = (nextu) ? gtab[(half) * 512 + tid] : gvp[half]; unsigned o_[2]; o_[0] = gather_off(p_, 0); o_[1] = gather_off(p_, 1); PG8_STAGE(bufoff, ptr, o_); } } while (0)
    S.a_ready(cur);
    if constexpr (SP2) {
        PG8_STAGE(PG8_SB(0, 0), cB, voffB); PG8_STAGE(PG8_SB(0, 1), cB + hstep, voffB); PG8_STAGE_A(PG8_SA(0, 0), cA, 0, false); PG8_STAGE_A(PG8_SA(0, 1), cA, 1, false);
        if (wr == 1) PG8_BAR;
        PG8_WAIT_V(2); PG8_BAR;
        PG8_STAGE(PG8_SB(1, 0), cB + kstep, voffB); PG8_STAGE_A(PG8_SA(1, 0), cA + kstep, 0, false); PG8_STAGE(PG8_SB(1, 1), cB + hstep + kstep, voffB);
        PG8_WAIT_V(6); PG8_BAR;
    } else {
        PG8_STAGE(PG8_SB(0, 0), cB, voffB); PG8_STAGE(PG8_SA(0, 0), cA, voffA); PG8_STAGE(PG8_SB(0, 1), cB + hstep, voffB); PG8_STAGE(PG8_SA(0, 1), cA + hstep, voffA);
        if (wr == 1) PG8_BAR;
        PG8_WAIT_V(4); PG8_BAR;
        PG8_STAGE(PG8_SB(1, 0), cB + kstep, voffB); PG8_STAGE(PG8_SA(1, 0), cA + kstep, voffA); PG8_STAGE(PG8_SB(1, 1), cB + hstep + kstep, voffB);
        PG8_WAIT_V(6); PG8_BAR;
    }
    for (;;) {
        const bool has_next = S.next(ui + 1, nxt);
        const char* nA = (has_next && !GATHER) ? (const char*)g.A + (size_t)nxt.pm * tstep : cA;
        if constexpr (GATHER) { unsigned o_[2] = {gvp[0], gvp[1]}; if (has_next) gather_toks(nxt, o_); gtab[tid] = o_[0]; gtab[512 + tid] = o_[1]; } const char* nB = has_next ? (const char*)g.Bt + (size_t)nxt.pn * tstep : cB;
        for (int t = 0; t < nt; t += 2) {
            const bool last = (t == nt - 2);
            const char* a1 = cA + (size_t)(t + 1) * kstep;
            const char* a2 = last ? nA : cA + (size_t)(t + 2) * kstep; const char* b2 = last ? nB : cB + (size_t)(t + 2) * kstep;
            const char* a3 = a2 + kstep; const char* b3 = b2 + kstep;
            if (last && has_next) S.a_ready(nxt);
            if constexpr (SP2) {
            PG8_LDB(B0, 0, 0); PG8_LDB(B1, 0, 1); PG8_SCHED; PG8_LDA(At, 0, 0); PG8_STAGE_A(PG8_SA(1, 1), a1, 1, false);
            PG8_WAIT_V(8); PG8_WAIT_L(0); PG8_BAR; PG8_MMA(0, 0, At, B0); PG8_MMA(0, 1, At, B1); PG8_BAR; PG8_SCHED;
            PG8_LDA(At, 0, 1); PG8_STAGE(PG8_SB(0, 0), b2, voffB); PG8_STAGE(PG8_SB(0, 1), b2 + hstep, voffB); PG8_STAGE_A(PG8_SA(0, 0), a2, 0, last);
            PG8_WAIT_V(8); PG8_WAIT_L(0); PG8_BAR; PG8_MMA(1, 0, At, B0); PG8_MMA(1, 1, At, B1); PG8_BAR; PG8_SCHED;
            PG8_LDB(B0, 1, 0); PG8_LDB(B1, 1, 1); PG8_SCHED; PG8_LDA(At, 1, 0); PG8_STAGE_A(PG8_SA(0, 1), a2, 1, last);
            PG8_WAIT_V(8); PG8_WAIT_L(0); PG8_BAR; PG8_MMA(0, 0, At, B0); PG8_MMA(0, 1, At, B1); PG8_BAR; PG8_SCHED;
            PG8_LDA(At, 1, 1); PG8_STAGE(PG8_SB(1, 0), b3, voffB); PG8_STAGE(PG8_SB(1, 1), b3 + hstep, voffB); PG8_STAGE_A(PG8_SA(1, 0), a3, 0, last);
            PG8_WAIT_V(8); PG8_WAIT_L(0); PG8_BAR; PG8_MMA(1, 0, At, B0); PG8_MMA(1, 1, At, B1); PG8_BAR; PG8_SCHED;
            } else {
            PG8_LDB(B0, 0, 0); PG8_SCHED; PG8_LDA(At, 0, 0); PG8_STAGE(PG8_SA(1, 1), a1 + hstep, voffA);
            PG8_WAIT_L(8); PG8_BAR; PG8_WAIT_L(0); PG8_MMA(0, 0, At, B0); PG8_BAR; PG8_SCHED;
            PG8_LDB(B1, 0, 1); PG8_STAGE(PG8_SB(0, 0), b2, voffB);
            PG8_BAR; PG8_WAIT_L(0); PG8_MMA(0, 1, At, B1); PG8_BAR;
            PG8_LDA(At, 0, 1); PG8_STAGE(PG8_SA(0, 0), a2, voffA);
            PG8_BAR; PG8_WAIT_L(0); PG8_MMA(1, 0, At, B0); PG8_BAR; PG8_SCHED;
            PG8_STAGE(PG8_SB(0, 1), b2 + hstep, voffB);
            PG8_WAIT_V(6); PG8_BAR; PG8_MMA(1, 1, At, B1); PG8_BAR;
            PG8_LDB(B0, 1, 0); PG8_SCHED; PG8_LDA(At, 1, 0); PG8_STAGE(PG8_SA(0, 1), a2 + hstep, voffA);
            PG8_WAIT_L(8); PG8_BAR; PG8_WAIT_L(0); PG8_MMA(0, 0, At, B0); PG8_BAR; PG8_SCHED;
            PG8_LDB(B1, 1, 1); PG8_STAGE(PG8_SB(1, 0), b3, voffB);
            PG8_BAR; PG8_WAIT_L(0); PG8_MMA(0, 1, At, B1); PG8_BAR;
            PG8_LDA(At, 1, 1); PG8_STAGE(PG8_SA(1, 0), a3, voffA);
            PG8_BAR; PG8_WAIT_L(0); PG8_MMA(1, 0, At, B0); PG8_BAR; PG8_SCHED;
            PG8_STAGE(PG8_SB(1, 1), b3 + hstep, voffB);
            PG8_WAIT_V(6); PG8_BAR; PG8_MMA(1, 1, At, B1); PG8_BAR;
            }
        }
        if constexpr (ALIGN_EPI) { if (wr == 0) PG8_BAR; }
        if constexpr (!Epi::AFTER_DRAIN) { E(acc, cur, wr, wc, fr, fq); S.done(cur); }
        if (!has_next) break;
        if constexpr (epi_seeds<Epi>::value) E.seed(acc, nxt, wr, wc, fr, fq); else {
#pragma unroll
        for (int a = 0; a < 2; ++a)
#pragma unroll
            for (int b = 0; b < 2; ++b)
#pragma unroll
                for (int m = 0; m < 4; ++m)
#pragma unroll
                    for (int n = 0; n < 2; ++n) acc[a][b][m][n] = (f32x4){0.f, 0.f, 0.f, 0.f};
        }
        cur = nxt; cA = nA; cB = nB; ++ui; vrows = cur.rows;
        if constexpr (GATHER) { gvp[0] = gtab[tid]; gvp[1] = gtab[512 + tid]; }
        if constexpr (ALIGN_EPI) { if (wr == 1) PG8_BAR; }
    }
    PG8_WAIT_V(0);
    if constexpr (!ALIGN_EPI) { if (wr == 0) PG8_BAR; }
    PG8_BAR;
    if constexpr (Epi::AFTER_DRAIN) { E.fused(acc, cur, wr, wc, fr, fq, lds, wid, lane); S.done(cur); }
#undef PG8_STAGE_A
#undef PG8_SA
#undef PG8_SB
#undef PG8_STAGE
#undef PG8_LDA
#undef PG8_LDB
#undef PG8_MMA
#undef PG8_WAIT_V
#undef PG8_WAIT_L
#undef PG8_BAR
#undef PG8_SCHED
}
}

constexpr int SEQ = 8192, DM = 2048, NPROJ = 8192, PW = 1024, AW = 1024, NH = 8, HD = 128, MBLK = 256, NBLK = 32;
constexpr int NE = 16, DE = 1024, ECAP = 8192;
constexpr float RMS_EPS = 1e-6f;
constexpr int NWAVES = 8, NTHREADS = 512;

#define GAS __attribute__((address_space(1)))
#define LAS __attribute__((address_space(3)))
typedef unsigned short bf16;
typedef unsigned v4u __attribute__((ext_vector_type(4)));
typedef unsigned v2u __attribute__((ext_vector_type(2)));
typedef float f32x4 __attribute__((ext_vector_type(4)));
typedef float f32x2 __attribute__((ext_vector_type(2)));
typedef short bf16x8 __attribute__((ext_vector_type(8)));
typedef GAS unsigned gu32;
#define RLX_AGENT __ATOMIC_RELAXED, __HIP_MEMORY_SCOPE_AGENT
#define LDS_WAIT() asm volatile("s_waitcnt lgkmcnt(0)" ::: "memory")
#define VM_WAIT() asm volatile("s_waitcnt vmcnt(0)" ::: "memory")
__device__ __forceinline__ unsigned f2bf(float f) { unsigned u = __builtin_bit_cast(unsigned, f); return (u + 0x7fffu + ((u >> 16) & 1u)) >> 16; }
__device__ __forceinline__ unsigned pk2(float lo, float hi) { unsigned r; asm("v_cvt_pk_bf16_f32 %0, %1, %2" : "=v"(r) : "v"(lo), "v"(hi)); return r; }
__device__ __forceinline__ float bf_lo(unsigned w) { return __builtin_bit_cast(float, w << 16); }
__device__ __forceinline__ float bf_hi(unsigned w) { return __builtin_bit_cast(float, w & 0xffff0000u); }
__device__ __forceinline__ float bf2f(bf16 b) { return __builtin_bit_cast(float, (unsigned)b << 16); }
__device__ __forceinline__ float shx(float v, int o, int lane) { return __builtin_bit_cast(float, __builtin_amdgcn_ds_bpermute((lane ^ o) << 2, __builtin_bit_cast(int, v))); }
__device__ __forceinline__ float wave_sum(float v) {
    const int l = lane_id();
#pragma unroll
    for (int o = 1; o < 64; o <<= 1) v += shx(v, o, l);
    return v;
}
__device__ __forceinline__ float wave_max(float v) {
    const int l = lane_id();
#pragma unroll
    for (int o = 1; o < 64; o <<= 1) v = fmaxf(v, shx(v, o, l));
    return v;
}
__device__ __forceinline__ float sigmoidf_(float x) { return __builtin_amdgcn_rcpf(1.0f + __expf(-x)); }

constexpr size_t MiB = 1u << 20;
constexpr size_t WS_CTL = 0, CTL_ZERO_BYTES = 128 * 1024;
constexpr size_t WS_TOKE = 1 * MiB;
constexpr size_t WS_TOKS = WS_TOKE + 65536;
constexpr size_t WS_ROWTOK = WS_TOKS + 65536;
constexpr size_t WS_ROWW = WS_ROWTOK + 524288;
constexpr size_t WS_SEL = 3 * MiB;
constexpr size_t WS_KMEAN = WS_SEL + 262144;
constexpr size_t WS_KMH = WS_KMEAN + 131072, WS_KML = WS_KMH + 65536;
constexpr size_t WS_KPART = WS_KML + 65536;
constexpr size_t WS_WIN = 4 * MiB, WS_WPOOL = 36 * MiB, WS_WBP = 37 * MiB, WS_WBA = 41 * MiB, WS_WOUT = 45 * MiB, WS_WGU = 53 * MiB, WS_WDN = 181 * MiB;
constexpr size_t WS_HN = 245 * MiB;
constexpr size_t WS_U = 277 * MiB, WS_Q = 293 * MiB, WS_K = 309 * MiB, WS_V = 325 * MiB, WS_SGP = 341 * MiB, WS_SGA = 373 * MiB;
constexpr size_t WS_YP = 405 * MiB, WS_AO = 421 * MiB, WS_MIXED = 437 * MiB, WS_PART = 453 * MiB;
constexpr size_t WS_PART3 = 245 * MiB, WS_ML = 261 * MiB;
constexpr size_t WS_TMP = 437 * MiB;
constexpr size_t WS_X1 = 293 * MiB;
constexpr size_t WS_H2P = 277 * MiB, WS_HID = 357 * MiB, WS_Y = 397 * MiB, WS_END = 502 * MiB;
constexpr int CW_BAR = 4096;
constexpr int CW_ATTN = 8192;
constexpr int CW_CONV = 8192 + 512;
constexpr int CW_MOEQ = 8192 + 1024;
constexpr int CW_CNT = 16384;

namespace pg8 {
struct EpiInProj {
    static constexpr bool PERM = true, AFTER_DRAIN = false;
    bf16_t *u, *q, *k, *v, *sgp, *sga; float* kpart;
    __device__ __forceinline__ void operator()(const f32x4 (&acc)[2][2][4][2], const Unit& un, int wr, int wc, int fr, int fq) const {
        if (un.pn >= 8 && un.pn < 12) {
#pragma unroll
            for (int bj = 0; bj < 2; ++bj)
#pragma unroll
                for (int n = 0; n < 2; ++n) { f32x4 s = acc[0][bj][0][n];
#pragma unroll
                    for (int m = 1; m < 4; ++m) s += acc[0][bj][m][n];
#pragma unroll
                    for (int m = 0; m < 4; ++m) s += acc[1][bj][m][n];
#pragma unroll
                    for (int o = 1; o < 16; o <<= 1) { s.x += __shfl_xor(s.x, o); s.y += __shfl_xor(s.y, o); s.z += __shfl_xor(s.z, o); s.w += __shfl_xor(s.w, o); }
                    if (fr == 0) *(f32x4*)(kpart + (size_t)(un.pm * 2 + wr) * 1024 + (un.pn - 8) * 256 + bj * HALF + wc * 32 + 8 * fq + 4 * n) = s; }
        }
        const int pn = un.pn; bf16_t* base; int ldc, colt; const bool sig = pn >= 16;
        if (pn < 16) { base = pn < 4 ? u : pn < 8 ? q : pn < 12 ? k : v; ldc = 1024; colt = (pn & 3) * 256; }
        else { base = pn < 24 ? sgp : sga; ldc = 2048; colt = (pn & 7) * 256; }
        const int row0 = un.pm * BM + wr * 64 + fr, col0 = colt + wc * 32 + 8 * fq;
#pragma unroll
        for (int ai = 0; ai < 2; ++ai)
#pragma unroll
            for (int m = 0; m < 4; ++m) { bf16_t* rowp = base + (size_t)(row0 + ai * HALF + m * 16) * ldc + col0;
#pragma unroll
                for (int bj = 0; bj < 2; ++bj) { f32x4 v0 = acc[ai][bj][m][0], v1 = acc[ai][bj][m][1];
                    if (sig) {
#pragma unroll
                        for (int i = 0; i < 4; ++i) { v0[i] = __builtin_amdgcn_rcpf(1.0f + __expf(-v0[i])); v1[i] = __builtin_amdgcn_rcpf(1.0f + __expf(-v1[i])); } }
                    u32x4 w; w.x = cvt_pk_bf16(v0[0], v0[1]); w.y = cvt_pk_bf16(v0[2], v0[3]); w.z = cvt_pk_bf16(v1[0], v1[1]); w.w = cvt_pk_bf16(v1[2], v1[3]);
                    *(u32x4*)(rowp + bj * HALF) = w; } }
    }
};
struct EpiPool {
    static constexpr bool PERM = true, AFTER_DRAIN = false;
    bf16_t* yp; const float* scale;
    __device__ __forceinline__ void operator()(const f32x4 (&acc)[2][2][4][2], const Unit& un, int wr, int wc, int fr, int fq) const {
        const int g = un.pn, row0 = (un.pm & 31) * BM + wr * 64 + fr, col0 = g * 256 + wc * 32 + 8 * fq;
#pragma unroll
        for (int bj = 0; bj < 2; ++bj) { const f32x4 s0 = *(const f32x4*)(scale + col0 + bj * HALF), s1 = *(const f32x4*)(scale + col0 + bj * HALF + 4);
#pragma unroll
            for (int ai = 0; ai < 2; ++ai)
#pragma unroll
                for (int m = 0; m < 4; ++m) { bf16_t* rowp = yp + (size_t)(row0 + ai * HALF + m * 16) * 1024 + col0 + bj * HALF;
                    const f32x4 v0 = acc[ai][bj][m][0] * s0, v1 = acc[ai][bj][m][1] * s1;
                    u32x4 w; w.x = cvt_pk_bf16(v0[0], v0[1]); w.y = cvt_pk_bf16(v0[2], v0[3]); w.z = cvt_pk_bf16(v1[0], v1[1]); w.w = cvt_pk_bf16(v1[2], v1[3]);
                    *(u32x4*)rowp = w; } }
    }
};
__device__ __forceinline__ void unpack8(const u32x4 w, float (&f)[8]) {
    f[0] = __builtin_bit_cast(float, w.x << 16); f[1] = __builtin_bit_cast(float, w.x & 0xffff0000u);
    f[2] = __builtin_bit_cast(float, w.y << 16); f[3] = __builtin_bit_cast(float, w.y & 0xffff0000u);
    f[4] = __builtin_bit_cast(float, w.z << 16); f[5] = __builtin_bit_cast(float, w.z & 0xffff0000u);
    f[6] = __builtin_bit_cast(float, w.w << 16); f[7] = __builtin_bit_cast(float, w.w & 0xffff0000u);
}
struct EpiBranch {
    static constexpr bool PERM = true, AFTER_DRAIN = false;
    const bf16_t* sgp; bf16_t* tmp; long sg_step, out_step;
    __device__ __forceinline__ void operator()(const f32x4 (&acc)[2][2][4][2], const Unit& un, int wr, int wc, int fr, int fq) const {
        const bool second = un.pm >= 32; const int pm = second ? un.pm - 32 : un.pm, pn = second ? un.pn - 8 : un.pn;
        const bf16_t* sg = sgp + (second ? sg_step : 0); bf16_t* outp = tmp + (second ? out_step : 0);
        const int row0 = pm * BM + wr * 64 + fr, col0 = pn * BM + wc * 32 + 8 * fq;
        u32x4 gv[2][2][2], tv[2][2][2];
        auto ld = [&](int c, int sl) {
#pragma unroll
            for (int mm = 0; mm < 2; ++mm)
#pragma unroll
                for (int bj = 0; bj < 2; ++bj) { const size_t off = (size_t)(row0 + (c >> 1) * HALF + ((c & 1) * 2 + mm) * 16) * 2048 + col0 + bj * HALF;
                    gv[sl][mm][bj] = *(const u32x4*)(sg + off); tv[sl][mm][bj] = second ? *(const u32x4*)(tmp + off) : u32x4{0u, 0u, 0u, 0u}; } };
        auto st = [&](int c, int sl) { const int ai = c >> 1;
#pragma unroll
            for (int mm = 0; mm < 2; ++mm)
#pragma unroll
                for (int bj = 0; bj < 2; ++bj) { const int m = (c & 1) * 2 + mm; float g[8], t[8]; unpack8(gv[sl][mm][bj], g); unpack8(tv[sl][mm][bj], t);
                    const f32x4 a0 = acc[ai][bj][m][0], a1 = acc[ai][bj][m][1];
                    const float r[8] = {a0[0] * g[0] + t[0], a0[1] * g[1] + t[1], a0[2] * g[2] + t[2], a0[3] * g[3] + t[3], a1[0] * g[4] + t[4], a1[1] * g[5] + t[5], a1[2] * g[6] + t[6], a1[3] * g[7] + t[7]};
                    u32x4 w; w.x = cvt_pk_bf16(r[0], r[1]); w.y = cvt_pk_bf16(r[2], r[3]); w.z = cvt_pk_bf16(r[4], r[5]); w.w = cvt_pk_bf16(r[6], r[7]);
                    *(u32x4*)(outp + (size_t)(row0 + ai * HALF + m * 16) * 2048 + col0 + bj * HALF) = w; } };
        ld(0, 0); ld(1, 1); st(0, 0); ld(2, 0); st(1, 1); ld(3, 1); st(2, 0); st(3, 1);
    }
};
struct BranchOrder {
    StaticOrder so; int nc;
    int sb_wave = 0; unsigned* sb_bar = nullptr; unsigned sb_x = 0; volatile PG8_LAS unsigned* sb_st = nullptr;
    __device__ __forceinline__ void init(int G, int c) { so.init(8192, 2048, G, c); nc = c < so.nwg ? (so.nwg - 1 - c) / G + 1 : 0; }
    __device__ __forceinline__ bool next(int i, Unit& u) const {
        if (i >= 2 * nc) return false; const bool second = i >= nc; (void)so.next(second ? i - nc : i, u); if (second) { u.pm += 32; u.pn += 8; } u.cnt = i == nc ? 1 : 0; return true; }
    __device__ __forceinline__ void a_ready(const Unit& u) const { if (sb_bar != nullptr && u.cnt == 1) xcd_barrier_wait_f(sb_wave, sb_bar, sb_x, sb_st); }
    __device__ __forceinline__ void done(const Unit&) const {}
};
struct EpiResid {
    static constexpr bool PERM = true, AFTER_DRAIN = false;
    const float* x; bf16_t* x1;
    __device__ __forceinline__ void seed(f32x4 (&acc)[2][2][4][2], const Unit& un, int wr, int wc, int fr, int fq) const {
        const int row0 = un.pm * BM + wr * 64 + fr, col0 = un.pn * BM + wc * 32 + 8 * fq;
#pragma unroll
        for (int ai = 0; ai < 2; ++ai)
#pragma unroll
            for (int m = 0; m < 4; ++m)
#pragma unroll
                for (int bj = 0; bj < 2; ++bj)
#pragma unroll
                    for (int n = 0; n < 2; ++n) acc[ai][bj][m][n] = __builtin_nontemporal_load((const f32x4*)(x + (size_t)(row0 + ai * HALF + m * 16) * 2048 + col0 + bj * HALF + n * 4));
    }
    __device__ __forceinline__ void operator()(const f32x4 (&acc)[2][2][4][2], const Unit& un, int wr, int wc, int fr, int fq) const {
        const int row0 = un.pm * BM + wr * 64 + fr, col0 = un.pn * BM + wc * 32 + 8 * fq;
#pragma unroll
        for (int ai = 0; ai < 2; ++ai)
#pragma unroll
            for (int m = 0; m < 4; ++m)
#pragma unroll
                for (int bj = 0; bj < 2; ++bj) { const f32x4 v0 = acc[ai][bj][m][0], v1 = acc[ai][bj][m][1];
                    u32x4 w; w.x = cvt_pk_bf16(v0[0], v0[1]); w.y = cvt_pk_bf16(v0[2], v0[3]); w.z = cvt_pk_bf16(v1[0], v1[1]); w.w = cvt_pk_bf16(v1[2], v1[3]);
                    *(u32x4*)(x1 + (size_t)(row0 + ai * HALF + m * 16) * 2048 + col0 + bj * HALF) = w; }
    }
};
struct EpiGU {
    static constexpr bool PERM = false, AFTER_DRAIN = false;
    bf16_t* hid; const float* roww;
    __device__ __forceinline__ void operator()(const f32x4 (&acc)[2][2][4][2], const Unit& un, int wr, int wc, int fr, int fq) const {
        const int e = un.pn >> 3, pnl = un.pn & 7; const int row0 = un.pm * BM + wr * 64 + fr, col0 = pnl * 128 + wc * 16 + 4 * fq;
        float wv[2][4];
#pragma unroll
        for (int ai = 0; ai < 2; ++ai)
#pragma unroll
            for (int m = 0; m < 4; ++m) { const int slot = row0 + ai * HALF + m * 16 - un.row0; wv[ai][m] = slot < un.cnt ? roww[e * ECAP + slot] : 0.f; }
#pragma unroll
        for (int ai = 0; ai < 2; ++ai)
#pragma unroll
            for (int m = 0; m < 4; ++m) { const int row = row0 + ai * HALF + m * 16; const float w = wv[ai][m];
#pragma unroll
                for (int bj = 0; bj < 2; ++bj) { const f32x4 a = acc[ai][bj][m][0], uu = acc[ai][bj][m][1]; float h[4];
#pragma unroll
                    for (int i = 0; i < 4; ++i) h[i] = a[i] * __builtin_amdgcn_rcpf(1.0f + __expf(-a[i])) * uu[i] * w;
                    u32x2 o; o.x = cvt_pk_bf16(h[0], h[1]); o.y = cvt_pk_bf16(h[2], h[3]);
                    *(u32x2*)(hid + (size_t)row * DE_ + col0 + bj * 64) = o; } }
    }
    static constexpr int DE_ = 1024;
};
struct EpiDown {
    static constexpr bool PERM = true, AFTER_DRAIN = false;
    bf16_t* y;
    __device__ __forceinline__ void operator()(const f32x4 (&acc)[2][2][4][2], const Unit& un, int wr, int wc, int fr, int fq) const {
        const int pnl = un.pn & 7; const int row0 = un.pm * BM + wr * 64 + fr, col0 = pnl * 256 + wc * 32 + 8 * fq;
#pragma unroll
        for (int ai = 0; ai < 2; ++ai)
#pragma unroll
            for (int m = 0; m < 4; ++m) { bf16_t* rowp = y + (size_t)(row0 + ai * HALF + m * 16) * 2048 + col0;
#pragma unroll
                for (int bj = 0; bj < 2; ++bj) { const f32x4 v0 = acc[ai][bj][m][0], v1 = acc[ai][bj][m][1];
                    u32x4 w; w.x = cvt_pk_bf16(v0[0], v0[1]); w.y = cvt_pk_bf16(v0[2], v0[3]); w.z = cvt_pk_bf16(v1[0], v1[1]); w.w = cvt_pk_bf16(v1[2], v1[3]);
                    *(u32x4*)(rowp + bj * HALF) = w; } }
    }
};
struct PoolOrder {
    int G, c;
    __device__ __forceinline__ bool next(int i, Unit& u) const { const int L = i * G + c; if (L >= 128) return false; u.pm = L; u.pn = L >> 5; u.row0 = 0; u.cnt = 0; u.rows = 256; return true; }
    __device__ __forceinline__ void a_ready(const Unit&) const {}
    __device__ __forceinline__ void done(const Unit&) const {}
};
struct MoeOrder {
    const PG8_LAS unsigned* cnt; int mode, G, c;
    __device__ __forceinline__ bool next(int i, Unit& u) const {
        const int lane = lane_id();
        unsigned cv = 0; if (lane < NE_) cv = cnt[lane];
        const int tiles = (int)((cv + 255u) >> 8); int incl = tiles;
#pragma unroll
        for (int o = 1; o < 16; o <<= 1) { const int t = __shfl_up(incl, o); if (lane >= o) incl += t; }
        const int Ttot = __shfl(incl, 15); int L = -1;
        if (G == 256 && Ttot >= 64) {
            const int n3 = 8 * (Ttot - 64), Gp = G - n3;
            const int x = c & 7, sl = c >> 3;
            if (mode == 0) { if (i < 2) L = i * G + x * 32 + sl; }
            else if (mode == 1) { if (i == 0 && c < n3) L = 512 + x * (n3 >> 3) + sl; }
            else if (mode == 2) { if (c >= n3 && i < 2) L = i * Gp + x * (Gp >> 3) + (sl - (n3 >> 3)); }
            else { const int R = 3 * n3, left = R - i * G, cnt_i = left < G ? left : G;
                if (c < cnt_i) { const int r = i * G + x * (cnt_i >> 3) + sl; L = r < 2 * n3 ? 2 * Gp + r : 512 + (r - 2 * n3); } }
        } else {
            if (mode == 0 || mode == 3) { const int l = i * G + c; if (l < 8 * Ttot) L = l; }
        }
        if (L < 0) return false;
        const int T = L >> 3;
        const int e = __popcll(__ballot(lane < NE_ && incl <= T));
        u.pm = __builtin_amdgcn_readfirstlane(T); u.pn = __builtin_amdgcn_readfirstlane(e * 8 + (L & 7)); u.row0 = __builtin_amdgcn_readfirstlane(__shfl(incl - tiles, e) * 256);
        u.cnt = __builtin_amdgcn_readfirstlane((int)__shfl((int)cv, e)); u.rows = 256; return true;
    }
    __device__ __forceinline__ void a_ready(const Unit&) const {}
    __device__ __forceinline__ void done(const Unit&) const {}
    static constexpr int NE_ = 16;
};
}

#define XB_TMO      128
#define XB_XCNT(j)  (256  + 64 * (j))
#define XB_XSUB(j)  (1280 + 64 * (j))
#define XB_XGEN(j)  (2304 + 64 * (j))
#define XB_TOP      3328
#define XB_TOPGEN   3392
#define XCD_BAR_WORDS 3456
#define XB_SPIN_CAP (1u << 18)

__device__ __forceinline__ unsigned xb_ld(unsigned* p)              { return __hip_atomic_load(p, __ATOMIC_RELAXED, __HIP_MEMORY_SCOPE_AGENT); }
__device__ __forceinline__ unsigned xb_add(unsigned* p, unsigned v) { return __hip_atomic_fetch_add(p, v, __ATOMIC_RELAXED, __HIP_MEMORY_SCOPE_AGENT); }
__device__ __forceinline__ unsigned xb_xcc_id() { return (unsigned)__builtin_amdgcn_s_getreg((3 << 11) | 20) & 0xFu; }
#define XB_SPIN(cond, bar) do { unsigned _sp = 0; while (cond) { __builtin_amdgcn_s_sleep(1); \
    if ((++_sp & 255u) == 0u) { if (xb_ld(&(bar)[XB_TMO])) break; if (_sp > XB_SPIN_CAP) { atomicAdd(&(bar)[XB_TMO], 1u); break; } } } } while (0)

struct XcdBarrier {
    int wave;
    unsigned* bar; unsigned x;
    volatile LAS unsigned* st;
};

__device__ __forceinline__ XcdBarrier xcd_barrier_post(unsigned* bar, volatile LAS unsigned* st, int wave) {
    XcdBarrier b; b.wave = wave; b.bar = bar; b.x = xb_xcc_id(); b.st = st;
    if (b.wave == 0 && lane_id() == 0) (void)xb_add(&bar[XB_XCNT(b.x)], 1u);
    return b;
}
__device__ __forceinline__ void xcd_barrier_complete(unsigned* bar, unsigned x, unsigned& nloc, unsigned& nx) {
    const unsigned G = gridDim.x * gridDim.y * gridDim.z;
    unsigned sum, cnt, mine, sp = 0u;
    for (;;) {
        sum = 0u; cnt = 0u; mine = 0u;
#pragma unroll
        for (unsigned j = 0; j < 16; ++j) { const unsigned c = xb_ld(&bar[XB_XCNT(j)]); sum += c; cnt += (c > 0u) ? 1u : 0u; mine = (j == x) ? c : mine; }
        if (sum == G) break;
        __builtin_amdgcn_s_sleep(1);
        if ((++sp & 255u) == 0u) { if (xb_ld(&bar[XB_TMO])) break; if (sp > XB_SPIN_CAP) { atomicAdd(&bar[XB_TMO], 1u); break; } }
    }
    nloc = mine > 0u ? mine : 1u; nx = cnt > 0u ? cnt : 1u;
}

__device__ __forceinline__ void xcd_barrier(const XcdBarrier& b) {
    asm volatile("s_waitcnt vmcnt(0)" ::: "memory");
    __syncthreads();
    if (b.wave == 0 && lane_id() == 0) {
        unsigned* bar = b.bar;
        __builtin_amdgcn_s_waitcnt(0);
        unsigned nloc = b.st[0], nx = b.st[1];
        if (nloc == 0u) { xcd_barrier_complete(bar, b.x, nloc, nx); b.st[0] = nloc; b.st[1] = nx; }
        const unsigned old = xb_add(&bar[XB_XSUB(b.x)], 1u);
        const unsigned gen = old / nloc;
        if (old + 1u == (gen + 1u) * nloc) {
            __builtin_amdgcn_fence(__ATOMIC_RELEASE, "agent");
            asm volatile("s_waitcnt vmcnt(0)" ::: "memory");
            const unsigned og = xb_add(&bar[XB_TOP], 1u);
            const unsigned tg = og / nx;
            if (og + 1u == (tg + 1u) * nx) xb_add(&bar[XB_TOPGEN], 1u);
            else XB_SPIN(xb_ld(&bar[XB_TOPGEN]) == tg, bar);
            __builtin_amdgcn_fence(__ATOMIC_ACQUIRE, "agent");
            xb_add(&bar[XB_XGEN(b.x)], 1u);
            asm volatile("s_waitcnt vmcnt(0)" ::: "memory");
        } else {
            XB_SPIN(xb_ld(&bar[XB_XGEN(b.x)]) == gen, bar);
            __builtin_amdgcn_fence(__ATOMIC_ACQUIRE, "agent");
            asm volatile("s_waitcnt vmcnt(0)" ::: "memory");
        }
    }
    __syncthreads();
}
template <class F>
__device__ __forceinline__ void xcd_barrier_hook(const XcdBarrier& b, const F& f) {
    asm volatile("s_waitcnt vmcnt(0)" ::: "memory");
    __syncthreads();
    if (b.wave == 0 && lane_id() == 0) {
        unsigned* bar = b.bar;
        __builtin_amdgcn_s_waitcnt(0);
        unsigned nloc = b.st[0], nx = b.st[1];
        if (nloc == 0u) { xcd_barrier_complete(bar, b.x, nloc, nx); b.st[0] = nloc; b.st[1] = nx; }
        const unsigned old = xb_add(&bar[XB_XSUB(b.x)], 1u);
        const unsigned gen = old / nloc;
        if (old + 1u == (gen + 1u) * nloc) {
            __builtin_amdgcn_fence(__ATOMIC_RELEASE, "agent");
            asm volatile("s_waitcnt vmcnt(0)" ::: "memory");
            const unsigned og = xb_add(&bar[XB_TOP], 1u);
            const unsigned tg = og / nx;
            if (og + 1u == (tg + 1u) * nx) xb_add(&bar[XB_TOPGEN], 1u);
            else XB_SPIN(xb_ld(&bar[XB_TOPGEN]) == tg, bar);
            __builtin_amdgcn_fence(__ATOMIC_ACQUIRE, "agent");
            xb_add(&bar[XB_XGEN(b.x)], 1u);
            asm volatile("s_waitcnt vmcnt(0)" ::: "memory");
        } else {
            XB_SPIN(xb_ld(&bar[XB_XGEN(b.x)]) == gen, bar);
            __builtin_amdgcn_fence(__ATOMIC_ACQUIRE, "agent");
            asm volatile("s_waitcnt vmcnt(0)" ::: "memory");
        }
    }
    f();
    __syncthreads();
}
__device__ __forceinline__ void xcd_barrier_arrive(const XcdBarrier& b) {
    asm volatile("s_waitcnt vmcnt(0)" ::: "memory");
    __syncthreads();
    if (b.wave == 0 && lane_id() == 0) {
        unsigned* bar = b.bar;
        __builtin_amdgcn_s_waitcnt(0);
        unsigned nloc = b.st[0], nx = b.st[1];
        if (nloc == 0u) { xcd_barrier_complete(bar, b.x, nloc, nx); b.st[0] = nloc; b.st[1] = nx; }
        const unsigned old = xb_add(&bar[XB_XSUB(b.x)], 1u);
        const unsigned gen = old / nloc; unsigned role = 0u, tg = 0u;
        if (old + 1u == (gen + 1u) * nloc) {
            __builtin_amdgcn_fence(__ATOMIC_RELEASE, "agent");
            asm volatile("s_waitcnt vmcnt(0)" ::: "memory");
            const unsigned og = xb_add(&bar[XB_TOP], 1u); tg = og / nx;
            if (og + 1u == (tg + 1u) * nx) { xb_add(&bar[XB_TOPGEN], 1u); role = 2u; } else role = 1u;
        }
        b.st[2] = role; b.st[3] = gen; b.st[4] = tg;
    }
}
__device__ __forceinline__ void xcd_barrier_wait_f(int wave, unsigned* bar_, unsigned x, volatile LAS unsigned* st) {
    if (wave == 0 && lane_id() == 0) {
        unsigned* bar = bar_; const unsigned role = st[2], gen = st[3], tg = st[4];
        if (role != 0u) {
            if (role == 1u) XB_SPIN(xb_ld(&bar[XB_TOPGEN]) == tg, bar);
            __builtin_amdgcn_fence(__ATOMIC_ACQUIRE, "agent");
            xb_add(&bar[XB_XGEN(x)], 1u);
            asm volatile("s_waitcnt vmcnt(0)" ::: "memory");
        } else {
            XB_SPIN(xb_ld(&bar[XB_XGEN(x)]) == gen, bar);
            __builtin_amdgcn_fence(__ATOMIC_ACQUIRE, "agent");
            asm volatile("s_waitcnt vmcnt(0)" ::: "memory");
        }
    }
    __syncthreads();
}


constexpr int RING_OFF = 0, RING_BYTES = 139264;
constexpr int LDSCTL_OFF = RING_BYTES, MISC_OFF = LDSCTL_OFF + 320;
constexpr int LDS_BYTES = 147456;

struct Args { const float* in[17]; float* out; unsigned char* ws; int ph_lo, ph_hi; };

struct Ctx {
    LAS unsigned char* lds; int tid, lane, wave, G, bid, gw, ngw;
};

struct TrDesc { const float* src; bf16* dst; int N, K, mode, n0; };
__device__ __forceinline__ TrDesc tr_desc(const float* W, int K, int N, bf16* WT, int mode, int tile) {
    const int nblk = N >> 6, kb = tile / nblk, nb = tile - kb * nblk; TrDesc d; d.src = W + (size_t)(kb * 64) * N + nb * 64; d.dst = WT + kb * 64; d.N = N; d.K = K; d.mode = mode; d.n0 = nb * 64; return d;
}
__device__ __forceinline__ void tr_load(const TrDesc& d, f32x4 (&v)[16], int lane) {
    const unsigned lo = (unsigned)((lane >> 4) * d.N + 4 * (lane & 15)) * 4u;
    const char* p = (const char*)d.src;
#pragma unroll
    for (int i = 0; i < 16; ++i) v[i] = __builtin_nontemporal_load((const f32x4*)(p + (size_t)(16 * i) * d.N + lo));
}
__device__ __forceinline__ void tr_store(const TrDesc& d, const f32x4 (&v)[16], LAS float* scr, int lane) {
    asm volatile("" ::: "memory"); __builtin_amdgcn_sched_barrier(0);
    {   const unsigned wa = (unsigned)(uintptr_t)(scr + (lane >> 4) * 65 + 4 * (lane & 15));
#pragma unroll
        for (int i = 0; i < 16; ++i) {
            asm volatile("ds_write_b32 %0, %1 offset:%2" :: "v"(wa), "v"(v[i].x), "n"(i * 1040 + 0) : "memory");
            asm volatile("ds_write_b32 %0, %1 offset:%2" :: "v"(wa), "v"(v[i].y), "n"(i * 1040 + 4) : "memory");
            asm volatile("ds_write_b32 %0, %1 offset:%2" :: "v"(wa), "v"(v[i].z), "n"(i * 1040 + 8) : "memory");
            asm volatile("ds_write_b32 %0, %1 offset:%2" :: "v"(wa), "v"(v[i].w), "n"(i * 1040 + 12) : "memory"); } }
    LDS_WAIT(); asm volatile("" ::: "memory");
    const int c = lane >> 3;
    const int rowbase = d.mode == 0 ? d.n0 : (d.n0 >> 4) * 32 + (d.mode == 2 ? 16 : 0);
    const unsigned so = (unsigned)((lane & 7) * d.K + 8 * c) * 2u;
    char* q = (char*)(d.dst + (size_t)rowbase * d.K);
#pragma unroll
    for (int j = 0; j < 8; ++j) { const LAS float* s = scr + (8 * c) * 65 + (lane & 7) + 8 * j;
        v4u o; o.x = pk2(s[0 * 65], s[1 * 65]); o.y = pk2(s[2 * 65], s[3 * 65]); o.z = pk2(s[4 * 65], s[5 * 65]); o.w = pk2(s[6 * 65], s[7 * 65]);
        const int rowj = d.mode == 0 ? 8 * j : (j >> 1) * 32 + 8 * (j & 1);
        __builtin_nontemporal_store(o, (v4u*)(q + (size_t)(2 * rowj) * d.K + so)); }
    LDS_WAIT(); asm volatile("" ::: "memory");
}
__device__ __forceinline__ void rms_row_bf16(const float* xrow, const float* g, bf16* orow, int lane) {
    f32x4 v[8]; float s = 0.f;
#pragma unroll
    for (int j = 0; j < 4; ++j) { const float* p = xrow + 8 * (lane + 64 * j); v[2 * j] = __builtin_nontemporal_load((const f32x4*)p); v[2 * j + 1] = __builtin_nontemporal_load((const f32x4*)(p + 4)); }
#pragma unroll
    for (int j = 0; j < 8; ++j) s += (v[j].x * v[j].x + v[j].y * v[j].y) + (v[j].z * v[j].z + v[j].w * v[j].w);
    const float rstd = 1.0f / sqrtf(wave_sum(s) * (1.0f / DM) + RMS_EPS);
#pragma unroll
    for (int j = 0; j < 4; ++j) { const float* gp = g + 8 * (lane + 64 * j); const f32x4 g0 = *(const f32x4*)gp, g1 = *(const f32x4*)(gp + 4);
        const f32x4 a = v[2 * j] * rstd * g0, b = v[2 * j + 1] * rstd * g1;
        v4u o; o.x = pk2(a.x, a.y); o.y = pk2(a.z, a.w); o.z = pk2(b.x, b.y); o.w = pk2(b.z, b.w);
        *(v4u*)(orow + 8 * (lane + 64 * j)) = o; }
}
__device__ __forceinline__ TrDesc p0_desc(const Args& a, int r) {
    unsigned char* ws = a.ws;
    constexpr int T_IN = (DM / 64) * (NPROJ / 64);
    if (r < T_IN) return tr_desc(a.in[2], DM, NPROJ, (bf16*)(ws + WS_WIN), 0, r); r -= T_IN;
    const int g = r >> 4; return tr_desc(a.in[3] + (size_t)g * 65536, 256, 256, (bf16*)(ws + WS_WPOOL) + (size_t)g * 65536, 0, r & 15);
}
__device__ __forceinline__ TrDesc late_desc(const Args& a, int r) {
    unsigned char* ws = a.ws;
    constexpr int T_BP = (PW / 64) * (DM / 64);
    if (r < T_BP) return tr_desc(a.in[5], PW, DM, (bf16*)(ws + WS_WBP), 0, r); r -= T_BP;
    if (r < T_BP) return tr_desc(a.in[6], AW, DM, (bf16*)(ws + WS_WBA), 0, r); r -= T_BP;
    return tr_desc(a.in[7], DM, DM, (bf16*)(ws + WS_WOUT), 0, r);
}
__device__ __forceinline__ void late_hook(const Ctx& C, const Args& a, int part) {
    constexpr int T_BP = (PW / 64) * (DM / 64), T_ALL = 2 * T_BP + (DM / 64) * (DM / 64), NHALF = T_ALL / 2;
    if (C.wave == 0 || C.wave > 4) return;
    const int lane = lane_id(); f32x4 va[16];
    LAS float* scr = (LAS float*)(C.lds + C.wave * 16640);
#pragma unroll 1
    for (int s_ = C.bid * 4 + (C.wave - 1); s_ < NHALF; s_ += 4 * C.G) {
        const int t = part == 0 ? (s_ < T_BP ? s_ : s_ + T_BP) : (s_ < T_BP ? s_ + T_BP : s_ + 2 * T_BP);
        const TrDesc d = late_desc(a, t); tr_load(d, va, lane); tr_store(d, va, scr, lane); }
}
__device__ __forceinline__ void p0_prologue(const Ctx& C, const Args& a) {
    LAS float* scr = (LAS float*)(C.lds + C.wave * 16640);
    constexpr int NT = (DM / 64) * (NPROJ / 64) + 64;
    int it = C.gw;
    if (it < NT) {
        f32x4 va[16], vb[16]; TrDesc d0 = p0_desc(a, it); tr_load(d0, va, C.lane);
        for (;;) { const int nx = it + C.ngw; const bool more = nx < NT; TrDesc d1 = d0;
            if (more) { d1 = p0_desc(a, nx); tr_load(d1, vb, C.lane); }
            tr_store(d0, va, scr, C.lane);
            if (!more) break;
            d0 = d1; it = nx;
#pragma unroll
            for (int i = 0; i < 16; ++i) va[i] = vb[i]; }
    }
    for (int m = C.gw; m < SEQ; m += C.ngw) rms_row_bf16(a.in[0] + (size_t)m * DM, a.in[1], (bf16*)(a.ws + WS_HN) + (size_t)m * DM, C.lane);
}
constexpr int CV_NT = 3 * NE * (DM / 64) * (DE / 64), CV_S5 = 1, CV_S4 = 8, CV_HOOK = 4096, CV_H0 = CV_NT - CV_HOOK, CV_HA = 768, CV_HC = 512, CV_HD = 1024, CV_HE = 1024;
static_assert(2 * CV_HA + CV_HC + CV_HD + CV_HE == CV_HOOK, "hook tiles");
__device__ __forceinline__ TrDesc moe_desc(const Args& a, int r);
__device__ __forceinline__ void moe_hook(const Ctx& C, const Args& a, int w0, int nw, int base, int n) {
    if (C.wave < w0 || C.wave >= w0 + nw) return;
    const int lane = lane_id(); f32x4 va[16];
    LAS float* scr = (LAS float*)(C.lds + C.wave * 16640);
#pragma unroll 1
    for (int s_ = C.bid * nw + (C.wave - w0); s_ < n; s_ += nw * C.G) { const TrDesc d = moe_desc(a, base + s_); tr_load(d, va, lane); tr_store(d, va, scr, lane); }
}
__device__ __forceinline__ TrDesc moe_desc(const Args& a, int r) {
    unsigned char* ws = a.ws;
    constexpr int TPE_G = (DM / 64) * (DE / 64), TPE_D = (DE / 64) * (DM / 64), T_G = NE * TPE_G;
    if (r < T_G) { const int e = r / TPE_G; return tr_desc(a.in[13] + (size_t)e * DM * DE, DM, DE, (bf16*)(ws + WS_WGU) + (size_t)e * 2048 * DM, 1, r - e * TPE_G); } r -= T_G;
    if (r < T_G) { const int e = r / TPE_G; return tr_desc(a.in[14] + (size_t)e * DM * DE, DM, DE, (bf16*)(ws + WS_WGU) + (size_t)e * 2048 * DM, 2, r - e * TPE_G); } r -= T_G;
    const int e = r / TPE_D; return tr_desc(a.in[15] + (size_t)e * DE * DM, DE, DM, (bf16*)(ws + WS_WDN) + (size_t)e * DM * DE, 0, r - e * TPE_D);
}
template <bool CONV_CU>
__device__ __forceinline__ void conv_tiles(const Ctx& C, const Args& a, int idx, int s_lo = 0, int s_hi = 0) {
    LAS float* scr = (LAS float*)(C.lds + C.wave * 16640);
    constexpr int NT = 3 * NE * (DM / 64) * (DE / 64), NW5 = 192 * NWAVES, NW4 = 16 * NWAVES, S5 = CV_S5, S4 = CV_S4, NT_A = NT - CV_HOOK - S5 * NW5 - S4 * NW4, NT_8 = NT_A - 1536;
    static_assert(NT == CV_NT, "tile count");
    static_assert(NT_A % 64 == 0 && NT_8 % 64 == 0 && NT_8 > 0, "whole tile groups");
    f32x4 va[16], vb[16];
    if (C.G != 256) { for (int t = C.gw; t < NT; t += C.ngw) { const TrDesc d = moe_desc(a, t); tr_load(d, va, C.lane); tr_store(d, va, scr, C.lane); } return; }
    if (!CONV_CU) {
        const bool five = idx < NW5; const int step = five ? NW5 : NW4; int t = (five ? NT_A + idx : NT_A + S5 * NW5 + (idx - NW5)) + s_lo * step;
#pragma unroll 1
        for (int s_ = s_lo; s_ < s_hi; ++s_, t += step) { const TrDesc d = moe_desc(a, t); tr_load(d, va, C.lane); tr_store(d, va, scr, C.lane); }
        return;
    }
    unsigned* ctr = (unsigned*)(a.ws + WS_CTL) + CW_CONV;
    auto pull = [&](unsigned* c, unsigned n) -> int { unsigned b0 = 0; if (C.lane == 0) b0 = __hip_atomic_fetch_add(c, n, RLX_AGENT); return __builtin_amdgcn_readfirstlane((int)b0); };
    auto first = [&](int base_) { const int b = base_ >> 3; return moe_desc(a, ((b >> 3) << 6) + (b & 7)); };
    auto sub = [](const TrDesc& m, int i) { const int sh = m.N == DM ? 2 : 1  , nbi = i & ((1 << sh) - 1), kbi = i >> sh;
        TrDesc d = m; d.src = m.src + (size_t)(kbi * 64) * m.N + nbi * 512; d.dst = m.dst + kbi * 64; d.n0 = m.n0 + nbi * 512; return d; };
    int base = pull(ctr, 8u);
    if (base < NT_8) {
        TrDesc m = first(base); tr_load(m, va, C.lane);
        for (;;) {
            const TrDesc d1 = sub(m, 1); tr_load(d1, vb, C.lane); tr_store(m, va, scr, C.lane);
            const TrDesc d2 = sub(m, 2); tr_load(d2, va, C.lane); tr_store(d1, vb, scr, C.lane);
            const TrDesc d3 = sub(m, 3); tr_load(d3, vb, C.lane); tr_store(d2, va, scr, C.lane);
            const TrDesc d4 = sub(m, 4); tr_load(d4, va, C.lane); tr_store(d3, vb, scr, C.lane);
            const TrDesc d5 = sub(m, 5); tr_load(d5, vb, C.lane); tr_store(d4, va, scr, C.lane);
            const TrDesc d6 = sub(m, 6); tr_load(d6, va, C.lane); tr_store(d5, vb, scr, C.lane);
            const TrDesc d7 = sub(m, 7); tr_load(d7, vb, C.lane); tr_store(d6, va, scr, C.lane);
            base = pull(ctr, 8u);
            if (base >= NT_8) { tr_store(d7, vb, scr, C.lane); break; }
            m = first(base); tr_load(m, va, C.lane);
            tr_store(d7, vb, scr, C.lane);
        }
    }
    for (;;) {
        const int t = pull(ctr + 64, 2u); if (t >= NT_A - NT_8) break;
        const TrDesc d0 = moe_desc(a, NT_8 + t), d1 = moe_desc(a, NT_8 + t + 1);
        tr_load(d0, va, C.lane); tr_load(d1, vb, C.lane); tr_store(d0, va, scr, C.lane); tr_store(d1, vb, scr, C.lane);
    }
}

template <int G_, class After>
__device__ __forceinline__ void pool_mixed_rows(const bf16* up, bf16* mp, int r0, const After& after_loads) {
    constexpr int W = 2 << G_, NR = W + 15;
    v4u raw[NR];
#pragma unroll
    for (int j = 0; j < NR; ++j) { const int i = r0 - W + 1 + j; raw[j] = i >= 0 ? *(const v4u*)(up + (size_t)i * PW) : (v4u){0u, 0u, 0u, 0u}; }
    after_loads();
    float s[8];
#pragma unroll
    for (int k = 0; k < 8; ++k) s[k] = 0.f;
#pragma unroll
    for (int j = 0; j < W - 1; ++j) { float f[8]; pg8::unpack8(raw[j], f);
#pragma unroll
        for (int k = 0; k < 8; ++k) s[k] += f[k]; }
#pragma unroll
    for (int q = 0; q < 16; ++q) { const int r = r0 + q; float cur[8]; pg8::unpack8(raw[W - 1 + q], cur);
#pragma unroll
        for (int k = 0; k < 8; ++k) s[k] += cur[k];
        if (q > 0) { float o[8]; pg8::unpack8(raw[q - 1], o);
#pragma unroll
            for (int k = 0; k < 8; ++k) s[k] -= o[k]; }
        const float inv = 1.0f / (float)(r + 1 < W ? r + 1 : W);
        v4u o; o.x = pk2(s[0] * inv - cur[0], s[1] * inv - cur[1]); o.y = pk2(s[2] * inv - cur[2], s[3] * inv - cur[3]);
        o.z = pk2(s[4] * inv - cur[4], s[5] * inv - cur[5]); o.w = pk2(s[6] * inv - cur[6], s[7] * inv - cur[7]);
        *(v4u*)(mp + (size_t)r * 256) = o; }
}
template <class After>
__device__ __forceinline__ void pool_mixed_tile(const Ctx& C, const Args& a, int L, const After& after_loads) {
    unsigned char* ws = a.ws; const bf16* u = (const bf16*)(ws + WS_U); bf16* mixed = (bf16*)(ws + WS_MIXED);
    const int g = L >> 5, rt = L & 31; const int chunk = C.tid & 31, run = C.tid >> 5;
    const int r0 = rt * 256 + run * 16; const bf16* up = u + g * 256 + chunk * 8; bf16* mp = mixed + ((size_t)g * SEQ) * 256 + chunk * 8;
    if (g == 0) pool_mixed_rows<0>(up, mp, r0, after_loads); else if (g == 1) pool_mixed_rows<1>(up, mp, r0, after_loads); else if (g == 2) pool_mixed_rows<2>(up, mp, r0, after_loads); else pool_mixed_rows<3>(up, mp, r0, after_loads);
}
__device__ __forceinline__ void pool_unit(const Ctx& C, const Args& a, int L) {
    typedef float f32x16 __attribute__((ext_vector_type(16)));
    unsigned char* ws = a.ws; LAS unsigned char* lds = C.lds; const int lane = lane_id(), wave = C.wave;
    const int g = L >> 5, rt = L & 31;
    const bf16* Wt = (const bf16*)(ws + WS_WPOOL) + (size_t)g * 65536; const float* scale = a.in[4] + g * 256;
    if (C.tid < 64) *(LAS f32x4*)(lds + 131072 + C.tid * 16) = *(const f32x4*)(scale + 4 * C.tid);
    pool_mixed_tile(C, a, L, [&]() {
#pragma unroll
        for (int i = 0; i < 16; ++i) { const int p = wave * 16 + i, c = 2 * p + (lane >> 5), j = lane & 31;
            __builtin_amdgcn_global_load_lds((const unsigned*)(Wt + (size_t)c * 256 + ((j ^ (c & 31)) * 8)), (LAS unsigned*)(lds + p * 1024), 16, 0, 0); } });
    VM_WAIT(); __syncthreads();
    const int ln = lane_id(), ql = ln & 31, hf = ln >> 5;
    const int t = rt * 256 + wave * 32 + ql;
    const bf16* mp = (const bf16*)(ws + WS_MIXED) + ((size_t)g * SEQ + t) * 256 + 8 * hf;
    bf16x8 bq[16];
#pragma unroll
    for (int s_ = 0; s_ < 16; ++s_) bq[s_] = *(const bf16x8*)(mp + 16 * s_);
    bf16* yp = (bf16*)(ws + WS_YP) + (size_t)t * PW + g * 256;
#pragma unroll 1
    for (int cb = 0; cb < 8; ++cb) {
        f32x16 acc;
#pragma unroll
        for (int r = 0; r < 16; ++r) acc[r] = 0.f;
        const LAS unsigned char* ab = lds + (cb * 32 + ql) * 512;
#pragma unroll
        for (int s_ = 0; s_ < 16; ++s_) acc = __builtin_amdgcn_mfma_f32_32x32x16_bf16(*(const LAS bf16x8*)(ab + (((2 * s_ + hf) ^ ql) * 16)), bq[s_], acc, 0, 0, 0);
#pragma unroll
        for (int q = 0; q < 4; ++q) { const int c0 = cb * 32 + 8 * q + 4 * hf; const f32x4 sc = *(const LAS f32x4*)(lds + 131072 + c0 * 4);
            v2u o; o.x = pk2(acc[4 * q] * sc.x, acc[4 * q + 1] * sc.y); o.y = pk2(acc[4 * q + 2] * sc.z, acc[4 * q + 3] * sc.w);
            *(v2u*)(yp + c0) = o; }
    }
    __syncthreads();
}

__device__ __forceinline__ bool gate_better(float av, int ai, float bv, int bi) { return av > bv || (av == bv && ai < bi); }

__device__ __forceinline__ void moe_offsets(const unsigned* cnt, int lane, int& incl_tiles, int& tiles, unsigned& cv) {
    cv = 0; if (lane < NE) cv = __hip_atomic_load(cnt + 64 * lane, RLX_AGENT);
    tiles = (int)((cv + 255u) >> 8); incl_tiles = tiles;
#pragma unroll
    for (int o = 1; o < 16; o <<= 1) { const int tt = __shfl_up(incl_tiles, o); if (lane >= o) incl_tiles += tt; }
}
constexpr int TPW = 4;
__device__ __forceinline__ void reduce32(float (&v)[32], int lane) {
#pragma unroll
    for (int i = 0; i < 16; ++i) { const bool up = lane & 32; const float snd = up ? v[i] : v[i + 16], kp = up ? v[i + 16] : v[i]; v[i] = kp + shx(snd, 32, lane); }
#pragma unroll
    for (int i = 0; i < 8; ++i) { const bool up = lane & 16; const float snd = up ? v[i] : v[i + 8], kp = up ? v[i + 8] : v[i]; v[i] = kp + shx(snd, 16, lane); }
#pragma unroll
    for (int i = 0; i < 4; ++i) { const bool up = lane & 8; const float snd = up ? v[i] : v[i + 4], kp = up ? v[i + 4] : v[i]; v[i] = kp + shx(snd, 8, lane); }
#pragma unroll
    for (int i = 0; i < 2; ++i) { const bool up = lane & 4; const float snd = up ? v[i] : v[i + 2], kp = up ? v[i + 2] : v[i]; v[i] = kp + shx(snd, 4, lane); }
    { const bool up = lane & 2; const float snd = up ? v[0] : v[1], kp = up ? v[1] : v[0]; v[0] = kp + shx(snd, 2, lane); }
    v[0] += shx(v[0], 1, lane);
}
template <class Bar>
__device__ __forceinline__ void p_router(const Ctx& C, const Args& a, const Bar& bar) {
    unsigned char* ws = a.ws; const bf16* x1 = (const bf16*)(ws + WS_X1); const float* g2 = a.in[8];
    const float* wrg = a.in[9]; const float* brg = a.in[10]; const float* wre = a.in[11]; const float* bre = a.in[12];
    unsigned* cnt = (unsigned*)(ws + WS_CTL) + CW_CNT;
    int* toke = (int*)(ws + WS_TOKE); int* toks = (int*)(ws + WS_TOKS); int* rowtok = (int*)(ws + WS_ROWTOK); float* roww = (float*)(ws + WS_ROWW);
    bf16* h2 = (bf16*)(ws + WS_HN);
    const int lane = C.lane, tid = C.tid;
    LAS float* wl = (LAS float*)C.lds;
    const bf16* xp[TPW];
#pragma unroll
    for (int k = 0; k < TPW; ++k) { const int t = C.gw + k * C.ngw; xp[k] = x1 + (size_t)__builtin_amdgcn_readfirstlane(t < SEQ ? t : 0) * DM; }
    const int lo4 = 4 * lane;
    float ga[TPW][4], ssq[TPW];
#pragma unroll
    for (int k = 0; k < TPW; ++k) { ssq[k] = 0.f; ga[k][0] = 0.f; ga[k][1] = 0.f; ga[k][2] = 0.f; ga[k][3] = 0.f; }
    __syncthreads();
#pragma unroll
    for (int r = 0; r < 4; ++r) *(LAS f32x4*)(wl + (r * 512 + tid) * 4) = *(const f32x4*)(wrg + (size_t)(r * 512 + tid) * 4);
    pg8::u32x2 xn[TPW][2]; f32x4 gn[2];
#pragma unroll
    for (int jj = 0; jj < 2; ++jj) { gn[jj] = *(const f32x4*)(g2 + 256 * jj + 4 * lane);
#pragma unroll
        for (int k = 0; k < TPW; ++k) xn[k][jj] = *(const pg8::u32x2*)(xp[k] + (256 * jj + lo4)); }
    __syncthreads();
#pragma unroll 1
    for (int ch = 0; ch < 4; ++ch) {
        pg8::u32x2 xv[TPW][2]; f32x4 gg[2];
#pragma unroll
        for (int jj = 0; jj < 2; ++jj) { gg[jj] = gn[jj];
#pragma unroll
            for (int k = 0; k < TPW; ++k) xv[k][jj] = xn[k][jj]; }
        { const int cn = ch < 3 ? ch + 1 : 3;
#pragma unroll
            for (int jj = 0; jj < 2; ++jj) { gn[jj] = *(const f32x4*)(g2 + cn * 512 + 256 * jj + 4 * lane);
#pragma unroll
                for (int k = 0; k < TPW; ++k) xn[k][jj] = *(const pg8::u32x2*)(xp[k] + (cn * 512 + 256 * jj + lo4)); } }
#pragma unroll
        for (int jj = 0; jj < 2; ++jj)
#pragma unroll
            for (int i = 0; i < 4; ++i) { const f32x4 w = *(const LAS f32x4*)(wl + (ch * 512 + 256 * jj + 4 * lane + i) * 4);
#pragma unroll
                for (int k = 0; k < TPW; ++k) { const unsigned xw_ = i < 2 ? xv[k][jj].x : xv[k][jj].y; const float x = (i & 1) ? bf_hi(xw_) : bf_lo(xw_), xs = x * gg[jj][i]; ssq[k] += x * x; ga[k][0] += xs * w.x; ga[k][1] += xs * w.y; ga[k][2] += xs * w.z; ga[k][3] += xs * w.w; } }
    }
    float rstd[TPW], gwt[TPW]; int gi[TPW];
    { float v[32];
#pragma unroll
        for (int c = 0; c < 32; ++c) v[c] = 0.f;
#pragma unroll
        for (int k = 0; k < TPW; ++k) { v[5 * k] = ga[k][0]; v[5 * k + 1] = ga[k][1]; v[5 * k + 2] = ga[k][2]; v[5 * k + 3] = ga[k][3]; v[5 * k + 4] = ssq[k]; }
        reduce32(v, lane); const float vt = v[0];
#pragma unroll
        for (int k = 0; k < TPW; ++k) {
            rstd[k] = 1.0f / sqrtf(__shfl(vt, 2 * (5 * k + 4)) * (1.0f / DM) + RMS_EPS);
            float gl[4];
#pragma unroll
            for (int i = 0; i < 4; ++i) gl[i] = __shfl(vt, 2 * (5 * k + i)) * rstd[k] + brg[i];
            int g = 0; float gm = gl[0];
#pragma unroll
            for (int i = 1; i < 4; ++i) if (gl[i] > gm) { gm = gl[i]; g = i; }
            float gs = 0.f;
#pragma unroll
            for (int i = 0; i < 4; ++i) gs += __expf(gl[i] - gm);
            gi[k] = g; gwt[k] = 1.0f / gs;
            asm volatile("" : "+v"(gwt[k]));
            __builtin_amdgcn_sched_barrier(0);
        } }
    float eacc[TPW][4];
#pragma unroll
    for (int k = 0; k < TPW; ++k) { eacc[k][0] = 0.f; eacc[k][1] = 0.f; eacc[k][2] = 0.f; eacc[k][3] = 0.f; }
    {
    __syncthreads();
#pragma unroll
    for (int g = 0; g < 4; ++g)
#pragma unroll
        for (int r = 0; r < 4; ++r) *(LAS f32x4*)(wl + g * 8192 + (r * 512 + tid) * 4) = *(const f32x4*)(wre + ((size_t)g * DM + r * 512 + tid) * 4);
    pg8::u32x2 xn[TPW][2];
#pragma unroll
    for (int jj = 0; jj < 2; ++jj)
#pragma unroll
        for (int k = 0; k < TPW; ++k) xn[k][jj] = *(const pg8::u32x2*)(xp[k] + (256 * jj + lo4));
    __syncthreads();
#pragma unroll 1
    for (int ch = 0; ch < 4; ++ch) {
        pg8::u32x2 xv[TPW][2]; f32x4 gg[2];
#pragma unroll
        for (int jj = 0; jj < 2; ++jj) { gg[jj] = *(const f32x4*)(g2 + ch * 512 + 256 * jj + 4 * lane);
#pragma unroll
            for (int k = 0; k < TPW; ++k) xv[k][jj] = xn[k][jj]; }
        { const int cn = ch < 3 ? ch + 1 : 3;
#pragma unroll
            for (int jj = 0; jj < 2; ++jj)
#pragma unroll
                for (int k = 0; k < TPW; ++k) xn[k][jj] = *(const pg8::u32x2*)(xp[k] + (cn * 512 + 256 * jj + lo4)); }
#pragma unroll
        for (int k = 0; k < TPW; ++k) { const int t = C.gw + k * C.ngw; const LAS float* wp = wl + gi[k] * 8192 + ch * 2048;
#pragma unroll
            for (int jj = 0; jj < 2; ++jj) { float hs[4];
#pragma unroll
                for (int i = 0; i < 4; ++i) { const f32x4 w = *(const LAS f32x4*)(wp + (256 * jj + 4 * lane + i) * 4); const unsigned xw_ = i < 2 ? xv[k][jj].x : xv[k][jj].y; const float x = (i & 1) ? bf_hi(xw_) : bf_lo(xw_), xs = x * gg[jj][i];
                    eacc[k][0] += xs * w.x; eacc[k][1] += xs * w.y; eacc[k][2] += xs * w.z; eacc[k][3] += xs * w.w; hs[i] = x * rstd[k] * gg[jj][i]; }
                if (t < SEQ) { v2u o; o.x = pk2(hs[0], hs[1]); o.y = pk2(hs[2], hs[3]); *(v2u*)(h2 + (size_t)t * DM + ch * 512 + 256 * jj + 4 * lane) = o; } }
            __builtin_amdgcn_sched_barrier(0); }
    }
    }
    { float v[32];
#pragma unroll
        for (int c = 0; c < 32; ++c) v[c] = 0.f;
#pragma unroll
        for (int k = 0; k < TPW; ++k) { v[4 * k] = eacc[k][0]; v[4 * k + 1] = eacc[k][1]; v[4 * k + 2] = eacc[k][2]; v[4 * k + 3] = eacc[k][3]; }
        const int lane2 = lane_id();
        reduce32(v, lane2); const float vt = v[0];
        int me = 0, mt = 0; float mw = 0.f; bool act = false;
#pragma unroll
        for (int k = 0; k < TPW; ++k) {
            const int t = C.gw + k * C.ngw;
            float el[4];
#pragma unroll
            for (int i = 0; i < 4; ++i) el[i] = __shfl(vt, 2 * (4 * k + i)) * rstd[k] + bre[gi[k] * 4 + i];
            int i0 = 0; float v0 = el[0];
#pragma unroll
            for (int i = 1; i < 4; ++i) if (el[i] > v0) { v0 = el[i]; i0 = i; }
            int i1 = -1; float v1 = -3.0e38f;
#pragma unroll
            for (int i = 0; i < 4; ++i) if (i != i0 && el[i] > v1) { v1 = el[i]; i1 = i; }
            const float e1 = __expf(v1 - v0), den = 1.0f / (1.0f + e1);
            const float w0 = den * gwt[k], w1 = e1 * den * gwt[k];
            const int ea = gi[k] * 4 + i0, eb = gi[k] * 4 + i1;
            if (lane2 == 2 * k) { me = ea; mw = w0; mt = t; act = t < SEQ; }
            if (lane2 == 2 * k + 1) { me = eb; mw = w1; mt = t; act = t < SEQ; }
            __builtin_amdgcn_sched_barrier(0);
        }
        volatile LAS int* dr = (volatile LAS int*)(C.lds + LDSCTL_OFF + 2048);
        if (lane2 < 8) dr[C.wave * 8 + lane2] = act ? me : -1;
        __syncthreads();
        if (C.wave == 0 && lane2 < NE) { int n = 0;
#pragma unroll 8
            for (int d = 0; d < 64; ++d) n += dr[d] == lane2;
            int base = 0; if (n > 0) base = (int)__hip_atomic_fetch_add(cnt + 64 * lane2, (unsigned)n, RLX_AGENT);
            dr[64 + lane2] = base; }
        __syncthreads();
        if (act) { const int d0 = C.wave * 8 + lane2; int rank = 0;
            for (int d = 0; d < d0; ++d) rank += dr[d] == me;
            const int x = dr[64 + me] + rank;
            roww[me * ECAP + x] = mw; rowtok[me * ECAP + x] = mt; toke[2 * mt + (lane2 & 1)] = me; toks[2 * mt + (lane2 & 1)] = x; } }
}
struct FinRow { v4u x[4], ya[4], yb[4]; };
__device__ __forceinline__ void fin_load(FinRow& r, const bf16* xr, const bf16* ya, const bf16* yb, int lane) {
#pragma unroll
    for (int j = 0; j < 4; ++j) { const int c0 = 8 * (lane + 64 * j); r.x[j] = __builtin_nontemporal_load((const v4u*)(xr + c0));
        r.ya[j] = __builtin_nontemporal_load((const v4u*)(ya + c0)); r.yb[j] = __builtin_nontemporal_load((const v4u*)(yb + c0)); }
}
struct FinPre { unsigned cv; int ea, sa, eb, sb; v4u x[4]; };
__device__ __forceinline__ void fin_prefetch(FinPre& p, const Ctx& C, const Args& a) {
    unsigned char* ws = a.ws; const int lane = lane_id(); const int t = C.gw < SEQ ? C.gw : 0;
    const int* toke = (const int*)(ws + WS_TOKE); const int* toks = (const int*)(ws + WS_TOKS);
    p.cv = 0; if (lane < NE) p.cv = __hip_atomic_load((const unsigned*)(ws + WS_CTL) + CW_CNT + 64 * lane, RLX_AGENT);
    p.ea = toke[2 * t]; p.sa = toks[2 * t]; p.eb = toke[2 * t + 1]; p.sb = toks[2 * t + 1];
    const bf16* xr = (const bf16*)(ws + WS_X1) + (size_t)t * DM;
#pragma unroll
    for (int j = 0; j < 4; ++j) p.x[j] = __builtin_nontemporal_load((const v4u*)(xr + 8 * (lane + 64 * j)));
}
__device__ __forceinline__ void p8_final(const Ctx& C, const Args& a, const FinPre& pre) {
    unsigned char* ws = a.ws; float* out = a.out; const float* gf = a.in[16]; const bf16* y = (const bf16*)(ws + WS_Y); const bf16* x1 = (const bf16*)(ws + WS_X1);
    const int* toke = (const int*)(ws + WS_TOKE); const int* toks = (const int*)(ws + WS_TOKS);
    const int lane = C.lane;
    const unsigned cv = pre.cv; const int tiles = (int)((cv + 255u) >> 8); int incl = tiles;
#pragma unroll
    for (int o = 1; o < 16; o <<= 1) { const int tt = __shfl_up(incl, o); if (lane >= o) incl += tt; }
    auto rowof = [&](int e, int slot) { return (__shfl(incl, e) - __shfl(tiles, e)) * 256 + slot; };
    int t = C.gw; if (t >= SEQ) return;
    FinRow cur, nxt;
    { const int ra = rowof(pre.ea, pre.sa), rb = rowof(pre.eb, pre.sb); const bf16* ya = y + (size_t)ra * DM; const bf16* yb = y + (size_t)rb * DM;
#pragma unroll
        for (int j = 0; j < 4; ++j) { const int c0 = 8 * (lane + 64 * j); cur.x[j] = pre.x[j]; cur.ya[j] = __builtin_nontemporal_load((const v4u*)(ya + c0)); cur.yb[j] = __builtin_nontemporal_load((const v4u*)(yb + c0)); } }
    for (;;) {
        const int tn = t + C.ngw; const bool more = tn < SEQ;
        if (more) { const int ra = rowof(toke[2 * tn], toks[2 * tn]), rb = rowof(toke[2 * tn + 1], toks[2 * tn + 1]); fin_load(nxt, x1 + (size_t)tn * DM, y + (size_t)ra * DM, y + (size_t)rb * DM, lane); }
        float* xr = out + (size_t)t * DM; float hv[32]; float s = 0.f;
#pragma unroll
        for (int j = 0; j < 4; ++j) { float fa[8], fb[8], fx[8]; pg8::unpack8(cur.ya[j], fa); pg8::unpack8(cur.yb[j], fb); pg8::unpack8(cur.x[j], fx);
#pragma unroll
            for (int i = 0; i < 8; ++i) hv[8 * j + i] = fx[i] + fa[i] + fb[i]; }
#pragma unroll
        for (int i = 0; i < 32; ++i) s += hv[i] * hv[i];
        const float rstd = 1.0f / sqrtf(wave_sum(s) * (1.0f / DM) + RMS_EPS);
#pragma unroll
        for (int j = 0; j < 4; ++j) { const int c0 = 8 * (lane + 64 * j); const f32x4 g0 = *(const f32x4*)(gf + c0), g1 = *(const f32x4*)(gf + c0 + 4);
            __builtin_nontemporal_store((f32x4){hv[8 * j] * rstd * g0.x, hv[8 * j + 1] * rstd * g0.y, hv[8 * j + 2] * rstd * g0.z, hv[8 * j + 3] * rstd * g0.w}, (f32x4*)(xr + c0));
            __builtin_nontemporal_store((f32x4){hv[8 * j + 4] * rstd * g1.x, hv[8 * j + 5] * rstd * g1.y, hv[8 * j + 6] * rstd * g1.z, hv[8 * j + 7] * rstd * g1.w}, (f32x4*)(xr + c0 + 4)); }
        if (!more) break;
        t = tn; cur = nxt;
    }
}

namespace moba {
typedef float f32x16 __attribute__((ext_vector_type(16)));
typedef short s16x4 __attribute__((ext_vector_type(4)));
typedef short v4i16_t __attribute__((ext_vector_type(4)));
constexpr int LK = 0, LV = 65536, LLIST = 131072, LWC = LLIST + 6144;
constexpr int MAXBLK = 12;
constexpr float LOG2E = 1.4426950408889634f, C1 = 0.08838834764831845f * 1.4426950408889634f;
constexpr int TARGET = 416, MAXENT = 192;
struct Tab { int nB, n; unsigned e[MAXENT]; };
constexpr Tab make_tab() {
    Tab t{}; int n = 0; float cost[MAXENT] = {};
    for (int j = 0; j < 31; ++j) { int b = j + 1; bool first = true;
        while (b < 32) { float acc = 0.f; const int lo = b; while (b < 32 && acc < (float)TARGET && b - lo < MAXBLK) { acc += b <= 3 ? 256.f : 768.f / (float)b; ++b; }
            t.e[n] = (unsigned)j | ((unsigned)lo << 8) | ((unsigned)b << 16) | (first ? 1u << 24 : 0u); cost[n] = acc + (first ? 144.f : 0.f); first = false; ++n; } }
    for (int i = 1; i < n; ++i) { const unsigned ke = t.e[i]; const float kc = cost[i]; int k = i - 1; while (k >= 0 && cost[k] < kc) { t.e[k + 1] = t.e[k]; cost[k + 1] = cost[k]; --k; } t.e[k + 1] = ke; cost[k + 1] = kc; }
    t.nB = n;
    t.e[n] = 31u | (31u << 8) | (32u << 16); ++n;
    t.n = n; return t;
}
__device__ const Tab g_tab = make_tab();

__device__ __forceinline__ int crow(int r, int hf) { return (r & 3) + 8 * (r >> 2) + 4 * hf; }
__device__ __forceinline__ s16x4 vtr(const LAS unsigned char* p) { return __builtin_bit_cast(s16x4, __builtin_amdgcn_ds_read_tr16_b64_v4i16((LAS v4i16_t*)p)); }

__device__ __forceinline__ void load_kv(LAS unsigned char* lds, const bf16* K, const bf16* V, int h, int j, int wave, int lane) {
#pragma unroll
    for (int i = 0; i < 8; ++i) { const int p = wave * 8 + i; const int key = 4 * p + (lane >> 4), cp = lane & 15;
        const bf16* src = K + (size_t)(j * 256 + key) * AW + h * HD + ((cp ^ (key & 15)) * 8);
        __builtin_amdgcn_global_load_lds((const unsigned*)src, (LAS unsigned*)(lds + LK + p * 1024), 16, 0, 0); }
#pragma unroll
    for (int i = 0; i < 8; ++i) { const int p = wave * 8 + i; const int q4 = p >> 4, kg = p & 15; const int key = kg * 16 + (lane >> 2), part = lane & 3;
        const bf16* src = V + (size_t)(j * 256 + key) * AW + h * HD + q4 * 32 + part * 8;
        __builtin_amdgcn_global_load_lds((const unsigned*)src, (LAS unsigned*)(lds + LV + q4 * 16384 + kg * 1024), 16, 0, 0); }
}

#define MOBA_SB() __builtin_amdgcn_sched_barrier(0)
template <bool CAUSAL>
__device__ __forceinline__ void attn_group(LAS unsigned char* lds, const LAS unsigned short* ent, int cnt, int tbase, const bf16* Q, bf16* part, bf16* part3, float* ml, int h, int j, int kmax, int lane) {
    const int ql = lane & 31, hf = lane >> 5;
    const unsigned en = ent[ql < cnt ? ql : 0];
    const int tq = tbase + (int)(en & 0xfffu), slot = (int)(en >> 12);
    bf16x8 qf[8]; { const bf16* qp = Q + (size_t)tq * AW + h * HD + 8 * hf;
#pragma unroll
        for (int s = 0; s < 8; ++s) qf[s] = *(const bf16x8*)(qp + 16 * s); }
    const float slope2 = exp2f(-(float)(h + 1)) * LOG2E;
    const float tb = (float)(j * 256 + 4 * hf - tq);
    f32x16 o[4];
#pragma unroll
    for (int d = 0; d < 4; ++d)
#pragma unroll
        for (int r = 0; r < 16; ++r) o[d][r] = 0.f;
    float m_run = -1e30f, l_run = 0.f;
    const LAS unsigned char* kbase = lds + LK + ql * 256;
    const LAS unsigned char* vbase = lds + LV + (4 * hf + ((lane & 15) >> 2)) * 64 + ((lane >> 4) & 1) * 32 + (lane & 3) * 8;
    const int kq = ql & 15;
#define MOBA_KF(idx) (*(const LAS bf16x8*)(kbase + ((idx) >> 3) * 8192 + (((2 * ((idx) & 7) + hf) ^ kq) * 16)))
#pragma unroll
    for (int half = 0; half < 2; ++half) {
        if (CAUSAL && half * 128 > kmax) break;
        f32x16 st[4];
#pragma unroll
        for (int kt = 0; kt < 4; ++kt)
#pragma unroll
            for (int r = 0; r < 16; ++r) st[kt][r] = 0.f;
        bf16x8 kr[8];
#pragma unroll
        for (int i = 0; i < 3; ++i) kr[i] = MOBA_KF(half * 32 + i);
#pragma unroll
        for (int i = 0; i < 32; ++i) {
            if (i + 3 < 32) kr[(i + 3) & 7] = MOBA_KF(half * 32 + i + 3);
            if ((i & 3) == 0) MOBA_SB();
            const int kt = i >> 3, s = i & 7;
            if (!(CAUSAL && (half * 4 + kt) * 32 > kmax)) st[kt] = __builtin_amdgcn_mfma_f32_32x32x16_bf16(kr[i & 7], qf[s], st[kt], 0, 0, 0);
        }
#pragma unroll
        for (int kt = 0; kt < 4; ++kt) {
            const int ktt = half * 4 + kt;
            if (CAUSAL && ktt * 32 > kmax) {
#pragma unroll
                for (int r = 0; r < 16; ++r) st[kt][r] = -1e30f;
            } else {
                const float tbk = tb + (float)(ktt * 32);
#pragma unroll
                for (int r = 0; r < 16; ++r) { const float rel = tbk + (float)((r & 3) + 8 * (r >> 2));
                    float s2 = st[kt][r] * C1 + slope2 * rel; if (CAUSAL && rel > 0.f) s2 = -1e30f; st[kt][r] = s2; }
            }
        }
        float mx = -1e30f;
#pragma unroll
        for (int kt = 0; kt < 4; ++kt)
#pragma unroll
            for (int r = 0; r < 16; ++r) mx = fmaxf(mx, st[kt][r]);
        mx = fmaxf(mx, __shfl_xor(mx, 32));
        const float m_new = fmaxf(m_run, mx), alpha = __builtin_amdgcn_exp2f(m_run - m_new);
        m_run = m_new; l_run *= alpha;
        if (half == 1) {
#pragma unroll
            for (int d = 0; d < 4; ++d)
#pragma unroll
                for (int r = 0; r < 16; ++r) o[d][r] *= alpha; }
        float ls = 0.f;
        s16x4 vr[8];
#define MOBA_VF(slot, idx) do { const LAS unsigned char* vp_ = vbase + ((idx) & 3) * 16384 + (half * 8 + ((idx) >> 2)) * 1024; vr[2 * (slot)] = vtr(vp_); vr[2 * (slot) + 1] = vtr(vp_ + 512); } while (0)
        MOBA_VF(0, 0); MOBA_VF(1, 1);
#pragma unroll
        for (int kt = 0; kt < 4; ++kt) {
            const int ktt = half * 4 + kt;
            const bool skip = CAUSAL && ktt * 32 > kmax;
            float p[16];
            if (!skip) {
#pragma unroll
                for (int r = 0; r < 16; ++r) { p[r] = __builtin_amdgcn_exp2f(st[kt][r] - m_new); ls += p[r]; } }
            else {
#pragma unroll
                for (int r = 0; r < 16; ++r) p[r] = 0.f; }
#pragma unroll
            for (int s2 = 0; s2 < 2; ++s2) {
                v4u pw; pw.x = pg8::cvt_pk_bf16(p[8 * s2 + 0], p[8 * s2 + 1]); pw.y = pg8::cvt_pk_bf16(p[8 * s2 + 2], p[8 * s2 + 3]); pw.z = pg8::cvt_pk_bf16(p[8 * s2 + 4], p[8 * s2 + 5]); pw.w = pg8::cvt_pk_bf16(p[8 * s2 + 6], p[8 * s2 + 7]);
                const bf16x8 pf = __builtin_bit_cast(bf16x8, pw);
#pragma unroll
                for (int d = 0; d < 4; ++d) {
                    const int idx = (kt * 2 + s2) * 4 + d;
                    if (idx + 2 < 32) MOBA_VF((idx + 2) & 3, idx + 2);
                    if ((idx & 1) == 0) MOBA_SB();
                    const s16x4 lo = vr[2 * (idx & 3)], hi = vr[2 * (idx & 3) + 1];
                    const bf16x8 vf = (bf16x8){lo[0], lo[1], lo[2], lo[3], hi[0], hi[1], hi[2], hi[3]};
                    if (!skip) o[d] = __builtin_amdgcn_mfma_f32_32x32x16_bf16(vf, pf, o[d], 0, 0, 0);
                }
            }
        }
#undef MOBA_VF
        l_run += ls;
    }
#undef MOBA_KF
    const float l_tot = l_run + __shfl_xor(l_run, 32);
    const float inv = 1.0f / l_tot;
    v4u ow[8];
#pragma unroll
    for (int d = 0; d < 4; ++d)
#pragma unroll
        for (int p = 0; p < 2; ++p) { const int r0 = 8 * p;
            unsigned ax = pg8::cvt_pk_bf16(o[d][r0] * inv, o[d][r0 + 1] * inv), ay = pg8::cvt_pk_bf16(o[d][r0 + 2] * inv, o[d][r0 + 3] * inv);
            unsigned bx = pg8::cvt_pk_bf16(o[d][r0 + 4] * inv, o[d][r0 + 5] * inv), by = pg8::cvt_pk_bf16(o[d][r0 + 6] * inv, o[d][r0 + 7] * inv);
            { const auto r = __builtin_amdgcn_permlane32_swap(ax, bx, false, false); ax = r[0]; bx = r[1]; }
            { const auto r = __builtin_amdgcn_permlane32_swap(ay, by, false, false); ay = r[0]; by = r[1]; }
            ow[2 * d + p] = (v4u){ax, ay, bx, by}; }
    if (ql < cnt) {
        bf16* pp = (slot == 3 ? part3 : part + (size_t)slot * SEQ * AW) + (size_t)tq * AW + h * HD + 8 * hf;
#pragma unroll
        for (int j2 = 0; j2 < 8; ++j2) *(v4u*)(pp + 16 * j2) = ow[j2];
        if (hf == 0) *(f32x2*)(ml + ((size_t)slot * SEQ + tq) * (2 * NH) + 2 * h) = (f32x2){m_run, l_tot};
    }
}
}

__device__ __forceinline__ bf16* part_ptr(unsigned char* ws) { return (bf16*)(ws + WS_PART); }
__device__ __forceinline__ float* ml_ptr(unsigned char* ws) { return (float*)(ws + WS_ML); }

__device__ __forceinline__ void p_attn(const Ctx& C, const Args& a, int rep, bool kv0) {
    using namespace moba;
    unsigned char* ws = a.ws; LAS unsigned char* lds = C.lds;
    const bf16* Q = (const bf16*)(ws + WS_Q); const bf16* K = (const bf16*)(ws + WS_K); const bf16* V = (const bf16*)(ws + WS_V);
    const unsigned* sel = (const unsigned*)(ws + WS_SEL); bf16* part = part_ptr(ws); bf16* part3 = (bf16*)(ws + WS_PART3); float* ml = ml_ptr(ws);
    unsigned* ctr = (unsigned*)(ws + WS_CTL) + CW_ATTN + 64 * rep;
    LAS unsigned short* lst = (LAS unsigned short*)(lds + LLIST); volatile LAS int* wc = (volatile LAS int*)(lds + LWC);
    const int NU = g_tab.n * NH; const int tid = C.tid, lane = C.lane, wave = C.wave;
    int u = C.bid;
    while (u < NU) {
        const unsigned ent = g_tab.e[u >> 3]; const int h = u & 7, j = (int)(ent & 0xff), blo = (int)((ent >> 8) & 0xff), bhi = (int)((ent >> 16) & 0xff);
        const bool past = blo != j, own = !past || ((ent >> 24) & 1u); const int t_lo = blo * 256; int n = 0;
        const int nt = past ? (bhi - blo) * 256 : 0;
        unsigned spv[MAXBLK / 2];
#pragma unroll
        for (int i = 0; i < MAXBLK / 2; ++i) { const int tr = i * 512 + tid; spv[i] = 0xffffffffu; if (tr < nt) spv[i] = sel[(t_lo + tr) * NH + h]; }
        if (!kv0) load_kv(lds, K, V, h, j, wave, lane);
        kv0 = false;
        LAS unsigned short* lown = (LAS unsigned short*)(lds + LWC + 256);
        if (own && tid < 256) lown[tid] = (unsigned short)(tid | (3 << 12));
        if (past) {
            int slot[MAXBLK / 2]; int before[MAXBLK / 2]; int mycnt = 0;
#pragma unroll
            for (int i = 0; i < MAXBLK / 2; ++i) { const unsigned sp = spv[i]; slot[i] = (int)(sp & 0xff) == j ? 0 : (int)((sp >> 8) & 0xff) == j ? 1 : (int)((sp >> 16) & 0xff) == j ? 2 : -1; }
#pragma unroll
            for (int i = 0; i < MAXBLK / 2; ++i) { const unsigned long long bal = __ballot(slot[i] >= 0); before[i] = mycnt + __popcll(bal & ((1ull << lane) - 1ull)); mycnt += __popcll(bal); }
            if (lane == 0) wc[wave] = mycnt;
            __syncthreads();
            int base = 0, tot = 0;
#pragma unroll
            for (int w = 0; w < 8; ++w) { const int c = wc[w]; if (w < wave) base += c; tot += c; }
#pragma unroll
            for (int i = 0; i < MAXBLK / 2; ++i) if (slot[i] >= 0) lst[base + before[i]] = (unsigned short)((i * 512 + tid) | (slot[i] << 12));
            n = tot;
        }
        if (tid == 0) wc[16] = (int)(C.G + __hip_atomic_fetch_add(ctr, 1u, RLX_AGENT));
        asm volatile("s_waitcnt vmcnt(0)" ::: "memory"); __syncthreads();
        if (own) attn_group<true>(lds, lown + wave * 32, 32, j * 256, Q, part, part3, ml, h, j, wave * 32 + 31, lane);
        if (past) { const int ng = (n + 31) >> 5;
            for (int g = 7 - wave; g < ng; g += 8) { const int c = n - g * 32; attn_group<false>(lds, lst + g * 32, c < 32 ? c : 32, t_lo, Q, part, part3, ml, h, j, 255, lane); } }
        __syncthreads();
        u = wc[16];
        __syncthreads();
    }
}

__device__ __forceinline__ void p_combine(const Ctx& C, const Args& a) {
    unsigned char* ws = a.ws; const unsigned* sel = (const unsigned*)(ws + WS_SEL); const bf16* part = part_ptr(ws); const bf16* part3 = (const bf16*)(ws + WS_PART3); const float* ml = ml_ptr(ws); bf16* ao = (bf16*)(ws + WS_AO);
    const int lane = C.lane, h = lane >> 3, dc = lane & 7;
    for (int t0 = C.gw; t0 < SEQ; t0 += 2 * C.ngw) {
        f32x2 mv[2][4]; v4u pv[2][4][2]; bool val[2][4];
#pragma unroll
        for (int k = 0; k < 2; ++k) { const int t = t0 + k * C.ngw; const bool tv = t < SEQ; const int tt = tv ? t : 0; const unsigned sp = sel[tt * NH + h]; const int own = tt >> 8;
#pragma unroll
            for (int s = 0; s < 4; ++s) { val[k][s] = tv && (s == 3 || (int)((sp >> (8 * s)) & 0xff) < own); } }
#pragma unroll
        for (int k = 0; k < 2; ++k) { const int t = t0 + k * C.ngw; const int tt = t < SEQ ? t : 0;
#pragma unroll
            for (int s = 0; s < 4; ++s) { mv[k][s] = (f32x2){-1e30f, 0.f}; pv[k][s][0] = (v4u){0u, 0u, 0u, 0u}; pv[k][s][1] = (v4u){0u, 0u, 0u, 0u};
                if (val[k][s]) { mv[k][s] = *(const f32x2*)(ml + ((size_t)s * SEQ + tt) * (2 * NH) + 2 * h);
                    const bf16* pp = (s == 3 ? part3 : part + (size_t)s * SEQ * AW) + (size_t)tt * AW + h * HD + dc * 16;
                    pv[k][s][0] = __builtin_nontemporal_load((const v4u*)pp); pv[k][s][1] = __builtin_nontemporal_load((const v4u*)(pp + 8)); } } }
#pragma unroll
        for (int k = 0; k < 2; ++k) { const int t = t0 + k * C.ngw;
            float M = -1e30f;
#pragma unroll
            for (int s = 0; s < 4; ++s) M = fmaxf(M, mv[k][s].x);
            float w[4], L = 0.f;
#pragma unroll
            for (int s = 0; s < 4; ++s) { w[s] = mv[k][s].y * exp2f(mv[k][s].x - M); L += w[s]; }
            const float invL = 1.0f / L; float acc[16];
#pragma unroll
            for (int i = 0; i < 16; ++i) acc[i] = 0.f;
#pragma unroll
            for (int s = 0; s < 4; ++s) { float f0[8], f1[8]; pg8::unpack8(pv[k][s][0], f0); pg8::unpack8(pv[k][s][1], f1); const float ws_ = w[s] * invL;
#pragma unroll
                for (int i = 0; i < 8; ++i) { acc[i] += ws_ * f0[i]; acc[8 + i] += ws_ * f1[i]; } }
            if (t < SEQ) { v4u o0, o1; o0.x = pk2(acc[0], acc[1]); o0.y = pk2(acc[2], acc[3]); o0.z = pk2(acc[4], acc[5]); o0.w = pk2(acc[6], acc[7]);
                o1.x = pk2(acc[8], acc[9]); o1.y = pk2(acc[10], acc[11]); o1.z = pk2(acc[12], acc[13]); o1.w = pk2(acc[14], acc[15]);
                bf16* op = ao + (size_t)t * AW + h * HD + dc * 16; *(v4u*)op = o0; *(v4u*)(op + 8) = o1; }
        }
    }
}

__device__ __forceinline__ void p_gate_mfma(const Ctx& C, const Args& a) {
    using moba::f32x16;
    unsigned char* ws = a.ws; const bf16* Q = (const bf16*)(ws + WS_Q); const float* kpart = (const float*)(ws + WS_KPART); unsigned* sel = (unsigned*)(ws + WS_SEL);
    const int lane = C.lane, ql = lane & 31, hf = lane >> 5;
    const bool split = C.G == 256; const int g0 = split ? C.gw - 128 * NWAVES : C.gw, gstep = split ? 128 * NWAVES : C.ngw;
    if (split && C.bid < 128) return;
    if (g0 >= (SEQ / 32) * NH) return;
    const int h = g0 & 7;
    v4u hwv[8], lwv[8];
    { const float* kp = kpart + (size_t)ql * 2048 + h * HD + 8 * hf;
#pragma unroll
        for (int s = 0; s < 8; ++s) {
            const f32x4 p0 = *(const f32x4*)(kp + 16 * s), p1 = *(const f32x4*)(kp + 16 * s + 4), r0 = *(const f32x4*)(kp + 1024 + 16 * s), r1 = *(const f32x4*)(kp + 1024 + 16 * s + 4);
            const f32x4 m0 = (p0 + r0) * (1.0f / MBLK), m1 = (p1 + r1) * (1.0f / MBLK);
            const float mm[8] = {m0.x, m0.y, m0.z, m0.w, m1.x, m1.y, m1.z, m1.w}; unsigned hb[8], lb[8];
#pragma unroll
            for (int i = 0; i < 8; ++i) { hb[i] = f2bf(mm[i]); lb[i] = f2bf(mm[i] - __builtin_bit_cast(float, hb[i] << 16)); }
            hwv[s].x = hb[0] | (hb[1] << 16); hwv[s].y = hb[2] | (hb[3] << 16); hwv[s].z = hb[4] | (hb[5] << 16); hwv[s].w = hb[6] | (hb[7] << 16);
            lwv[s].x = lb[0] | (lb[1] << 16); lwv[s].y = lb[2] | (lb[3] << 16); lwv[s].z = lb[4] | (lb[5] << 16); lwv[s].w = lb[6] | (lb[7] << 16); } }
    bf16x8 qn[8];
    { const bf16* qp = Q + (size_t)((g0 >> 3) * 32 + ql) * AW + h * HD + 8 * hf;
#pragma unroll
        for (int s = 0; s < 8; ++s) qn[s] = *(const bf16x8*)(qp + 16 * s); }
#pragma unroll 1
    for (int it = g0; it < (SEQ / 32) * NH; it += gstep) {
        const int tile = it >> 3, tq = tile * 32 + ql, own = tile >> 3;
        bf16x8 qc[8];
#pragma unroll
        for (int s = 0; s < 8; ++s) qc[s] = qn[s];
        { const int itn = it + gstep < (SEQ / 32) * NH ? it + gstep : it; const bf16* qp = Q + (size_t)((itn >> 3) * 32 + ql) * AW + h * HD + 8 * hf;
#pragma unroll
            for (int s = 0; s < 8; ++s) qn[s] = *(const bf16x8*)(qp + 16 * s); }
        f32x16 acc;
#pragma unroll
        for (int r = 0; r < 16; ++r) acc[r] = 0.f;
#pragma unroll
        for (int s = 0; s < 8; ++s) { acc = __builtin_amdgcn_mfma_f32_32x32x16_bf16(__builtin_bit_cast(bf16x8, hwv[s]), qc[s], acc, 0, 0, 0); acc = __builtin_amdgcn_mfma_f32_32x32x16_bf16(__builtin_bit_cast(bf16x8, lwv[s]), qc[s], acc, 0, 0, 0); }
        float g[16];
#pragma unroll
        for (int r = 0; r < 16; ++r) g[r] = moba::crow(r, hf) < own ? acc[r] : -1e30f;
        unsigned packed = 0;
#pragma unroll
        for (int rd = 0; rd < 3; ++rd) {
            float bv = g[0]; int bi = moba::crow(0, hf);
#pragma unroll
            for (int r = 1; r < 16; ++r) { const int idx = moba::crow(r, hf); if (gate_better(g[r], idx, bv, bi)) { bv = g[r]; bi = idx; } }
            { const float ov = __shfl_xor(bv, 32); const int oi = __shfl_xor(bi, 32); if (gate_better(ov, oi, bv, bi)) { bv = ov; bi = oi; } }
            packed |= (unsigned)bi << (8 * rd);
#pragma unroll
            for (int r = 0; r < 16; ++r) if (moba::crow(r, hf) == bi) g[r] = -3.0e38f;
        }
        if (hf == 0) sel[tq * NH + h] = packed;
    }
}

__device__ __forceinline__ Ctx phase_ctx(const Ctx& C0) { Ctx C = C0; C.lane = lane_id(); asm volatile("" : "+v"(C.lane)); C.tid = C0.wave * 64 + C.lane; C.gw = C.bid * NWAVES + C.wave; return C; }
__device__ __forceinline__ Args phase_args(const Args& a0) { Args a = a0; GAS unsigned char* w = (GAS unsigned char*)a0.ws; asm volatile("" : "+s"(w)); a.ws = (unsigned char*)w; return a; }
#ifndef SKIP_GU
#define SKIP_GU true
#endif
#ifndef SKIP_DN
#define SKIP_DN true
#endif
struct BarRef { const XcdBarrier* b; __device__ __forceinline__ void sync() const { xcd_barrier(*b); } };
__global__ void __launch_bounds__(NTHREADS, 2) mk_fwd(Args args) {
    extern __shared__ __attribute__((aligned(16))) unsigned char lds[];
    Ctx C0; C0.lds = (LAS unsigned char*)lds; C0.tid = threadIdx.x; C0.lane = C0.tid & 63; C0.wave = __builtin_amdgcn_readfirstlane(C0.tid >> 6);
    C0.G = gridDim.x; C0.bid = blockIdx.x; C0.gw = C0.bid * NWAVES + C0.wave; C0.ngw = C0.G * NWAVES;
    LAS unsigned char* ring = C0.lds + RING_OFF;
    for (int u = C0.tid; u < (LDS_BYTES - LDSCTL_OFF) / 4; u += NTHREADS) ((LAS unsigned*)(C0.lds + LDSCTL_OFF))[u] = 0u;
    __syncthreads();
    volatile LAS unsigned* MISC = (volatile LAS unsigned*)(C0.lds + MISC_OFF);
    XcdBarrier bar = xcd_barrier_post((unsigned*)(args.ws + WS_CTL) + CW_BAR, MISC + 8, C0.wave);
#define SEAM() xcd_barrier(bar)
    { const Ctx C = phase_ctx(C0); const Args A = phase_args(args); p0_prologue(C, A); }
    SEAM();
    { const Ctx C = phase_ctx(C0); const Args A = phase_args(args); unsigned char* ws = A.ws;
        const int grp = C.bid >> 3; const bool conv_cu = (C.G == 256) && (grp % 5 == 4);
        if (!conv_cu) {
            const int Gg = C.G == 256 ? 208 : C.G, cg = C.G == 256 ? C.bid - 8 * ((grp + 1) / 5) : C.bid;
            pg8::Gemm g{(const bf16*)(ws + WS_HN), (const bf16*)(ws + WS_WIN), SEQ, NPROJ, DM}; pg8::StaticOrder S; S.init(SEQ, NPROJ, Gg, cg);
            pg8::EpiInProj E{(bf16*)(ws + WS_U), (bf16*)(ws + WS_Q), (bf16*)(ws + WS_K), (bf16*)(ws + WS_V), (bf16*)(ws + WS_SGP), (bf16*)(ws + WS_SGA), (float*)(ws + WS_KPART)};
            const bool five = cg < 192; const int nu = C.G == 256 && five ? 1 + ((cg >> 3) & 3) : (1 << 30), ntot = five ? CV_S5 : CV_S4;
            { pg8::RangeOrder R{S, 0, nu}; pg8::gemm_phase<pg8::EpiInProj, pg8::RangeOrder, true, true>(ring, g, R, E, C.wave); }
            conv_tiles<false>(C, A, cg * NWAVES + C.wave, 0, ntot);
            if (nu < (1 << 30)) { __syncthreads();
                pg8::RangeOrder R{S, nu, 1 << 30}; pg8::gemm_phase<pg8::EpiInProj, pg8::RangeOrder, true, true>(ring, g, R, E, C.wave); }
        } else conv_tiles<true>(C, A, 0);
    }
    { const Ctx C = phase_ctx(C0); const Args A = phase_args(args); xcd_barrier_hook(bar, [&]() { late_hook(C, A, 0); moe_hook(C, A, 5, 3, CV_H0, CV_HA); }); }
    { const Ctx C = phase_ctx(C0); const Args A = phase_args(args); unsigned char* ws = A.ws;
        for (int L = C.bid; L < 128; L += C.G) pool_unit(C, A, L);
        p_gate_mfma(C, A);
        if (C.G == 256 && C.bid >= 128) { __syncthreads();
            const TrDesc d = moe_desc(A, CV_H0 + 2 * CV_HA + CV_HC + CV_HD + (C.bid - 128) * NWAVES + C.wave); f32x4 va[16]; tr_load(d, va, C.lane); tr_store(d, va, (LAS float*)(C.lds + C.wave * 16640), C.lane); }
    }
    bool kv0 = false;
    { const Ctx C = phase_ctx(C0); const Args A = phase_args(args);
        const int u0 = C.bid; kv0 = u0 < moba::g_tab.n * NH;
        xcd_barrier_hook(bar, [&]() { if (kv0) { const unsigned ent = moba::g_tab.e[u0 >> 3];
            moba::load_kv(C.lds, (const bf16*)(A.ws + WS_K), (const bf16*)(A.ws + WS_V), u0 & 7, (int)(ent & 0xff), C.wave, lane_id()); } });
    }
    { const Ctx C = phase_ctx(C0); const Args A = phase_args(args); p_attn(C, A, 0, kv0); }
    { const Ctx C = phase_ctx(C0); const Args A = phase_args(args); xcd_barrier_hook(bar, [&]() { late_hook(C, A, 1); moe_hook(C, A, 5, 3, CV_H0 + CV_HA, CV_HA); moe_hook(C, A, 1, 4, CV_H0 + 2 * CV_HA + CV_HC, CV_HD); }); }
    { const Ctx C = phase_ctx(C0); const Args A = phase_args(args); p_combine(C, A); }
    xcd_barrier_arrive(bar);
    { const Ctx C = phase_ctx(C0); const Args A = phase_args(args); unsigned char* ws = A.ws;
        pg8::Gemm g{(const bf16*)(ws + WS_YP), (const bf16*)(ws + WS_WBP), 2 * SEQ, 2 * DM, PW}; pg8::BranchOrder S; S.init(C.G, C.bid); S.sb_wave = bar.wave; S.sb_bar = bar.bar; S.sb_x = bar.x; S.sb_st = bar.st;
        pg8::EpiBranch E{(const bf16*)(ws + WS_SGP), (bf16*)(ws + WS_TMP), (long)((WS_SGA - WS_SGP) / 2), ((long)WS_HN - (long)WS_TMP) / 2};
        pg8::gemm_phase<pg8::EpiBranch, pg8::BranchOrder, true, true>(ring, g, S, E, C.wave);
        if (S.nc == 0) xcd_barrier_wait_f(bar.wave, bar.bar, bar.x, bar.st);
    }
    pg8::f32x4 acc6[2][2][4][2];
    { const Ctx C = phase_ctx(C0); const Args A = phase_args(args);
        pg8::StaticOrder S6; S6.init(SEQ, DM, C.G, C.bid); pg8::Unit u6; const bool has6 = S6.next(0, u6); const pg8::EpiResid E6{A.in[0], nullptr};
        xcd_barrier_hook(bar, [&]() { if (has6) { const int ln = lane_id(); E6.seed(acc6, u6, C.wave >> 2, C.wave & 3, ln & 15, ln >> 4); } });
    }
    { const Ctx C = phase_ctx(C0); const Args A = phase_args(args); unsigned char* ws = A.ws;
        pg8::Gemm g{(const bf16*)(ws + WS_HN), (const bf16*)(ws + WS_WOUT), SEQ, DM, DM}; pg8::StaticOrder S; S.init(SEQ, DM, C.G, C.bid);
        pg8::EpiResid E{A.in[0], (bf16*)(ws + WS_X1)};
        pg8::gemm_phase<pg8::EpiResid, pg8::StaticOrder, true, true, false, false, true>(ring, g, S, E, C.wave, acc6);
    }
    { const Ctx C = phase_ctx(C0); const Args A = phase_args(args); xcd_barrier_hook(bar, [&]() { moe_hook(C, A, 1, 2, CV_H0 + 2 * CV_HA, CV_HC); }); }
    { const Ctx C = phase_ctx(C0); const Args A = phase_args(args); BarRef br{&bar}; p_router(C, A, br); }
    SEAM();
    { const Ctx C = phase_ctx(C0); const Args A = phase_args(args); unsigned char* ws = A.ws;
        if (C.tid < NE) ((LAS unsigned*)(C.lds + LDSCTL_OFF + 1024))[C.tid] = __hip_atomic_load((const unsigned*)(ws + WS_CTL) + CW_CNT + 64 * C.tid, RLX_AGENT);
        __syncthreads();
        pg8::Gemm g{(const bf16*)(ws + WS_HN), (const bf16*)(ws + WS_WGU), 0, 0, DM, (const int*)(ws + WS_ROWTOK)}; pg8::MoeOrder S{(const LAS unsigned*)(C.lds + LDSCTL_OFF + 1024), 0, C.G, C.bid};
        pg8::EpiGU E{(bf16*)(ws + WS_HID), (const float*)(ws + WS_ROWW)};
        pg8::gemm_phase<pg8::EpiGU, pg8::MoeOrder, true, true, false, true>(ring, g, S, E, C.wave);
    }
    SEAM();
    { const Ctx C = phase_ctx(C0); const Args A = phase_args(args); unsigned char* ws = A.ws;
        { pg8::Gemm g{(const bf16*)(ws + WS_HN), (const bf16*)(ws + WS_WGU), 0, 0, DM, (const int*)(ws + WS_ROWTOK)}; pg8::MoeOrder S{(const LAS unsigned*)(C.lds + LDSCTL_OFF + 1024), 1, C.G, C.bid};
          pg8::EpiGU E{(bf16*)(ws + WS_HID), (const float*)(ws + WS_ROWW)};
          pg8::gemm_phase<pg8::EpiGU, pg8::MoeOrder, true, true, false, true>(ring, g, S, E, C.wave); }
        { pg8::Gemm g{(const bf16*)(ws + WS_HID), (const bf16*)(ws + WS_WDN), 0, 0, DE}; pg8::MoeOrder S{(const LAS unsigned*)(C.lds + LDSCTL_OFF + 1024), 2, C.G, C.bid};
          pg8::EpiDown E{(bf16*)(ws + WS_Y)};
          pg8::gemm_phase<pg8::EpiDown, pg8::MoeOrder, true, true>(ring, g, S, E, C.wave); }
    }
    SEAM();
    { const Ctx C = phase_ctx(C0); const Args A = phase_args(args); unsigned char* ws = A.ws;
        pg8::Gemm g{(const bf16*)(ws + WS_HID), (const bf16*)(ws + WS_WDN), 0, 0, DE}; pg8::MoeOrder S{(const LAS unsigned*)(C.lds + LDSCTL_OFF + 1024), 3, C.G, C.bid};
        pg8::EpiDown E{(bf16*)(ws + WS_Y)};
        pg8::gemm_phase<pg8::EpiDown, pg8::MoeOrder, true, true>(ring, g, S, E, C.wave);
    }
    FinPre fpre;
    { const Ctx C = phase_ctx(C0); const Args A = phase_args(args); xcd_barrier_hook(bar, [&]() { fin_prefetch(fpre, C, A); }); }
    { const Ctx C = phase_ctx(C0); const Args A = phase_args(args); p8_final(C, A, fpre); }
#undef SEAM
}

#ifndef MK_N_LAUNCHES
#define MK_N_LAUNCHES 1
#endif
extern "C" void kernel_launch(void* const* d_in, const int* in_sizes, int n_in, void* d_out, int out_size, void* d_ws, size_t ws_size, hipStream_t stream) {
    static int grid = 0;
    if (grid == 0) {
        if (n_in != 17 || out_size != SEQ * DM || ws_size < WS_END) { fprintf(stderr, "kernel_launch: unexpected shapes (n_in %d out %d ws %zu)\n", n_in, out_size, ws_size); grid = -1; return; }
        int dev = 0, cus = 0, per_cu = 0;
        if (hipGetDevice(&dev) != hipSuccess || hipDeviceGetAttribute(&cus, hipDeviceAttributeMultiprocessorCount, dev) != hipSuccess) { grid = -1; return; }
        if (hipFuncSetAttribute((const void*)mk_fwd, hipFuncAttributeMaxDynamicSharedMemorySize, LDS_BYTES) != hipSuccess) { fprintf(stderr, "kernel_launch: hipFuncSetAttribute failed\n"); grid = -1; return; }
        if (hipOccupancyMaxActiveBlocksPerMultiprocessor(&per_cu, (const void*)mk_fwd, NTHREADS, LDS_BYTES) != hipSuccess || per_cu < 1) { fprintf(stderr, "kernel_launch: occupancy query failed (%d)\n", per_cu); (void)hipGetLastError(); per_cu = 1; }
        if (per_cu > 1) per_cu = 1;
        grid = cus * per_cu;
    }
    if (grid < 0) return;
    (void)hipMemsetAsync((char*)d_ws + WS_CTL, 0, CTL_ZERO_BYTES, stream);
    Args a{};
    for (int i = 0; i < 17; ++i) a.in[i] = (const float*)d_in[i];
    a.out = (float*)d_out; a.ws = (unsigned char*)d_ws;
    if (MK_N_LAUNCHES == 1) {
        a.ph_lo = 0; a.ph_hi = 0; void* kargs[] = {&a};
        hipError_t e = hipLaunchCooperativeKernel((const void*)mk_fwd, dim3(grid), dim3(NTHREADS), kargs, LDS_BYTES, stream);
        if (e != hipSuccess) fprintf(stderr, "kernel_launch: cooperative launch failed: %s (grid %d)\n", hipGetErrorString(e), grid);
    } else {
        fprintf(stderr, "kernel_launch: multi-launch build not supported in this version\n");
    }
}
```
